# Optimizing an MI355X kernel written in HIP

```python
import math
import jax, jax.numpy as jnp
from jax import lax
import numpy as np

D_MODEL = 1024
BATCH = 4
SEQ = 4096
DEPTH = 2
DEC_BATCH = 16
DEC_SEQ = 64
PAST_LEN = 4096

CHUNK = 64
C_CONV = D_MODEL // 2
CONV_WIDTH = 31
HEAD_DIM = 64
N_HEADS = (D_MODEL // 2) // HEAD_DIM
N_KV_HEADS = 2
GROUP = N_HEADS // N_KV_HEADS
ATTN_WIDTH = N_HEADS * HEAD_DIM
MIX_WIDTH = C_CONV + ATTN_WIDTH
N_IDX_HEADS = 8
IDX_DIM = 64
TOPK_MAX = 256
ROPE_THETA = 10000.0
QUERY_BLOCK = 128
D_FF = -(-8 * D_MODEL // (3 * 256)) * 256
IN_DIM = 2 * C_CONV + (N_HEADS + 2 * N_KV_HEADS) * HEAD_DIM + N_IDX_HEADS * IDX_DIM + IDX_DIM + N_IDX_HEADS
ALPHA = (2 * DEPTH) ** 0.25
BETA = (8 * DEPTH) ** -0.25
ATTN_SCALE = HEAD_DIM ** -0.5
IDX_SCALE = IDX_DIM ** -0.5
IDX_HEAD_SCALE = N_IDX_HEADS ** -0.5
LN_EPS = 1e-5

kernel_name = "hybrid_conv_dsa_stream_step"


def layer_norm(x, g, b):
    xf = x.astype(jnp.float32)
    mu = jnp.mean(xf, axis=-1, keepdims=True)
    var = jnp.mean(jnp.square(xf - mu), axis=-1, keepdims=True)
    y = (xf - mu) * lax.rsqrt(var + LN_EPS) * g.astype(jnp.float32) + b.astype(jnp.float32)
    return y.astype(x.dtype)


def rope(x, pos):
    half = x.shape[-1] // 2
    inv = ROPE_THETA ** (-jnp.arange(half, dtype=jnp.float32) / half)
    ang = pos.astype(jnp.float32)[:, None] * inv[None, :]
    cos = jnp.cos(ang)[None, :, None, :]
    sin = jnp.sin(ang)[None, :, None, :]
    xf = x.astype(jnp.float32)
    x1, x2 = xf[..., :half], xf[..., half:]
    return jnp.concatenate([x1 * cos - x2 * sin, x2 * cos + x1 * sin], axis=-1).astype(x.dtype)


def conv_mixer(u, conv_state, conv_w, conv_b, ln_g, ln_b):
    full = jnp.concatenate([conv_state.astype(u.dtype), u], axis=1)
    y = lax.conv_general_dilated(full, conv_w[:, None, :].astype(u.dtype), window_strides=(1,),
                                 padding='VALID', dimension_numbers=('NWC', 'WIO', 'NWC'),
                                 feature_group_count=C_CONV) + conv_b
    y = jax.nn.silu(layer_norm(y, ln_g, ln_b))
    return y, full[:, -(CONV_WIDTH - 1):]


def dsa_attention(q, k, v, qi, ki, wi, q_pos, topk):
    B, T = q.shape[0], q.shape[1]
    S = k.shape[1]
    qb = min(QUERY_BLOCK, T)
    nb = T // qb
    key_chunk = jnp.arange(S, dtype=jnp.int32) // CHUNK
    ki32 = ki.astype(jnp.float32)
    bidx = jnp.arange(B)[:, None, None]

    def block(args):
        q_b, qi_b, wi_b, pos_b = args
        q_chunk = pos_b // CHUNK
        admit = key_chunk[None, :] <= q_chunk[:, None]
        dots = jnp.einsum('bqhd,bsd->bqhs', qi_b.astype(jnp.float32), ki32) * IDX_SCALE
        score = jnp.einsum('bqh,bqhs->bqs', wi_b.astype(jnp.float32), jax.nn.relu(dots))
        score = jnp.where(admit[None], score, -jnp.inf)
        _, idx = lax.top_k(score, topk)
        valid = (idx // CHUNK) <= q_chunk[None, :, None]
        kg = k[bidx, idx].astype(jnp.float32)
        vg = v[bidx, idx].astype(jnp.float32)
        qg = q_b.reshape(B, qb, N_KV_HEADS, GROUP, HEAD_DIM).astype(jnp.float32)
        logits = jnp.einsum('bqgrd,bqkgd->bqgrk', qg, kg) * ATTN_SCALE
        logits = jnp.where(valid[:, :, None, None, :], logits, -jnp.inf)
        p = jax.nn.softmax(logits, axis=-1)
        o = jnp.einsum('bqgrk,bqkgd->bqgrd', p, vg)
        return o.reshape(B, qb, ATTN_WIDTH).astype(q.dtype)

    def split(a):
        return jnp.moveaxis(a.reshape((B, nb, qb) + a.shape[2:]), 1, 0)

    out = lax.map(block, (split(q), split(qi), split(wi), q_pos.reshape(nb, qb)))
    return jnp.moveaxis(out, 0, 1).reshape(B, T, ATTN_WIDTH)


def trunk_layer(x, conv_state, k_past, v_past, ki_past,
                w_in, conv_w, conv_b, cln_g, cln_b, w_o, ln1_g, ln1_b,
                w_gate_up, w_down, ln2_g, ln2_b):
    B, T, _ = x.shape
    past = k_past.shape[1]
    pos = jnp.arange(T, dtype=jnp.int32) + past
    sizes = (C_CONV, C_CONV, ATTN_WIDTH, N_KV_HEADS * HEAD_DIM, N_KV_HEADS * HEAD_DIM,
             N_IDX_HEADS * IDX_DIM, IDX_DIM, N_IDX_HEADS)
    points = [sum(sizes[:i + 1]) for i in range(len(sizes) - 1)]
    h = x @ w_in
    a, g, q, k, v, qi, ki, wi = jnp.split(h, points, axis=-1)
    u = a * jax.nn.sigmoid(g)
    conv_out, new_conv = conv_mixer(u, conv_state, conv_w, conv_b, cln_g, cln_b)
    q = rope(q.reshape(B, T, N_HEADS, HEAD_DIM), pos)
    k = rope(k.reshape(B, T, N_KV_HEADS, HEAD_DIM), pos)
    v = v.reshape(B, T, N_KV_HEADS, HEAD_DIM)
    qi = rope(qi.reshape(B, T, N_IDX_HEADS, IDX_DIM), pos)
    ki = rope(ki[:, :, None, :], pos)[:, :, 0]
    wi = wi * IDX_HEAD_SCALE
    k_all = jnp.concatenate([k_past.astype(k.dtype), k], axis=1)
    v_all = jnp.concatenate([v_past.astype(v.dtype), v], axis=1)
    ki_all = jnp.concatenate([ki_past.astype(ki.dtype), ki], axis=1)
    topk = min(TOPK_MAX, k_all.shape[1] // 4)
    attn_out = dsa_attention(q, k_all, v_all, qi, ki_all, wi, pos, topk)
    mix = jnp.concatenate([conv_out, attn_out], axis=-1) @ w_o
    x = layer_norm(ALPHA * x + mix, ln1_g, ln1_b)
    gate, up = jnp.split(x @ w_gate_up, 2, axis=-1)
    ffn = (jax.nn.silu(gate) * up) @ w_down
    x = layer_norm(ALPHA * x + ffn, ln2_g, ln2_b)
    return x, k, v, ki, new_conv


def setup_inputs(seed: int = 0) -> dict:
    key = jax.random.key(seed)
    ks = jax.random.split(key, 20)

    def nrm(k, shape, s):
        return jax.random.normal(k, shape, jnp.float32) * s

    return {
        "x_prompt": nrm(ks[0], (BATCH, SEQ, D_MODEL), 1.0),
        "x_sample": nrm(ks[1], (DEC_BATCH, DEC_SEQ, D_MODEL), 1.0),
        "cache_k": nrm(ks[2], (DEPTH, DEC_BATCH, PAST_LEN, N_KV_HEADS, HEAD_DIM), 1.0),
        "cache_v": nrm(ks[3], (DEPTH, DEC_BATCH, PAST_LEN, N_KV_HEADS, HEAD_DIM), 1.0),
        "cache_k_idx": nrm(ks[4], (DEPTH, DEC_BATCH, PAST_LEN, IDX_DIM), 1.0),
        "state_conv": nrm(ks[5], (DEPTH, DEC_BATCH, CONV_WIDTH - 1, C_CONV), 0.5),
        "w_in": nrm(ks[6], (DEPTH, D_MODEL, IN_DIM), D_MODEL ** -0.5),
        "conv_w": nrm(ks[7], (DEPTH, CONV_WIDTH, C_CONV), CONV_WIDTH ** -0.5),
        "conv_b": nrm(ks[8], (DEPTH, C_CONV), 0.02),
        "conv_ln_g": 1.0 + nrm(ks[9], (DEPTH, C_CONV), 0.02),
        "conv_ln_b": nrm(ks[10], (DEPTH, C_CONV), 0.02),
        "w_o": nrm(ks[11], (DEPTH, MIX_WIDTH, D_MODEL), MIX_WIDTH ** -0.5 * BETA),
        "ln1_g": 1.0 + nrm(ks[12], (DEPTH, D_MODEL), 0.02),
        "ln1_b": nrm(ks[13], (DEPTH, D_MODEL), 0.02),
        "w_gate_up": nrm(ks[14], (DEPTH, D_MODEL, 2 * D_FF), D_MODEL ** -0.5),
        "w_down": nrm(ks[15], (DEPTH, D_FF, D_MODEL), D_FF ** -0.5 * BETA),
        "ln2_g": 1.0 + nrm(ks[16], (DEPTH, D_MODEL), 0.02),
        "ln2_b": nrm(ks[17], (DEPTH, D_MODEL), 0.02),
    }


def reference(x_prompt, x_sample, cache_k, cache_v, cache_k_idx, state_conv,
              w_in, conv_w, conv_b, conv_ln_g, conv_ln_b, w_o, ln1_g, ln1_b,
              w_gate_up, w_down, ln2_g, ln2_b):
    Bp = x_prompt.shape[0]
    dt = x_prompt.dtype
    empty_kv = jnp.zeros((Bp, 0, N_KV_HEADS, HEAD_DIM), dt)
    empty_ki = jnp.zeros((Bp, 0, IDX_DIM), dt)
    zero_conv = jnp.zeros((Bp, CONV_WIDTH - 1, C_CONV), dt)
    hp, hs = x_prompt, x_sample
    kp, vp, kip, cp = [], [], [], []
    ksl, vsl, kisl, csl = [], [], [], []
    for l in range(DEPTH):
        w = (w_in[l], conv_w[l], conv_b[l], conv_ln_g[l], conv_ln_b[l], w_o[l],
             ln1_g[l], ln1_b[l], w_gate_up[l], w_down[l], ln2_g[l], ln2_b[l])
        hp, k1, v1, ki1, c1 = trunk_layer(hp, zero_conv, empty_kv, empty_kv, empty_ki, *w)
        hs, k2, v2, ki2, c2 = trunk_layer(hs, state_conv[l], cache_k[l], cache_v[l], cache_k_idx[l], *w)
        kp.append(k1); vp.append(v1); kip.append(ki1); cp.append(c1)
        ksl.append(k2); vsl.append(v2); kisl.append(ki2); csl.append(c2)
    return (hp, hs,
            jnp.stack(kp), jnp.stack(vp), jnp.stack(kip), jnp.stack(cp),
            jnp.stack(ksl), jnp.stack(vsl), jnp.stack(kisl), jnp.stack(csl))
```

```cpp
#include <hip/hip_runtime.h>
#include <hip/hip_cooperative_groups.h>
#include <cstdio>
#include <cstdint>
namespace cg = cooperative_groups;

#ifndef MK_COOP
#define MK_COOP 0
#endif

typedef unsigned short bf16_t;
typedef short bf16x8 __attribute__((ext_vector_type(8)));
typedef float f32x4 __attribute__((ext_vector_type(4)));
typedef float f32x16 __attribute__((ext_vector_type(16)));
typedef unsigned u32x4 __attribute__((ext_vector_type(4)));

constexpr int DM = 1024, TP = 16384, TSM = 1024, TT = TP + TSM;
constexpr int NIN = 2376, NINP = 2432, DFF = 2816, NGU = 5632;
constexpr int SP = 4096, SS = 4160;
constexpr int LDS_BYTES = 4 * SS * 4 + 4 * 256 * 2;
constexpr float ALPHA = 1.4142135623730951f;
constexpr float LN_EPS = 1e-5f;

constexpr size_t O_YP = 0, O_YS = 16777216, O_KP = 17825792, O_VP = 22020096, O_KIP = 26214400, O_CP = 28311552,
                 O_KS = 28434432, O_VS = 28696576, O_KIS = 28958720, O_CS = 29089792;

struct Params {
    const float *x_prompt, *x_sample, *cache_k, *cache_v, *cache_ki, *state_conv;
    const float *w_in, *conv_w, *conv_b, *cln_g, *cln_b, *w_o, *ln1_g, *ln1_b, *w_gu, *w_dn, *ln2_g, *ln2_b;
    float* out;
    bf16_t *win_t, *wo_t, *wgu_t, *wdn_t;
    float2* trig;
    bf16_t *kp, *vp, *kip, *ks, *vs, *kis;
    bf16_t* ab;
    float* F;
    bf16_t *act, *u, *q, *qi;
    float* wi;
};

__device__ __forceinline__ unsigned pk_bf16(float lo, float hi) { unsigned r; asm volatile("v_cvt_pk_bf16_f32 %0, %1, %2" : "=v"(r) : "v"(lo), "v"(hi)); return r; }
__device__ __forceinline__ float bf_lo(unsigned v) { return __uint_as_float(v << 16); }
__device__ __forceinline__ float bf_hi(unsigned v) { return __uint_as_float(v & 0xffff0000u); }
__device__ __forceinline__ int opaque_tid() { int t = threadIdx.x; asm volatile("" : "+v"(t)); return t; }
__device__ __forceinline__ unsigned tokey(float f) { unsigned u = __float_as_uint(f); return (u & 0x80000000u) ? ~u : (u | 0x80000000u); }
__device__ __forceinline__ float sigmoidf_(float x) { return 1.0f / (1.0f + __expf(-x)); }

__device__ __forceinline__ int perm_in(int n) {
    const int g = n >> 6, w = n & 63;
    if (g < 16) return (w < 32) ? (32 * g + w) : (512 + 32 * g + (w - 32));
    const int c = 1024 + (g - 16) * 64 + w;
    return c < NIN ? c : -1;
}
__device__ __forceinline__ int perm_gu(int n) { const int g = n >> 6, w = n & 63; return (w < 32) ? (32 * g + w) : (DFF + 32 * g + (w - 32)); }

template <int MODE>
__device__ void transpose_tiles(const float* __restrict__ W, bf16_t* __restrict__ Wt, int K, int N, int Np, float* lds, int& cursor) {
    const int tk = K >> 6, tn = Np >> 6, nt = tk * tn, tid = opaque_tid();
    for (int t = 0; t < nt; ++t, ++cursor) {
        if ((cursor % (int)gridDim.x) != (int)blockIdx.x) continue;
        const int k0 = (t / tn) << 6, n0 = (t % tn) << 6;
        __syncthreads();
#pragma unroll
        for (int i = 0; i < 16; ++i) {
            const int k = i * 4 + (tid >> 6), n = tid & 63;
            int c = n0 + n; if (MODE == 1) c = perm_in(c); else if (MODE == 2) c = perm_gu(c);
            lds[k * 65 + n] = (c >= 0) ? W[(size_t)(k0 + k) * N + c] : 0.f;
        }
        __syncthreads();
#pragma unroll
        for (int i = 0; i < 8; ++i) {
            const int n = i * 8 + (tid >> 5), k = (tid & 31) * 2;
            *(unsigned*)(Wt + (size_t)(n0 + n) * K + k0 + k) = pk_bf16(lds[k * 65 + n], lds[(k + 1) * 65 + n]);
        }
    }
}

__device__ void convert_chunks(const float* __restrict__ src, bf16_t* __restrict__ dst, int nb, int chunk8  , int dst_stride8  ) {
    const int total = nb * chunk8;
    for (int i = blockIdx.x * 256 + opaque_tid(); i < total; i += gridDim.x * 256) {
        const int b = i / chunk8, r = i - b * chunk8;
        const float4 a = *(const float4*)(src + (size_t)i * 8), c = *(const float4*)(src + (size_t)i * 8 + 4);
        uint4 o; o.x = pk_bf16(a.x, a.y); o.y = pk_bf16(a.z, a.w); o.z = pk_bf16(c.x, c.y); o.w = pk_bf16(c.z, c.w);
        *(uint4*)(dst + ((size_t)b * dst_stride8 + r) * 8) = o;
    }
}
__device__ void convert_cache(const Params& p, int l) {
    convert_chunks(p.cache_k + (size_t)l * 16 * 4096 * 128, p.ks, 16, 4096 * 16, SS * 16);
    convert_chunks(p.cache_v + (size_t)l * 16 * 4096 * 128, p.vs, 16, 4096 * 16, SS * 16);
    convert_chunks(p.cache_ki + (size_t)l * 16 * 4096 * 64, p.kis, 16, 4096 * 8, SS * 8);
}

__device__ void phase0(const Params& p, unsigned char* lds) {
    int cursor = 0;
    for (int l = 0; l < 2; ++l) {
        transpose_tiles<1>(p.w_in + (size_t)l * DM * NIN, p.win_t + (size_t)l * NINP * DM, DM, NIN, NINP, (float*)lds, cursor);
        transpose_tiles<0>(p.w_o + (size_t)l * DM * DM, p.wo_t + (size_t)l * DM * DM, DM, DM, DM, (float*)lds, cursor);
        transpose_tiles<2>(p.w_gu + (size_t)l * DM * NGU, p.wgu_t + (size_t)l * NGU * DM, DM, NGU, NGU, (float*)lds, cursor);
        transpose_tiles<0>(p.w_dn + (size_t)l * DFF * DM, p.wdn_t + (size_t)l * DM * DFF, DFF, DM, DM, (float*)lds, cursor);
    }
    __syncthreads();
    convert_chunks(p.x_prompt, p.ab, 1, TP * 128, TP * 128);
    convert_chunks(p.x_sample, p.ab + (size_t)TP * DM, 1, TSM * 128, TSM * 128);
    convert_cache(p, 0);
    for (int i = blockIdx.x * 256 + opaque_tid(); i < SS * 32; i += gridDim.x * 256) {
        const int pos = i >> 5, f = i & 31;
        const float inv = exp2f(-(float)f * (13.287712379549449f / 32.0f));
        const float angf = (float)pos * inv;
        const double rev = (double)angf * 0.15915494309189535;
        const double fr = rev - __builtin_rint(rev);
        const float ang = (float)(fr * 6.283185307179586);
        p.trig[i] = make_float2(__cosf(ang), __sinf(ang));
    }
}

template <class Epi>
__device__ __forceinline__ void gemm_tile(const bf16_t* __restrict__ A, const bf16_t* __restrict__ Bt, int K, int row0, int col0, unsigned char* lds, const Epi& epi) {
    const int tid = opaque_tid(), lane = tid & 63, wid = tid >> 6, wr = wid >> 1, wc = wid & 1, fr = lane & 15, fq = lane >> 4;
    const int sc = tid & 7, sr = tid >> 3;
    const bf16_t* ag = A + (size_t)(row0 + sr) * K + sc * 8;
    const bf16_t* bg = Bt + (size_t)(col0 + sr) * K + sc * 8;
    u32x4 ra[4], rb[4];
    f32x4 acc[4][4];
#pragma unroll
    for (int m = 0; m < 4; ++m)
#pragma unroll
        for (int n = 0; n < 4; ++n) acc[m][n] = (f32x4){0.f, 0.f, 0.f, 0.f};
    const int soff = sr * 128 + ((sc ^ ((sr >> 1) & 7)) << 4);
    const int nk = K >> 6;
#pragma unroll
    for (int i = 0; i < 4; ++i) { ra[i] = *(const u32x4*)(ag + (size_t)i * 32 * K); rb[i] = *(const u32x4*)(bg + (size_t)i * 32 * K); }
    __syncthreads();
#pragma unroll
    for (int i = 0; i < 4; ++i) { *(u32x4*)(lds + soff + i * 4096) = ra[i]; *(u32x4*)(lds + 16384 + soff + i * 4096) = rb[i]; }
    __syncthreads();
    const int swz = (fr >> 1) & 7;
    for (int kt = 0; kt < nk; ++kt) {
        if (kt + 1 < nk) {
#pragma unroll
            for (int i = 0; i < 4; ++i) { ra[i] = *(const u32x4*)(ag + (size_t)i * 32 * K + (kt + 1) * 64); rb[i] = *(const u32x4*)(bg + (size_t)i * 32 * K + (kt + 1) * 64); }
        }
        const unsigned char* ba = lds + (kt & 1) * 32768;
        const unsigned char* bb = ba + 16384;
#pragma unroll
        for (int ks = 0; ks < 2; ++ks) {
            bf16x8 af[4], bfr[4];
            const int ch = ((ks * 4 + fq) ^ swz) << 4;
#pragma unroll
            for (int m = 0; m < 4; ++m) af[m] = *(const bf16x8*)(ba + (wr * 64 + m * 16 + fr) * 128 + ch);
#pragma unroll
            for (int n = 0; n < 4; ++n) bfr[n] = *(const bf16x8*)(bb + (wc * 64 + n * 16 + fr) * 128 + ch);
#pragma unroll
            for (int m = 0; m < 4; ++m)
#pragma unroll
                for (int n = 0; n < 4; ++n) acc[m][n] = __builtin_amdgcn_mfma_f32_16x16x32_bf16(bfr[n], af[m], acc[m][n], 0, 0, 0);
        }
        if (kt + 1 < nk) {
            unsigned char* d = lds + ((kt + 1) & 1) * 32768;
#pragma unroll
            for (int i = 0; i < 4; ++i) { *(u32x4*)(d + soff + i * 4096) = ra[i]; *(u32x4*)(d + 16384 + soff + i * 4096) = rb[i]; }
        }
        __syncthreads();
    }
    epi(acc, row0 + wr * 64, col0 + wc * 64, fr, fq);
}

template <class Epi>
__device__ void gemm_phase(const bf16_t* A, const bf16_t* Bt, int K, int nN, unsigned char* lds, const Epi& epi) {
    const int nt = (TT / 128) * nN;
    for (int t = blockIdx.x; t < nt; t += gridDim.x) {
        const int mt = t / nN, ntile = t - mt * nN;
        gemm_tile(A, Bt, K, mt * 128, ntile * 128, lds, epi);
    }
}

__device__ __forceinline__ void tok_decode(int row, bool& isS, int& b, int& t, int& pos) {
    isS = row >= TP;
    if (!isS) { b = row >> 12; t = row & 4095; pos = t; } else { const int r = row - TP; b = r >> 6; t = r & 63; pos = 4096 + t; }
}

struct EpiIn {
    Params p; int l;
    __device__ __forceinline__ void operator()(f32x4 (&acc)[4][4], int rbase, int cbase, int fr, int fq) const {
        const int G = cbase >> 6;
#pragma unroll
        for (int m = 0; m < 4; ++m) {
            const int row = rbase + m * 16 + fr;
            bool isS; int b, t, pos; tok_decode(row, isS, b, t, pos);
            if (G < 16) {
                const int tl = isS ? t - 34 : t - 4066;
#pragma unroll
                for (int n = 0; n < 2; ++n) {
                    const int ch = 32 * G + n * 16 + fq * 4;
                    float u[4];
#pragma unroll
                    for (int j = 0; j < 4; ++j) u[j] = acc[m][n][j] * sigmoidf_(acc[m][n + 2][j]);
                    uint2 w; w.x = pk_bf16(u[0], u[1]); w.y = pk_bf16(u[2], u[3]);
                    *(uint2*)(p.u + (size_t)row * 512 + ch) = w;
                    if (tl >= 0) {
                        float* o = p.out + (isS ? O_CS + ((size_t)(l * 16 + b) * 30 + tl) * 512 : O_CP + ((size_t)(l * 4 + b) * 30 + tl) * 512) + ch;
                        *(float4*)o = make_float4(u[0], u[1], u[2], u[3]);
                    }
                }
            } else if (G == 26 || G == 27) {
                const int kvh = G - 26;
                float* o = p.out + (isS ? O_VS + (((size_t)(l * 16 + b) * 64 + t) * 2 + kvh) * 64 : O_VP + (((size_t)(l * 4 + b) * 4096 + t) * 2 + kvh) * 64);
                bf16_t* vb = (isS ? p.vs + ((size_t)b * SS + 4096 + t) * 128 : p.vp + ((size_t)b * SP + t) * 128) + kvh * 64;
#pragma unroll
                for (int n = 0; n < 4; ++n) {
                    const int d = n * 16 + fq * 4;
                    *(float4*)(o + d) = make_float4(acc[m][n][0], acc[m][n][1], acc[m][n][2], acc[m][n][3]);
                    uint2 w; w.x = pk_bf16(acc[m][n][0], acc[m][n][1]); w.y = pk_bf16(acc[m][n][2], acc[m][n][3]);
                    *(uint2*)(vb + d) = w;
                }
            } else if (G == 37) {
                if (fq < 2) {
                    const float s = 0.35355339059327373f * 0.125f;
                    *(float4*)(p.wi + (size_t)row * 8 + fq * 4) = make_float4(acc[m][0][0] * s, acc[m][0][1] * s, acc[m][0][2] * s, acc[m][0][3] * s);
                }
            } else {
                float o1[2][4], o2[2][4];
#pragma unroll
                for (int n = 0; n < 2; ++n) {
                    const float4* tp = (const float4*)(p.trig + (size_t)pos * 32 + n * 16 + fq * 4);
                    const float4 t0 = tp[0], t1 = tp[1];
                    const float cs[4] = {t0.x, t0.z, t1.x, t1.z}, sn[4] = {t0.y, t0.w, t1.y, t1.w};
#pragma unroll
                    for (int j = 0; j < 4; ++j) {
                        const float x1 = acc[m][n][j], x2 = acc[m][n + 2][j];
                        o1[n][j] = x1 * cs[j] - x2 * sn[j];
                        o2[n][j] = x2 * cs[j] + x1 * sn[j];
                    }
                }
                if (G < 24 || (G >= 28 && G < 36)) {
                    const bool isq = G < 24;
                    const float s = isq ? 0.125f * 1.4426950408889634f : 1.0f;
                    bf16_t* dst = (isq ? p.q + (size_t)row * 512 + (G - 16) * 64 : p.qi + (size_t)row * 512 + (G - 28) * 64);
#pragma unroll
                    for (int n = 0; n < 2; ++n) {
                        const int d = n * 16 + fq * 4;
                        uint2 w; w.x = pk_bf16(o1[n][0] * s, o1[n][1] * s); w.y = pk_bf16(o1[n][2] * s, o1[n][3] * s);
                        *(uint2*)(dst + d) = w;
                        w.x = pk_bf16(o2[n][0] * s, o2[n][1] * s); w.y = pk_bf16(o2[n][2] * s, o2[n][3] * s);
                        *(uint2*)(dst + d + 32) = w;
                    }
                } else if (G == 24 || G == 25) {
                    const int kvh = G - 24;
                    float* o = p.out + (isS ? O_KS + (((size_t)(l * 16 + b) * 64 + t) * 2 + kvh) * 64 : O_KP + (((size_t)(l * 4 + b) * 4096 + t) * 2 + kvh) * 64);
                    bf16_t* kb = (isS ? p.ks + ((size_t)b * SS + 4096 + t) * 128 : p.kp + ((size_t)b * SP + t) * 128) + kvh * 64;
#pragma unroll
                    for (int n = 0; n < 2; ++n) {
                        const int d = n * 16 + fq * 4;
                        *(float4*)(o + d) = make_float4(o1[n][0], o1[n][1], o1[n][2], o1[n][3]);
                        *(float4*)(o + d + 32) = make_float4(o2[n][0], o2[n][1], o2[n][2], o2[n][3]);
                        uint2 w; w.x = pk_bf16(o1[n][0], o1[n][1]); w.y = pk_bf16(o1[n][2], o1[n][3]);
                        *(uint2*)(kb + d) = w;
                        w.x = pk_bf16(o2[n][0], o2[n][1]); w.y = pk_bf16(o2[n][2], o2[n][3]);
                        *(uint2*)(kb + d + 32) = w;
                    }
                } else {
                    float* o = p.out + (isS ? O_KIS + ((size_t)(l * 16 + b) * 64 + t) * 64 : O_KIP + ((size_t)(l * 4 + b) * 4096 + t) * 64);
                    bf16_t* kb = (isS ? p.kis + ((size_t)b * SS + 4096 + t) * 64 : p.kip + ((size_t)b * SP + t) * 64);
#pragma unroll
                    for (int n = 0; n < 2; ++n) {
                        const int d = n * 16 + fq * 4;
                        *(float4*)(o + d) = make_float4(o1[n][0], o1[n][1], o1[n][2], o1[n][3]);
                        *(float4*)(o + d + 32) = make_float4(o2[n][0], o2[n][1], o2[n][2], o2[n][3]);
                        uint2 w; w.x = pk_bf16(o1[n][0], o1[n][1]); w.y = pk_bf16(o1[n][2], o1[n][3]);
                        *(uint2*)(kb + d) = w;
                        w.x = pk_bf16(o2[n][0], o2[n][1]); w.y = pk_bf16(o2[n][2], o2[n][3]);
                        *(uint2*)(kb + d + 32) = w;
                    }
                }
            }
        }
    }
};

struct EpiWo {
    Params p; int l;
    __device__ __forceinline__ void operator()(f32x4 (&acc)[4][4], int rbase, int cbase, int fr, int fq) const {
#pragma unroll
        for (int m = 0; m < 4; ++m) {
            const int row = rbase + m * 16 + fr;
            const float* xr = (l == 0) ? ((row < TP) ? p.x_prompt + (size_t)row * DM : p.x_sample + (size_t)(row - TP) * DM) : p.F + (size_t)row * DM;
            float* fo = p.F + (size_t)row * DM;
#pragma unroll
            for (int n = 0; n < 4; ++n) {
                const int c = cbase + n * 16 + fq * 4;
                const float4 x = *(const float4*)(xr + c);
                *(float4*)(fo + c) = make_float4(ALPHA * x.x + acc[m][n][0], ALPHA * x.y + acc[m][n][1], ALPHA * x.z + acc[m][n][2], ALPHA * x.w + acc[m][n][3]);
            }
        }
    }
};
struct EpiGu {
    Params p;
    __device__ __forceinline__ void operator()(f32x4 (&acc)[4][4], int rbase, int cbase, int fr, int fq) const {
        const int G = cbase >> 6;
#pragma unroll
        for (int m = 0; m < 4; ++m) {
            const int row = rbase + m * 16 + fr;
#pragma unroll
            for (int n = 0; n < 2; ++n) {
                float a[4];
#pragma unroll
                for (int j = 0; j < 4; ++j) { const float g = acc[m][n][j]; a[j] = g * sigmoidf_(g) * acc[m][n + 2][j]; }
                uint2 w; w.x = pk_bf16(a[0], a[1]); w.y = pk_bf16(a[2], a[3]);
                *(uint2*)(p.act + (size_t)row * DFF + 32 * G + n * 16 + fq * 4) = w;
            }
        }
    }
};
struct EpiDn {
    Params p;
    __device__ __forceinline__ void operator()(f32x4 (&acc)[4][4], int rbase, int cbase, int fr, int fq) const {
#pragma unroll
        for (int m = 0; m < 4; ++m) {
            float* fo = p.F + (size_t)(rbase + m * 16 + fr) * DM;
#pragma unroll
            for (int n = 0; n < 4; ++n) {
                const int c = cbase + n * 16 + fq * 4;
                const float4 x = *(const float4*)(fo + c);
                *(float4*)(fo + c) = make_float4(ALPHA * x.x + acc[m][n][0], ALPHA * x.y + acc[m][n][1], ALPHA * x.z + acc[m][n][2], ALPHA * x.w + acc[m][n][3]);
            }
        }
    }
};

__device__ void ln_phase(const Params& p, int l, int which) {
    const int tid = opaque_tid(), lane = tid & 63, wid = tid >> 6;
    const float* g = (which == 1 ? p.ln1_g : p.ln2_g) + l * DM;
    const float* bb = (which == 1 ? p.ln1_b : p.ln2_b) + l * DM;
    const bool fin = (which == 2 && l == 1);
    for (int row = blockIdx.x * 4 + wid; row < TT; row += gridDim.x * 4) {
        float* fr = p.F + (size_t)row * DM;
        float4 v[4];
        float s = 0.f;
#pragma unroll
        for (int i = 0; i < 4; ++i) { v[i] = *(const float4*)(fr + i * 256 + lane * 4); s += (v[i].x + v[i].y) + (v[i].z + v[i].w); }
#pragma unroll
        for (int o = 32; o >= 1; o >>= 1) s += __shfl_xor(s, o);
        const float mean = s * (1.0f / 1024.0f);
        float q = 0.f;
#pragma unroll
        for (int i = 0; i < 4; ++i) { const float a = v[i].x - mean, b = v[i].y - mean, c = v[i].z - mean, d = v[i].w - mean; q += (a * a + b * b) + (c * c + d * d); }
#pragma unroll
        for (int o = 32; o >= 1; o >>= 1) q += __shfl_xor(q, o);
        const float rstd = rsqrtf(q * (1.0f / 1024.0f) + LN_EPS);
#pragma unroll
        for (int i = 0; i < 4; ++i) {
            const int c = i * 256 + lane * 4;
            const float4 gg = *(const float4*)(g + c), be = *(const float4*)(bb + c);
            const float4 o = make_float4((v[i].x - mean) * rstd * gg.x + be.x, (v[i].y - mean) * rstd * gg.y + be.y, (v[i].z - mean) * rstd * gg.z + be.z, (v[i].w - mean) * rstd * gg.w + be.w);
            if (fin) *(float4*)(p.out + (size_t)row * DM + c) = o;
            else {
                *(float4*)(fr + c) = o;
                uint2 w; w.x = pk_bf16(o.x, o.y); w.y = pk_bf16(o.z, o.w);
                *(uint2*)(p.ab + (size_t)row * DM + c) = w;
            }
        }
    }
}

__device__ void conv_unit(const Params& p, int l, int cu, unsigned char* lds) {
    const int tid = opaque_tid(), lane = tid & 63, wid = tid >> 6;
    const int row0 = cu * 32;
    bool isS; int b, t0, pos; tok_decode(row0, isS, b, t0, pos);
    const int seq_row0 = row0 - t0;
    unsigned* xs = (unsigned*)lds;
    float* red = (float*)(lds + 62 * 1024);
    const unsigned* ug = (const unsigned*)p.u;
    __syncthreads();
#pragma unroll 2
    for (int i = 0; i < 62; ++i) {
        const int tok = t0 - 30 + i;
        unsigned v = 0u;
        if (tok >= 0) v = ug[(size_t)(seq_row0 + tok) * 256 + tid];
        else if (isS) { const float2 s = *(const float2*)(p.state_conv + ((size_t)(l * 16 + b) * 30 + (30 + tok)) * 512 + 2 * tid); v = pk_bf16(s.x, s.y); }
        xs[i * 256 + tid] = v;
    }
    float cw0[31], cw1[31];
#pragma unroll
    for (int w = 0; w < 31; ++w) { const float2 c = *(const float2*)(p.conv_w + ((size_t)l * 31 + w) * 512 + 2 * tid); cw0[w] = c.x; cw1[w] = c.y; }
    const float2 cb = *(const float2*)(p.conv_b + l * 512 + 2 * tid);
#pragma unroll 1
    for (int t = 0; t < 32; ++t) {
        float a0 = cb.x, a1 = cb.y;
        const unsigned* xr = xs + t * 256 + tid;
#pragma unroll
        for (int w = 0; w < 31; ++w) { const unsigned v = xr[w * 256]; a0 += bf_lo(v) * cw0[w]; a1 += bf_hi(v) * cw1[w]; }
        float s = a0 + a1, q = a0 * a0 + a1 * a1;
#pragma unroll
        for (int o = 32; o >= 1; o >>= 1) { s += __shfl_xor(s, o); q += __shfl_xor(q, o); }
        if (lane == 0) { red[(wid * 32 + t) * 2] = s; red[(wid * 32 + t) * 2 + 1] = q; }
        xs[t * 256 + tid] = pk_bf16(a0, a1);
    }
    __syncthreads();
    const float2 lg = *(const float2*)(p.cln_g + l * 512 + 2 * tid);
    const float2 lb = *(const float2*)(p.cln_b + l * 512 + 2 * tid);
#pragma unroll 4
    for (int t = 0; t < 32; ++t) {
        const float s = (red[t * 2] + red[(32 + t) * 2]) + (red[(64 + t) * 2] + red[(96 + t) * 2]);
        const float q = (red[t * 2 + 1] + red[(32 + t) * 2 + 1]) + (red[(64 + t) * 2 + 1] + red[(96 + t) * 2 + 1]);
        const float mean = s * (1.0f / 512.0f);
        const float var = fmaxf(q * (1.0f / 512.0f) - mean * mean, 0.f);
        const float rstd = rsqrtf(var + LN_EPS);
        const unsigned v = xs[t * 256 + tid];
        float a = (bf_lo(v) - mean) * rstd * lg.x + lb.x, c = (bf_hi(v) - mean) * rstd * lg.y + lb.y;
        a = a * sigmoidf_(a); c = c * sigmoidf_(c);
        *(unsigned*)(p.ab + (size_t)(row0 + t) * DM + 2 * tid) = pk_bf16(a, c);
    }
    __syncthreads();
}

__device__ void attn_unit(const Params& p, int isS, int b, int t0, unsigned char* lds) {
    const int tid = opaque_tid(), lane = tid & 63, wid = tid >> 6, r = lane & 31, hh = lane >> 5;
    unsigned* sc = (unsigned*)lds;
    unsigned short* idxl = (unsigned short*)(lds + 4 * SS * 4) + wid * 256;
    const int row0 = isS ? TP + b * 64 + t0 : b * 4096 + t0;
    const int S = isS ? SS : ((t0 >> 6) + 1) * 64;
    const bf16_t* KI = isS ? p.kis + (size_t)b * SS * 64 : p.kip + (size_t)b * SP * 64;
    const bf16_t* Kc = isS ? p.ks + (size_t)b * SS * 128 : p.kp + (size_t)b * SP * 128;
    const bf16_t* Vc = isS ? p.vs + (size_t)b * SS * 128 : p.vp + (size_t)b * SP * 128;
    __syncthreads();
    {
        bf16x8 qf[4];
#pragma unroll
        for (int ks = 0; ks < 4; ++ks) qf[ks] = *(const bf16x8*)(p.qi + (size_t)(row0 + (r >> 3)) * 512 + (r & 7) * 64 + ks * 16 + hh * 8);
        float w[4][4];
#pragma unroll
        for (int q = 0; q < 4; ++q) { const float4 t = *(const float4*)(p.wi + (size_t)(row0 + q) * 8 + 4 * hh); w[q][0] = t.x; w[q][1] = t.y; w[q][2] = t.z; w[q][3] = t.w; }
        const int ntile = S >> 5;
        for (int kt = wid; kt < ntile; kt += 4) {
            const bf16_t* kr = KI + (size_t)(kt * 32 + r) * 64 + hh * 8;
            bf16x8 kf[4];
#pragma unroll
            for (int ks = 0; ks < 4; ++ks) kf[ks] = *(const bf16x8*)(kr + ks * 16);
            f32x16 d;
#pragma unroll
            for (int i = 0; i < 16; ++i) d[i] = 0.f;
#pragma unroll
            for (int ks = 0; ks < 4; ++ks) d = __builtin_amdgcn_mfma_f32_32x32x16_bf16(qf[ks], kf[ks], d, 0, 0, 0);
            float s[4];
#pragma unroll
            for (int q = 0; q < 4; ++q) {
                s[q] = (w[q][0] * fmaxf(d[4 * q], 0.f) + w[q][1] * fmaxf(d[4 * q + 1], 0.f)) + (w[q][2] * fmaxf(d[4 * q + 2], 0.f) + w[q][3] * fmaxf(d[4 * q + 3], 0.f));
                s[q] += __shfl_xor(s[q], 32);
                s[q] += 0.0f;
            }
            const float a0 = hh ? s[2] : s[0], a1 = hh ? s[3] : s[1];
            sc[(hh * 2) * SS + kt * 32 + r] = tokey(a0);
            sc[(hh * 2 + 1) * SS + kt * 32 + r] = tokey(a1);
        }
    }
    __syncthreads();
    const int Ksel = S < 256 ? S : 256;
    if (S <= 256) {
        for (int i = lane; i < S; i += 64) idxl[i] = (unsigned short)i;
    } else {
        unsigned key[65];
        const unsigned* myr = sc + wid * SS;
        const int nslot = S >> 6;
#pragma unroll
        for (int s = 0; s < 65; ++s) key[s] = (s < nslot) ? myr[s * 64 + lane] : 0u;
        unsigned P = 0; bool exact = false;
        for (int bit = 31; bit >= 0; --bit) {
            const unsigned C = P | (1u << bit);
            int cnt = 0;
#pragma unroll
            for (int s = 0; s < 65; ++s) cnt += __builtin_popcountll(__ballot(key[s] >= C));
            if (cnt >= 256) { P = C; if (cnt == 256) { exact = true; break; } }
        }
        const unsigned Tg = exact ? P - 1u : P;
        const unsigned long long lt = (1ull << lane) - 1ull;
        int base = 0;
#pragma unroll
        for (int s = 0; s < 65; ++s) {
            const bool g = key[s] > Tg;
            const unsigned long long m = __ballot(g);
            if (g) idxl[base + __builtin_popcountll(m & lt)] = (unsigned short)(s * 64 + lane);
            base += __builtin_popcountll(m);
        }
        const int need = 256 - base;
        if (need > 0) {
            int tb = 0;
#pragma unroll
            for (int s = 0; s < 65; ++s) {
                const bool e = (key[s] == Tg) && (s < nslot);
                const unsigned long long m = __ballot(e);
                const int rk = tb + __builtin_popcountll(m & lt);
                if (e && rk < need) idxl[base + rk] = (unsigned short)(s * 64 + lane);
                tb += __builtin_popcountll(m);
            }
        }
    }
    __syncthreads();
    const int row = row0 + wid;
    float* Pl = (float*)(sc + wid * SS);
    {
        bf16x8 qa[8];
#pragma unroll
        for (int ks = 0; ks < 8; ++ks) {
            const int kk = ks * 16 + hh * 8, g = kk >> 6, d = kk & 63;
            const bool valid = (r < 8) && ((r >> 2) == g);
            bf16x8 z;
#pragma unroll
            for (int j = 0; j < 8; ++j) z[j] = 0;
            qa[ks] = valid ? *(const bf16x8*)(p.q + (size_t)row * 512 + r * 64 + d) : z;
        }
#pragma unroll 1
        for (int tile = 0; tile < 8; ++tile) {
            const int key = tile * 32 + r;
            const int id = (key < Ksel) ? (int)idxl[key] : 0;
            const bf16_t* kr = Kc + (size_t)id * 128 + hh * 8;
            bf16x8 kf[8];
#pragma unroll
            for (int ks = 0; ks < 8; ++ks) kf[ks] = *(const bf16x8*)(kr + ks * 16);
            f32x16 d;
#pragma unroll
            for (int i = 0; i < 16; ++i) d[i] = 0.f;
#pragma unroll
            for (int ks = 0; ks < 8; ++ks) d = __builtin_amdgcn_mfma_f32_32x32x16_bf16(qa[ks], kf[ks], d, 0, 0, 0);
            const bool ok = key < Ksel;
            *(float4*)(Pl + key * 8 + 4 * hh) = make_float4(ok ? d[0] : -INFINITY, ok ? d[1] : -INFINITY, ok ? d[2] : -INFINITY, ok ? d[3] : -INFINITY);
        }
    }
    {
        float lg[8][4];
#pragma unroll
        for (int tile = 0; tile < 8; ++tile) { const float4 t = *(const float4*)(Pl + (tile * 32 + r) * 8 + 4 * hh); lg[tile][0] = t.x; lg[tile][1] = t.y; lg[tile][2] = t.z; lg[tile][3] = t.w; }
#pragma unroll
        for (int i = 0; i < 4; ++i) {
            float mx = lg[0][i];
#pragma unroll
            for (int tile = 1; tile < 8; ++tile) mx = fmaxf(mx, lg[tile][i]);
#pragma unroll
            for (int o = 16; o >= 1; o >>= 1) mx = fmaxf(mx, __shfl_xor(mx, o));
            float sm = 0.f;
#pragma unroll
            for (int tile = 0; tile < 8; ++tile) { lg[tile][i] = exp2f(lg[tile][i] - mx); sm += lg[tile][i]; }
#pragma unroll
            for (int o = 16; o >= 1; o >>= 1) sm += __shfl_xor(sm, o);
            const float inv = 1.0f / sm;
#pragma unroll
            for (int tile = 0; tile < 8; ++tile) lg[tile][i] *= inv;
        }
#pragma unroll
        for (int tile = 0; tile < 8; ++tile) *(float4*)(Pl + (tile * 32 + r) * 8 + 4 * hh) = make_float4(lg[tile][0], lg[tile][1], lg[tile][2], lg[tile][3]);
    }
    __syncthreads();
    {
        const int g = lane >> 5;
        float o0[4] = {0.f, 0.f, 0.f, 0.f}, o1[4] = {0.f, 0.f, 0.f, 0.f};
        for (int k0 = 0; k0 < Ksel; k0 += 8) {
            unsigned vv[8];
#pragma unroll
            for (int j = 0; j < 8; ++j) { const int id = idxl[k0 + j]; vv[j] = *(const unsigned*)(Vc + (size_t)id * 128 + 2 * lane); }
#pragma unroll
            for (int j = 0; j < 8; ++j) {
                const float4 pp = *(const float4*)(Pl + (k0 + j) * 8 + 4 * g);
                const float v0 = bf_lo(vv[j]), v1 = bf_hi(vv[j]);
                o0[0] += pp.x * v0; o1[0] += pp.x * v1; o0[1] += pp.y * v0; o1[1] += pp.y * v1;
                o0[2] += pp.z * v0; o1[2] += pp.z * v1; o0[3] += pp.w * v0; o1[3] += pp.w * v1;
            }
        }
#pragma unroll
        for (int i = 0; i < 4; ++i) *(unsigned*)(p.ab + (size_t)row * DM + 512 + (4 * g + i) * 64 + 2 * (lane & 31)) = pk_bf16(o0[i], o1[i]);
    }
}

__device__ void mixer_phase(const Params& p, int l, unsigned char* lds) {
    const int G = gridDim.x;
    {
        const int NU = 4352;
        for (int rd = 0; rd * G < NU; ++rd) {
            const int i = rd * G + ((rd & 1) ? (G - 1 - (int)blockIdx.x) : (int)blockIdx.x);
            if (i >= NU) continue;
            int isS, b, t0;
            if (i < 256) { isS = 1; b = i >> 4; t0 = (i & 15) * 4; }
            else { const int j = i - 256, c = 63 - (j >> 6), rr = j & 63; isS = 0; b = rr >> 4; t0 = c * 64 + (rr & 15) * 4; }
            attn_unit(p, isS, b, t0, lds);
        }
    }
    __syncthreads();
    for (int i = G - 1 - (int)blockIdx.x; i < 544; i += G) conv_unit(p, l, i, lds);
}

__device__ void run_phase(const Params& p, int ph, unsigned char* lds) {
#ifndef TEST_K
    if (ph == 0) { phase0(p, lds); return; }
#else
    if (TEST_K == 7) { phase0(p, lds); return; }
#endif
    const int l = (ph - 1) / 7, k = (ph - 1) % 7;
#ifdef TEST_K
    if (k != TEST_K) return;
#endif
    switch (k) {
        case 0: { EpiIn e{p, l}; gemm_phase(p.ab, p.win_t + (size_t)l * NINP * DM, DM, NINP / 128, lds, e); } break;
        case 1: mixer_phase(p, l, lds); break;
        case 2: { EpiWo e{p, l}; gemm_phase(p.ab, p.wo_t + (size_t)l * DM * DM, DM, DM / 128, lds, e); } break;
        case 3: ln_phase(p, l, 1); if (l == 0) convert_cache(p, 1); break;
        case 4: { EpiGu e{p}; gemm_phase(p.ab, p.wgu_t + (size_t)l * NGU * DM, DM, NGU / 128, lds, e); } break;
        case 5: { EpiDn e{p}; gemm_phase(p.act, p.wdn_t + (size_t)l * DM * DFF, DFF, DM / 128, lds, e); } break;
        case 6: ln_phase(p, l, 2); break;
    }
}

__global__ void __launch_bounds__(256, 2) mk(Params p, int ph_lo, int ph_hi) {
    extern __shared__ __attribute__((aligned(16))) unsigned char lds[];
#if MK_COOP
    cg::grid_group grid = cg::this_grid();
#endif
    for (int ph = ph_lo; ph < ph_hi; ++ph) {
        run_phase(p, ph, lds);
#if MK_COOP
        if (ph + 1 < ph_hi) grid.sync();
#endif
    }
}

static inline size_t al256(size_t x) { return (x + 255) & ~(size_t)255; }

extern "C" void kernel_launch(void* const* d_in, const int* in_sizes, int n_in, void* d_out, int out_size, void* d_ws, size_t ws_size, hipStream_t stream) {
    static int grid = 0;
    if (grid == 0) {
        int dev = 0, cus = 0, per_cu = 0;
        hipGetDevice(&dev);
        hipDeviceGetAttribute(&cus, hipDeviceAttributeMultiprocessorCount, dev);
        if (hipFuncSetAttribute((const void*)mk, hipFuncAttributeMaxDynamicSharedMemorySize, LDS_BYTES) != hipSuccess) { fprintf(stderr, "hipFuncSetAttribute failed\n"); grid = -1; return; }
        hipOccupancyMaxActiveBlocksPerMultiprocessor(&per_cu, (const void*)mk, 256, LDS_BYTES);
        if (per_cu < 1) { fprintf(stderr, "occupancy query says %d\n", per_cu); grid = -1; return; }
        if (per_cu > 2) per_cu = 2;
        grid = cus * per_cu;
        fprintf(stderr, "grid %d (cus %d x %d)\n", grid, cus, per_cu);
    }
    if (grid < 0) return;
    Params p{};
    const float* const* in = (const float* const*)d_in;
    p.x_prompt = in[0]; p.x_sample = in[1]; p.cache_k = in[2]; p.cache_v = in[3]; p.cache_ki = in[4]; p.state_conv = in[5];
    p.w_in = in[6]; p.conv_w = in[7]; p.conv_b = in[8]; p.cln_g = in[9]; p.cln_b = in[10]; p.w_o = in[11]; p.ln1_g = in[12]; p.ln1_b = in[13];
    p.w_gu = in[14]; p.w_dn = in[15]; p.ln2_g = in[16]; p.ln2_b = in[17];
    p.out = (float*)d_out;
    unsigned char* w = (unsigned char*)d_ws; size_t off = 0;
    auto take = [&](size_t bytes) { unsigned char* r = w + off; off = al256(off + bytes); return r; };
    p.win_t = (bf16_t*)take((size_t)2 * NINP * DM * 2);
    p.wo_t = (bf16_t*)take((size_t)2 * DM * DM * 2);
    p.wgu_t = (bf16_t*)take((size_t)2 * NGU * DM * 2);
    p.wdn_t = (bf16_t*)take((size_t)2 * DM * DFF * 2);
    p.trig = (float2*)take((size_t)SS * 32 * 8);
    p.kp = (bf16_t*)take((size_t)4 * SP * 128 * 2); p.vp = (bf16_t*)take((size_t)4 * SP * 128 * 2); p.kip = (bf16_t*)take((size_t)4 * SP * 64 * 2);
    p.ks = (bf16_t*)take((size_t)16 * SS * 128 * 2); p.vs = (bf16_t*)take((size_t)16 * SS * 128 * 2); p.kis = (bf16_t*)take((size_t)16 * SS * 64 * 2);
    p.ab = (bf16_t*)take((size_t)TT * DM * 2);
    p.F = (float*)take((size_t)TT * DM * 4);
    unsigned char* big = take((size_t)TT * DFF * 2);
    p.act = (bf16_t*)big;
    p.u = (bf16_t*)big; p.q = (bf16_t*)(big + (size_t)TT * 512 * 2); p.qi = (bf16_t*)(big + (size_t)2 * TT * 512 * 2); p.wi = (float*)(big + (size_t)3 * TT * 512 * 2);
    if (off > ws_size) { fprintf(stderr, "workspace too small: need %zu have %zu\n", off, ws_size); return; }
#if MK_COOP
    int lo = 0, hi = 15;
    void* args[] = {&p, &lo, &hi};
    hipError_t e = hipLaunchCooperativeKernel((const void*)mk, dim3(grid), dim3(256), args, LDS_BYTES, stream);
    if (e != hipSuccess) fprintf(stderr, "cooperative launch failed: %s (grid %d)\n", hipGetErrorString(e), grid);
#else
    for (int ph = 0; ph < 15; ++ph) hipLaunchKernelGGL(mk, dim3(grid), dim3(256), LDS_BYTES, stream, p, ph, ph + 1);
#endif
}
```

```cpp
#include <hip/hip_runtime.h>
#include <hip/hip_cooperative_groups.h>
#include <cstdio>
#include <cstdint>
namespace cg = cooperative_groups;

#ifndef MK_COOP
#define MK_COOP 1
#endif

typedef unsigned short bf16_t;
typedef short bf16x8 __attribute__((ext_vector_type(8)));
typedef float f32x4 __attribute__((ext_vector_type(4)));
typedef float f32x16 __attribute__((ext_vector_type(16)));
typedef unsigned u32x4 __attribute__((ext_vector_type(4)));

constexpr int DM = 1024, TP = 16384, TSM = 1024, TT = TP + TSM;
constexpr int NIN = 2376, NINP = 2432, DFF = 2816, NGU = 5632;
constexpr int SP = 4096, SS = 4160;
constexpr int LDS_BYTES = 4 * SS * 4 + 4 * 256 * 2;
constexpr float ALPHA = 1.4142135623730951f;
constexpr float LN_EPS = 1e-5f;

constexpr size_t O_YP = 0, O_YS = 16777216, O_KP = 17825792, O_VP = 22020096, O_KIP = 26214400, O_CP = 28311552,
                 O_KS = 28434432, O_VS = 28696576, O_KIS = 28958720, O_CS = 29089792;

struct Params {
    const float *x_prompt, *x_sample, *cache_k, *cache_v, *cache_ki, *state_conv;
    const float *w_in, *conv_w, *conv_b, *cln_g, *cln_b, *w_o, *ln1_g, *ln1_b, *w_gu, *w_dn, *ln2_g, *ln2_b;
    float* out;
    bf16_t *win_t, *wo_t, *wgu_t, *wdn_t;
    float2* trig;
    bf16_t *kp, *vp, *kip, *ks, *vs, *kis;
    bf16_t* ab;
    float* F;
    bf16_t *act, *u, *q, *qi;
    float* wi;
};

__device__ __forceinline__ unsigned pk_bf16(float lo, float hi) { unsigned r; asm volatile("v_cvt_pk_bf16_f32 %0, %1, %2" : "=v"(r) : "v"(lo), "v"(hi)); return r; }
__device__ __forceinline__ float bf_lo(unsigned v) { return __uint_as_float(v << 16); }
__device__ __forceinline__ float bf_hi(unsigned v) { return __uint_as_float(v & 0xffff0000u); }
__device__ __forceinline__ int opaque_tid() { int t = threadIdx.x; asm volatile("" : "+v"(t)); return t; }
__device__ __forceinline__ unsigned tokey(float f) { unsigned u = __float_as_uint(f); return (u & 0x80000000u) ? ~u : (u | 0x80000000u); }
__device__ __forceinline__ float sigmoidf_(float x) { return 1.0f / (1.0f + __expf(-x)); }

__device__ __forceinline__ int perm_in(int n) {
    const int g = n >> 6, w = n & 63;
    if (g < 16) return (w < 32) ? (32 * g + w) : (512 + 32 * g + (w - 32));
    const int c = 1024 + (g - 16) * 64 + w;
    return c < NIN ? c : -1;
}
__device__ __forceinline__ int perm_gu(int n) { const int g = n >> 6, w = n & 63; return (w < 32) ? (32 * g + w) : (DFF + 32 * g + (w - 32)); }

template <int MODE>
__device__ void transpose_tiles(const float* __restrict__ W, bf16_t* __restrict__ Wt, int K, int N, int Np, float* lds, int& cursor) {
    const int tk = K >> 6, tn = Np >> 6, nt = tk * tn, tid = opaque_tid();
    for (int t = 0; t < nt; ++t, ++cursor) {
        if ((cursor % (int)gridDim.x) != (int)blockIdx.x) continue;
        const int k0 = (t / tn) << 6, n0 = (t % tn) << 6;
        __syncthreads();
#pragma unroll
        for (int i = 0; i < 16; ++i) {
            const int k = i * 4 + (tid >> 6), n = tid & 63;
            int c = n0 + n; if (MODE == 1) c = perm_in(c); else if (MODE == 2) c = perm_gu(c);
            lds[k * 65 + n] = (c >= 0) ? W[(size_t)(k0 + k) * N + c] : 0.f;
        }
        __syncthreads();
#pragma unroll
        for (int i = 0; i < 8; ++i) {
            const int n = i * 8 + (tid >> 5), k = (tid & 31) * 2;
            *(unsigned*)(Wt + (size_t)(n0 + n) * K + k0 + k) = pk_bf16(lds[k * 65 + n], lds[(k + 1) * 65 + n]);
        }
    }
}

__device__ void convert_chunks(const float* __restrict__ src, bf16_t* __restrict__ dst, int nb, int chunk8  , int dst_stride8  ) {
    const int total = nb * chunk8;
    for (int i = blockIdx.x * 256 + opaque_tid(); i < total; i += gridDim.x * 256) {
        const int b = i / chunk8, r = i - b * chunk8;
        const float4 a = *(const float4*)(src + (size_t)i * 8), c = *(const float4*)(src + (size_t)i * 8 + 4);
        uint4 o; o.x = pk_bf16(a.x, a.y); o.y = pk_bf16(a.z, a.w); o.z = pk_bf16(c.x, c.y); o.w = pk_bf16(c.z, c.w);
        *(uint4*)(dst + ((size_t)b * dst_stride8 + r) * 8) = o;
    }
}
__device__ void convert_cache(const Params& p, int l) {
    convert_chunks(p.cache_k + (size_t)l * 16 * 4096 * 128, p.ks, 16, 4096 * 16, SS * 16);
    convert_chunks(p.cache_v + (size_t)l * 16 * 4096 * 128, p.vs, 16, 4096 * 16, SS * 16);
    convert_chunks(p.cache_ki + (size_t)l * 16 * 4096 * 64, p.kis, 16, 4096 * 8, SS * 8);
}

__device__ void phase0(const Params& p, unsigned char* lds) {
    int cursor = 0;
    for (int l = 0; l < 2; ++l) {
        transpose_tiles<1>(p.w_in + (size_t)l * DM * NIN, p.win_t + (size_t)l * NINP * DM, DM, NIN, NINP, (float*)lds, cursor);
        transpose_tiles<0>(p.w_o + (size_t)l * DM * DM, p.wo_t + (size_t)l * DM * DM, DM, DM, DM, (float*)lds, cursor);
        transpose_tiles<2>(p.w_gu + (size_t)l * DM * NGU, p.wgu_t + (size_t)l * NGU * DM, DM, NGU, NGU, (float*)lds, cursor);
        transpose_tiles<0>(p.w_dn + (size_t)l * DFF * DM, p.wdn_t + (size_t)l * DM * DFF, DFF, DM, DM, (float*)lds, cursor);
    }
    __syncthreads();
    convert_chunks(p.x_prompt, p.ab, 1, TP * 128, TP * 128);
    convert_chunks(p.x_sample, p.ab + (size_t)TP * DM, 1, TSM * 128, TSM * 128);
    convert_cache(p, 0);
    for (int i = blockIdx.x * 256 + opaque_tid(); i < SS * 32; i += gridDim.x * 256) {
        const int pos = i >> 5, f = i & 31;
        const float inv = exp2f(-(float)f * (13.287712379549449f / 32.0f));
        const float angf = (float)pos * inv;
        const double rev = (double)angf * 0.15915494309189535;
        const double fr = rev - __builtin_rint(rev);
        const float ang = (float)(fr * 6.283185307179586);
        p.trig[i] = make_float2(__cosf(ang), __sinf(ang));
    }
}

template <class Epi>
__device__ __forceinline__ void gemm_tile(const bf16_t* __restrict__ A, const bf16_t* __restrict__ Bt, int K, int row0, int col0, unsigned char* lds, const Epi& epi) {
    const int tid = opaque_tid(), lane = tid & 63, wid = tid >> 6, wr = wid >> 1, wc = wid & 1, fr = lane & 15, fq = lane >> 4;
    const int sc = tid & 7, sr = tid >> 3;
    const bf16_t* ag = A + (size_t)(row0 + sr) * K + sc * 8;
    const bf16_t* bg = Bt + (size_t)(col0 + sr) * K + sc * 8;
    u32x4 ra[4], rb[4];
    f32x4 acc[4][4];
#pragma unroll
    for (int m = 0; m < 4; ++m)
#pragma unroll
        for (int n = 0; n < 4; ++n) acc[m][n] = (f32x4){0.f, 0.f, 0.f, 0.f};
    const int soff = sr * 128 + ((sc ^ ((sr >> 1) & 7)) << 4);
    const int nk = K >> 6;
#pragma unroll
    for (int i = 0; i < 4; ++i) { ra[i] = *(const u32x4*)(ag + (size_t)i * 32 * K); rb[i] = *(const u32x4*)(bg + (size_t)i * 32 * K); }
    __syncthreads();
#pragma unroll
    for (int i = 0; i < 4; ++i) { *(u32x4*)(lds + soff + i * 4096) = ra[i]; *(u32x4*)(lds + 16384 + soff + i * 4096) = rb[i]; }
    __syncthreads();
    const int swz = (fr >> 1) & 7;
    for (int kt = 0; kt < nk; ++kt) {
        if (kt + 1 < nk) {
#pragma unroll
            for (int i = 0; i < 4; ++i) { ra[i] = *(const u32x4*)(ag + (size_t)i * 32 * K + (kt + 1) * 64); rb[i] = *(const u32x4*)(bg + (size_t)i * 32 * K + (kt + 1) * 64); }
        }
        const unsigned char* ba = lds + (kt & 1) * 32768;
        const unsigned char* bb = ba + 16384;
#pragma unroll
        for (int ks = 0; ks < 2; ++ks) {
            bf16x8 af[4], bfr[4];
            const int ch = ((ks * 4 + fq) ^ swz) << 4;
#pragma unroll
            for (int m = 0; m < 4; ++m) af[m] = *(const bf16x8*)(ba + (wr * 64 + m * 16 + fr) * 128 + ch);
#pragma unroll
            for (int n = 0; n < 4; ++n) bfr[n] = *(const bf16x8*)(bb + (wc * 64 + n * 16 + fr) * 128 + ch);
#pragma unroll
            for (int m = 0; m < 4; ++m)
#pragma unroll
                for (int n = 0; n < 4; ++n) acc[m][n] = __builtin_amdgcn_mfma_f32_16x16x32_bf16(bfr[n], af[m], acc[m][n], 0, 0, 0);
        }
        if (kt + 1 < nk) {
            unsigned char* d = lds + ((kt + 1) & 1) * 32768;
#pragma unroll
            for (int i = 0; i < 4; ++i) { *(u32x4*)(d + soff + i * 4096) = ra[i]; *(u32x4*)(d + 16384 + soff + i * 4096) = rb[i]; }
        }
        __syncthreads();
    }
    epi(acc, row0 + wr * 64, col0 + wc * 64, fr, fq);
}

template <class Epi>
__device__ void gemm_phase(const bf16_t* A, const bf16_t* Bt, int K, int nN, unsigned char* lds, const Epi& epi) {
    const int nt = (TT / 128) * nN;
    for (int t = blockIdx.x; t < nt; t += gridDim.x) {
        const int mt = t / nN, ntile = t - mt * nN;
        gemm_tile(A, Bt, K, mt * 128, ntile * 128, lds, epi);
    }
}

__device__ __forceinline__ void tok_decode(int row, bool& isS, int& b, int& t, int& pos) {
    isS = row >= TP;
    if (!isS) { b = row >> 12; t = row & 4095; pos = t; } else { const int r = row - TP; b = r >> 6; t = r & 63; pos = 4096 + t; }
}

struct EpiIn {
    Params p; int l;
    __device__ __forceinline__ void operator()(f32x4 (&acc)[4][4], int rbase, int cbase, int fr, int fq) const {
        const int G = cbase >> 6;
#pragma unroll
        for (int m = 0; m < 4; ++m) {
            const int row = rbase + m * 16 + fr;
            bool isS; int b, t, pos; tok_decode(row, isS, b, t, pos);
            if (G < 16) {
                const int tl = isS ? t - 34 : t - 4066;
#pragma unroll
                for (int n = 0; n < 2; ++n) {
                    const int ch = 32 * G + n * 16 + fq * 4;
                    float u[4];
#pragma unroll
                    for (int j = 0; j < 4; ++j) u[j] = acc[m][n][j] * sigmoidf_(acc[m][n + 2][j]);
                    uint2 w; w.x = pk_bf16(u[0], u[1]); w.y = pk_bf16(u[2], u[3]);
                    *(uint2*)(p.u + (size_t)row * 512 + ch) = w;
                    if (tl >= 0) {
                        float* o = p.out + (isS ? O_CS + ((size_t)(l * 16 + b) * 30 + tl) * 512 : O_CP + ((size_t)(l * 4 + b) * 30 + tl) * 512) + ch;
                        *(float4*)o = make_float4(u[0], u[1], u[2], u[3]);
                    }
                }
            } else if (G == 26 || G == 27) {
                const int kvh = G - 26;
                float* o = p.out + (isS ? O_VS + (((size_t)(l * 16 + b) * 64 + t) * 2 + kvh) * 64 : O_VP + (((size_t)(l * 4 + b) * 4096 + t) * 2 + kvh) * 64);
                bf16_t* vb = (isS ? p.vs + ((size_t)b * SS + 4096 + t) * 128 : p.vp + ((size_t)b * SP + t) * 128) + kvh * 64;
#pragma unroll
                for (int n = 0; n < 4; ++n) {
                    const int d = n * 16 + fq * 4;
                    *(float4*)(o + d) = make_float4(acc[m][n][0], acc[m][n][1], acc[m][n][2], acc[m][n][3]);
                    uint2 w; w.x = pk_bf16(acc[m][n][0], acc[m][n][1]); w.y = pk_bf16(acc[m][n][2], acc[m][n][3]);
                    *(uint2*)(vb + d) = w;
                }
            } else if (G == 37) {
                if (fq < 2) {
                    const float s = 0.35355339059327373f * 0.125f;
                    *(float4*)(p.wi + (size_t)row * 8 + fq * 4) = make_float4(acc[m][0][0] * s, acc[m][0][1] * s, acc[m][0][2] * s, acc[m][0][3] * s);
                }
            } else {
                float o1[2][4], o2[2][4];
#pragma unroll
                for (int n = 0; n < 2; ++n) {
                    const float4* tp = (const float4*)(p.trig + (size_t)pos * 32 + n * 16 + fq * 4);
                    const float4 t0 = tp[0], t1 = tp[1];
                    const float cs[4] = {t0.x, t0.z, t1.x, t1.z}, sn[4] = {t0.y, t0.w, t1.y, t1.w};
#pragma unroll
                    for (int j = 0; j < 4; ++j) {
                        const float x1 = acc[m][n][j], x2 = acc[m][n + 2][j];
                        o1[n][j] = x1 * cs[j] - x2 * sn[j];
                        o2[n][j] = x2 * cs[j] + x1 * sn[j];
                    }
                }
                if (G < 24 || (G >= 28 && G < 36)) {
                    const bool isq = G < 24;
                    const float s = isq ? 0.125f * 1.4426950408889634f : 1.0f;
                    bf16_t* dst = (isq ? p.q + (size_t)row * 512 + (G - 16) * 64 : p.qi + (size_t)row * 512 + (G - 28) * 64);
#pragma unroll
                    for (int n = 0; n < 2; ++n) {
                        const int d = n * 16 + fq * 4;
                        uint2 w; w.x = pk_bf16(o1[n][0] * s, o1[n][1] * s); w.y = pk_bf16(o1[n][2] * s, o1[n][3] * s);
                        *(uint2*)(dst + d) = w;
                        w.x = pk_bf16(o2[n][0] * s, o2[n][1] * s); w.y = pk_bf16(o2[n][2] * s, o2[n][3] * s);
                        *(uint2*)(dst + d + 32) = w;
                    }
                } else if (G == 24 || G == 25) {
                    const int kvh = G - 24;
                    float* o = p.out + (isS ? O_KS + (((size_t)(l * 16 + b) * 64 + t) * 2 + kvh) * 64 : O_KP + (((size_t)(l * 4 + b) * 4096 + t) * 2 + kvh) * 64);
                    bf16_t* kb = (isS ? p.ks + ((size_t)b * SS + 4096 + t) * 128 : p.kp + ((size_t)b * SP + t) * 128) + kvh * 64;
#pragma unroll
                    for (int n = 0; n < 2; ++n) {
                        const int d = n * 16 + fq * 4;
                        *(float4*)(o + d) = make_float4(o1[n][0], o1[n][1], o1[n][2], o1[n][3]);
                        *(float4*)(o + d + 32) = make_float4(o2[n][0], o2[n][1], o2[n][2], o2[n][3]);
                        uint2 w; w.x = pk_bf16(o1[n][0], o1[n][1]); w.y = pk_bf16(o1[n][2], o1[n][3]);
                        *(uint2*)(kb + d) = w;
                        w.x = pk_bf16(o2[n][0], o2[n][1]); w.y = pk_bf16(o2[n][2], o2[n][3]);
                        *(uint2*)(kb + d + 32) = w;
                    }
                } else {
                    float* o = p.out + (isS ? O_KIS + ((size_t)(l * 16 + b) * 64 + t) * 64 : O_KIP + ((size_t)(l * 4 + b) * 4096 + t) * 64);
                    bf16_t* kb = (isS ? p.kis + ((size_t)b * SS + 4096 + t) * 64 : p.kip + ((size_t)b * SP + t) * 64);
#pragma unroll
                    for (int n = 0; n < 2; ++n) {
                        const int d = n * 16 + fq * 4;
                        *(float4*)(o + d) = make_float4(o1[n][0], o1[n][1], o1[n][2], o1[n][3]);
                        *(float4*)(o + d + 32) = make_float4(o2[n][0], o2[n][1], o2[n][2], o2[n][3]);
                        uint2 w; w.x = pk_bf16(o1[n][0], o1[n][1]); w.y = pk_bf16(o1[n][2], o1[n][3]);
                        *(uint2*)(kb + d) = w;
                        w.x = pk_bf16(o2[n][0], o2[n][1]); w.y = pk_bf16(o2[n][2], o2[n][3]);
                        *(uint2*)(kb + d + 32) = w;
                    }
                }
            }
        }
    }
};

struct EpiWo {
    Params p; int l;
    __device__ __forceinline__ void operator()(f32x4 (&acc)[4][4], int rbase, int cbase, int fr, int fq) const {
#pragma unroll
        for (int m = 0; m < 4; ++m) {
            const int row = rbase + m * 16 + fr;
            const float* xr = (l == 0) ? ((row < TP) ? p.x_prompt + (size_t)row * DM : p.x_sample + (size_t)(row - TP) * DM) : p.F + (size_t)row * DM;
            float* fo = p.F + (size_t)row * DM;
#pragma unroll
            for (int n = 0; n < 4; ++n) {
                const int c = cbase + n * 16 + fq * 4;
                const float4 x = *(const float4*)(xr + c);
                *(float4*)(fo + c) = make_float4(ALPHA * x.x + acc[m][n][0], ALPHA * x.y + acc[m][n][1], ALPHA * x.z + acc[m][n][2], ALPHA * x.w + acc[m][n][3]);
            }
        }
    }
};
struct EpiGu {
    Params p;
    __device__ __forceinline__ void operator()(f32x4 (&acc)[4][4], int rbase, int cbase, int fr, int fq) const {
        const int G = cbase >> 6;
#pragma unroll
        for (int m = 0; m < 4; ++m) {
            const int row = rbase + m * 16 + fr;
#pragma unroll
            for (int n = 0; n < 2; ++n) {
                float a[4];
#pragma unroll
                for (int j = 0; j < 4; ++j) { const float g = acc[m][n][j]; a[j] = g * sigmoidf_(g) * acc[m][n + 2][j]; }
                uint2 w; w.x = pk_bf16(a[0], a[1]); w.y = pk_bf16(a[2], a[3]);
                *(uint2*)(p.act + (size_t)row * DFF + 32 * G + n * 16 + fq * 4) = w;
            }
        }
    }
};
struct EpiDn {
    Params p;
    __device__ __forceinline__ void operator()(f32x4 (&acc)[4][4], int rbase, int cbase, int fr, int fq) const {
#pragma unroll
        for (int m = 0; m < 4; ++m) {
            float* fo = p.F + (size_t)(rbase + m * 16 + fr) * DM;
#pragma unroll
            for (int n = 0; n < 4; ++n) {
                const int c = cbase + n * 16 + fq * 4;
                const float4 x = *(const float4*)(fo + c);
                *(float4*)(fo + c) = make_float4(ALPHA * x.x + acc[m][n][0], ALPHA * x.y + acc[m][n][1], ALPHA * x.z + acc[m][n][2], ALPHA * x.w + acc[m][n][3]);
            }
        }
    }
};

__device__ void ln_phase(const Params& p, int l, int which) {
    const int tid = opaque_tid(), lane = tid & 63, wid = tid >> 6;
    const float* g = (which == 1 ? p.ln1_g : p.ln2_g) + l * DM;
    const float* bb = (which == 1 ? p.ln1_b : p.ln2_b) + l * DM;
    const bool fin = (which == 2 && l == 1);
    for (int row = blockIdx.x * 4 + wid; row < TT; row += gridDim.x * 4) {
        float* fr = p.F + (size_t)row * DM;
        float4 v[4];
        float s = 0.f;
#pragma unroll
        for (int i = 0; i < 4; ++i) { v[i] = *(const float4*)(fr + i * 256 + lane * 4); s += (v[i].x + v[i].y) + (v[i].z + v[i].w); }
#pragma unroll
        for (int o = 32; o >= 1; o >>= 1) s += __shfl_xor(s, o);
        const float mean = s * (1.0f / 1024.0f);
        float q = 0.f;
#pragma unroll
        for (int i = 0; i < 4; ++i) { const float a = v[i].x - mean, b = v[i].y - mean, c = v[i].z - mean, d = v[i].w - mean; q += (a * a + b * b) + (c * c + d * d); }
#pragma unroll
        for (int o = 32; o >= 1; o >>= 1) q += __shfl_xor(q, o);
        const float rstd = rsqrtf(q * (1.0f / 1024.0f) + LN_EPS);
#pragma unroll
        for (int i = 0; i < 4; ++i) {
            const int c = i * 256 + lane * 4;
            const float4 gg = *(const float4*)(g + c), be = *(const float4*)(bb + c);
            const float4 o = make_float4((v[i].x - mean) * rstd * gg.x + be.x, (v[i].y - mean) * rstd * gg.y + be.y, (v[i].z - mean) * rstd * gg.z + be.z, (v[i].w - mean) * rstd * gg.w + be.w);
            if (fin) *(float4*)(p.out + (size_t)row * DM + c) = o;
            else {
                *(float4*)(fr + c) = o;
                uint2 w; w.x = pk_bf16(o.x, o.y); w.y = pk_bf16(o.z, o.w);
                *(uint2*)(p.ab + (size_t)row * DM + c) = w;
            }
        }
    }
}

__device__ void conv_unit(const Params& p, int l, int cu, unsigned char* lds) {
    const int tid = opaque_tid(), lane = tid & 63, wid = tid >> 6;
    const int row0 = cu * 32;
    bool isS; int b, t0, pos; tok_decode(row0, isS, b, t0, pos);
    const int seq_row0 = row0 - t0;
    unsigned* xs = (unsigned*)lds;
    float* red = (float*)(lds + 62 * 1024);
    const unsigned* ug = (const unsigned*)p.u;
    __syncthreads();
#pragma unroll 2
    for (int i = 0; i < 62; ++i) {
        const int tok = t0 - 30 + i;
        unsigned v = 0u;
        if (tok >= 0) v = ug[(size_t)(seq_row0 + tok) * 256 + tid];
        else if (isS) { const float2 s = *(const float2*)(p.state_conv + ((size_t)(l * 16 + b) * 30 + (30 + tok)) * 512 + 2 * tid); v = pk_bf16(s.x, s.y); }
        xs[i * 256 + tid] = v;
    }
    float cw0[31], cw1[31];
#pragma unroll
    for (int w = 0; w < 31; ++w) { const float2 c = *(const float2*)(p.conv_w + ((size_t)l * 31 + w) * 512 + 2 * tid); cw0[w] = c.x; cw1[w] = c.y; }
    const float2 cb = *(const float2*)(p.conv_b + l * 512 + 2 * tid);
#pragma unroll 1
    for (int t = 0; t < 32; ++t) {
        float a0 = cb.x, a1 = cb.y;
        const unsigned* xr = xs + t * 256 + tid;
#pragma unroll
        for (int w = 0; w < 31; ++w) { const unsigned v = xr[w * 256]; a0 += bf_lo(v) * cw0[w]; a1 += bf_hi(v) * cw1[w]; }
        float s = a0 + a1, q = a0 * a0 + a1 * a1;
#pragma unroll
        for (int o = 32; o >= 1; o >>= 1) { s += __shfl_xor(s, o); q += __shfl_xor(q, o); }
        if (lane == 0) { red[(wid * 32 + t) * 2] = s; red[(wid * 32 + t) * 2 + 1] = q; }
        xs[t * 256 + tid] = pk_bf16(a0, a1);
    }
    __syncthreads();
    const float2 lg = *(const float2*)(p.cln_g + l * 512 + 2 * tid);
    const float2 lb = *(const float2*)(p.cln_b + l * 512 + 2 * tid);
#pragma unroll 4
    for (int t = 0; t < 32; ++t) {
        const float s = (red[t * 2] + red[(32 + t) * 2]) + (red[(64 + t) * 2] + red[(96 + t) * 2]);
        const float q = (red[t * 2 + 1] + red[(32 + t) * 2 + 1]) + (red[(64 + t) * 2 + 1] + red[(96 + t) * 2 + 1]);
        const float mean = s * (1.0f / 512.0f);
        const float var = fmaxf(q * (1.0f / 512.0f) - mean * mean, 0.f);
        const float rstd = rsqrtf(var + LN_EPS);
        const unsigned v = xs[t * 256 + tid];
        float a = (bf_lo(v) - mean) * rstd * lg.x + lb.x, c = (bf_hi(v) - mean) * rstd * lg.y + lb.y;
        a = a * sigmoidf_(a); c = c * sigmoidf_(c);
        *(unsigned*)(p.ab + (size_t)(row0 + t) * DM + 2 * tid) = pk_bf16(a, c);
    }
    __syncthreads();
}

__device__ void attn_unit(const Params& p, int isS, int b, int t0, unsigned char* lds) {
    const int tid = opaque_tid(), lane = tid & 63, wid = tid >> 6, r = lane & 31, hh = lane >> 5;
    unsigned* sc = (unsigned*)lds;
    unsigned short* idxl = (unsigned short*)(lds + 4 * SS * 4) + wid * 256;
    const int row0 = isS ? TP + b * 64 + t0 : b * 4096 + t0;
    const int S = isS ? SS : ((t0 >> 6) + 1) * 64;
    const bf16_t* KI = isS ? p.kis + (size_t)b * SS * 64 : p.kip + (size_t)b * SP * 64;
    const bf16_t* Kc = isS ? p.ks + (size_t)b * SS * 128 : p.kp + (size_t)b * SP * 128;
    const bf16_t* Vc = isS ? p.vs + (size_t)b * SS * 128 : p.vp + (size_t)b * SP * 128;
    __syncthreads();
    {
        bf16x8 qf[4];
#pragma unroll
        for (int ks = 0; ks < 4; ++ks) qf[ks] = *(const bf16x8*)(p.qi + (size_t)(row0 + (r >> 3)) * 512 + (r & 7) * 64 + ks * 16 + hh * 8);
        float w[4][4];
#pragma unroll
        for (int q = 0; q < 4; ++q) { const float4 t = *(const float4*)(p.wi + (size_t)(row0 + q) * 8 + 4 * hh); w[q][0] = t.x; w[q][1] = t.y; w[q][2] = t.z; w[q][3] = t.w; }
        const int ntile = S >> 5;
        for (int kt = wid; kt < ntile; kt += 4) {
            const bf16_t* kr = KI + (size_t)(kt * 32 + r) * 64 + hh * 8;
            bf16x8 kf[4];
#pragma unroll
            for (int ks = 0; ks < 4; ++ks) kf[ks] = *(const bf16x8*)(kr + ks * 16);
            f32x16 d;
#pragma unroll
            for (int i = 0; i < 16; ++i) d[i] = 0.f;
#pragma unroll
            for (int ks = 0; ks < 4; ++ks) d = __builtin_amdgcn_mfma_f32_32x32x16_bf16(qf[ks], kf[ks], d, 0, 0, 0);
            float s[4];
#pragma unroll
            for (int q = 0; q < 4; ++q) {
                s[q] = (w[q][0] * fmaxf(d[4 * q], 0.f) + w[q][1] * fmaxf(d[4 * q + 1], 0.f)) + (w[q][2] * fmaxf(d[4 * q + 2], 0.f) + w[q][3] * fmaxf(d[4 * q + 3], 0.f));
                s[q] += __shfl_xor(s[q], 32);
                s[q] += 0.0f;
            }
            const float a0 = hh ? s[2] : s[0], a1 = hh ? s[3] : s[1];
            sc[(hh * 2) * SS + kt * 32 + r] = tokey(a0);
            sc[(hh * 2 + 1) * SS + kt * 32 + r] = tokey(a1);
        }
    }
    __syncthreads();
    const int Ksel = S < 256 ? S : 256;
    if (S <= 256) {
        for (int i = lane; i < S; i += 64) idxl[i] = (unsigned short)i;
    } else {
        unsigned key[65];
        const unsigned* myr = sc + wid * SS;
        const int nslot = S >> 6;
#pragma unroll
        for (int s = 0; s < 65; ++s) key[s] = (s < nslot) ? myr[s * 64 + lane] : 0u;
        unsigned P = 0; bool exact = false;
        for (int bit = 31; bit >= 0; --bit) {
            const unsigned C = P | (1u << bit);
            int cnt = 0;
#pragma unroll
            for (int s = 0; s < 65; ++s) cnt += __builtin_popcountll(__ballot(key[s] >= C));
            if (cnt >= 256) { P = C; if (cnt == 256) { exact = true; break; } }
        }
        const unsigned Tg = exact ? P - 1u : P;
        const unsigned long long lt = (1ull << lane) - 1ull;
        int base = 0;
#pragma unroll
        for (int s = 0; s < 65; ++s) {
            const bool g = key[s] > Tg;
            const unsigned long long m = __ballot(g);
            if (g) idxl[base + __builtin_popcountll(m & lt)] = (unsigned short)(s * 64 + lane);
            base += __builtin_popcountll(m);
        }
        const int need = 256 - base;
        if (need > 0) {
            int tb = 0;
#pragma unroll
            for (int s = 0; s < 65; ++s) {
                const bool e = (key[s] == Tg) && (s < nslot);
                const unsigned long long m = __ballot(e);
                const int rk = tb + __builtin_popcountll(m & lt);
                if (e && rk < need) idxl[base + rk] = (unsigned short)(s * 64 + lane);
                tb += __builtin_popcountll(m);
            }
        }
    }
    __syncthreads();
    const int row = row0 + wid;
    float* Pl = (float*)(sc + wid * SS);
    {
        bf16x8 qa[8];
#pragma unroll
        for (int ks = 0; ks < 8; ++ks) {
            const int kk = ks * 16 + hh * 8, g = kk >> 6, d = kk & 63;
            const bool valid = (r < 8) && ((r >> 2) == g);
            bf16x8 z;
#pragma unroll
            for (int j = 0; j < 8; ++j) z[j] = 0;
            qa[ks] = valid ? *(const bf16x8*)(p.q + (size_t)row * 512 + r * 64 + d) : z;
        }
#pragma unroll 1
        for (int tile = 0; tile < 8; ++tile) {
            const int key = tile * 32 + r;
            const int id = (key < Ksel) ? (int)idxl[key] : 0;
            const bf16_t* kr = Kc + (size_t)id * 128 + hh * 8;
            bf16x8 kf[8];
#pragma unroll
            for (int ks = 0; ks < 8; ++ks) kf[ks] = *(const bf16x8*)(kr + ks * 16);
            f32x16 d;
#pragma unroll
            for (int i = 0; i < 16; ++i) d[i] = 0.f;
#pragma unroll
            for (int ks = 0; ks < 8; ++ks) d = __builtin_amdgcn_mfma_f32_32x32x16_bf16(qa[ks], kf[ks], d, 0, 0, 0);
            const bool ok = key < Ksel;
            *(float4*)(Pl + key * 8 + 4 * hh) = make_float4(ok ? d[0] : -INFINITY, ok ? d[1] : -INFINITY, ok ? d[2] : -INFINITY, ok ? d[3] : -INFINITY);
        }
    }
    {
        float lg[8][4];
#pragma unroll
        for (int tile = 0; tile < 8; ++tile) { const float4 t = *(const float4*)(Pl + (tile * 32 + r) * 8 + 4 * hh); lg[tile][0] = t.x; lg[tile][1] = t.y; lg[tile][2] = t.z; lg[tile][3] = t.w; }
#pragma unroll
        for (int i = 0; i < 4; ++i) {
            float mx = lg[0][i];
#pragma unroll
            for (int tile = 1; tile < 8; ++tile) mx = fmaxf(mx, lg[tile][i]);
#pragma unroll
            for (int o = 16; o >= 1; o >>= 1) mx = fmaxf(mx, __shfl_xor(mx, o));
            float sm = 0.f;
#pragma unroll
            for (int tile = 0; tile < 8; ++tile) { lg[tile][i] = exp2f(lg[tile][i] - mx); sm += lg[tile][i]; }
#pragma unroll
            for (int o = 16; o >= 1; o >>= 1) sm += __shfl_xor(sm, o);
            const float inv = 1.0f / sm;
#pragma unroll
            for (int tile = 0; tile < 8; ++tile) lg[tile][i] *= inv;
        }
#pragma unroll
        for (int tile = 0; tile < 8; ++tile) *(float4*)(Pl + (tile * 32 + r) * 8 + 4 * hh) = make_float4(lg[tile][0], lg[tile][1], lg[tile][2], lg[tile][3]);
    }
    __syncthreads();
    {
        const int g = lane >> 5;
        float o0[4] = {0.f, 0.f, 0.f, 0.f}, o1[4] = {0.f, 0.f, 0.f, 0.f};
        for (int k0 = 0; k0 < Ksel; k0 += 8) {
            unsigned vv[8];
#pragma unroll
            for (int j = 0; j < 8; ++j) { const int id = idxl[k0 + j]; vv[j] = *(const unsigned*)(Vc + (size_t)id * 128 + 2 * lane); }
#pragma unroll
            for (int j = 0; j < 8; ++j) {
                const float4 pp = *(const float4*)(Pl + (k0 + j) * 8 + 4 * g);
                const float v0 = bf_lo(vv[j]), v1 = bf_hi(vv[j]);
                o0[0] += pp.x * v0; o1[0] += pp.x * v1; o0[1] += pp.y * v0; o1[1] += pp.y * v1;
                o0[2] += pp.z * v0; o1[2] += pp.z * v1; o0[3] += pp.w * v0; o1[3] += pp.w * v1;
            }
        }
#pragma unroll
        for (int i = 0; i < 4; ++i) *(unsigned*)(p.ab + (size_t)row * DM + 512 + (4 * g + i) * 64 + 2 * (lane & 31)) = pk_bf16(o0[i], o1[i]);
    }
}

__device__ void mixer_phase(const Params& p, int l, unsigned char* lds) {
    const int G = gridDim.x;
    {
        const int NU = 4352;
        for (int rd = 0; rd * G < NU; ++rd) {
            const int i = rd * G + ((rd & 1) ? (G - 1 - (int)blockIdx.x) : (int)blockIdx.x);
            if (i >= NU) continue;
            int isS, b, t0;
            if (i < 256) { isS = 1; b = i >> 4; t0 = (i & 15) * 4; }
            else { const int j = i - 256, c = 63 - (j >> 6), rr = j & 63; isS = 0; b = rr >> 4; t0 = c * 64 + (rr & 15) * 4; }
            attn_unit(p, isS, b, t0, lds);
        }
    }
    __syncthreads();
    for (int i = G - 1 - (int)blockIdx.x; i < 544; i += G) conv_unit(p, l, i, lds);
}

__device__ void run_phase(const Params& p, int ph, unsigned char* lds) {
#ifndef TEST_K
    if (ph == 0) { phase0(p, lds); return; }
#else
    if (TEST_K == 7) { phase0(p, lds); return; }
#endif
    const int l = (ph - 1) / 7, k = (ph - 1) % 7;
#ifdef TEST_K
    if (k != TEST_K) return;
#endif
    switch (k) {
        case 0: { EpiIn e{p, l}; gemm_phase(p.ab, p.win_t + (size_t)l * NINP * DM, DM, NINP / 128, lds, e); } break;
        case 1: mixer_phase(p, l, lds); break;
        case 2: { EpiWo e{p, l}; gemm_phase(p.ab, p.wo_t + (size_t)l * DM * DM, DM, DM / 128, lds, e); } break;
        case 3: ln_phase(p, l, 1); if (l == 0) convert_cache(p, 1); break;
        case 4: { EpiGu e{p}; gemm_phase(p.ab, p.wgu_t + (size_t)l * NGU * DM, DM, NGU / 128, lds, e); } break;
        case 5: { EpiDn e{p}; gemm_phase(p.act, p.wdn_t + (size_t)l * DM * DFF, DFF, DM / 128, lds, e); } break;
        case 6: ln_phase(p, l, 2); break;
    }
}

__global__ void __launch_bounds__(256, 2) mk(Params p, int ph_lo, int ph_hi) {
    extern __shared__ __attribute__((aligned(16))) unsigned char lds[];
#if MK_COOP
    cg::grid_group grid = cg::this_grid();
#endif
    for (int ph = ph_lo; ph < ph_hi; ++ph) {
        run_phase(p, ph, lds);
#if MK_COOP
        if (ph + 1 < ph_hi) grid.sync();
#endif
    }
}

static inline size_t al256(size_t x) { return (x + 255) & ~(size_t)255; }

extern "C" void kernel_launch(void* const* d_in, const int* in_sizes, int n_in, void* d_out, int out_size, void* d_ws, size_t ws_size, hipStream_t stream) {
    static int grid = 0;
    if (grid == 0) {
        int dev = 0, cus = 0, per_cu = 0;
        hipGetDevice(&dev);
        hipDeviceGetAttribute(&cus, hipDeviceAttributeMultiprocessorCount, dev);
        if (hipFuncSetAttribute((const void*)mk, hipFuncAttributeMaxDynamicSharedMemorySize, LDS_BYTES) != hipSuccess) { fprintf(stderr, "hipFuncSetAttribute failed\n"); grid = -1; return; }
        hipOccupancyMaxActiveBlocksPerMultiprocessor(&per_cu, (const void*)mk, 256, LDS_BYTES);
        if (per_cu < 1) { fprintf(stderr, "occupancy query says %d\n", per_cu); grid = -1; return; }
        if (per_cu > 2) per_cu = 2;
        grid = cus * per_cu;
        fprintf(stderr, "grid %d (cus %d x %d)\n", grid, cus, per_cu);
    }
    if (grid < 0) return;
    Params p{};
    const float* const* in = (const float* const*)d_in;
    p.x_prompt = in[0]; p.x_sample = in[1]; p.cache_k = in[2]; p.cache_v = in[3]; p.cache_ki = in[4]; p.state_conv = in[5];
    p.w_in = in[6]; p.conv_w = in[7]; p.conv_b = in[8]; p.cln_g = in[9]; p.cln_b = in[10]; p.w_o = in[11]; p.ln1_g = in[12]; p.ln1_b = in[13];
    p.w_gu = in[14]; p.w_dn = in[15]; p.ln2_g = in[16]; p.ln2_b = in[17];
    p.out = (float*)d_out;
    unsigned char* w = (unsigned char*)d_ws; size_t off = 0;
    auto take = [&](size_t bytes) { unsigned char* r = w + off; off = al256(off + bytes); return r; };
    p.win_t = (bf16_t*)take((size_t)2 * NINP * DM * 2);
    p.wo_t = (bf16_t*)take((size_t)2 * DM * DM * 2);
    p.wgu_t = (bf16_t*)take((size_t)2 * NGU * DM * 2);
    p.wdn_t = (bf16_t*)take((size_t)2 * DM * DFF * 2);
    p.trig = (float2*)take((size_t)SS * 32 * 8);
    p.kp = (bf16_t*)take((size_t)4 * SP * 128 * 2); p.vp = (bf16_t*)take((size_t)4 * SP * 128 * 2); p.kip = (bf16_t*)take((size_t)4 * SP * 64 * 2);
    p.ks = (bf16_t*)take((size_t)16 * SS * 128 * 2); p.vs = (bf16_t*)take((size_t)16 * SS * 128 * 2); p.kis = (bf16_t*)take((size_t)16 * SS * 64 * 2);
    p.ab = (bf16_t*)take((size_t)TT * DM * 2);
    p.F = (float*)take((size_t)TT * DM * 4);
    unsigned char* big = take((size_t)TT * DFF * 2);
    p.act = (bf16_t*)big;
    p.u = (bf16_t*)big; p.q = (bf16_t*)(big + (size_t)TT * 512 * 2); p.qi = (bf16_t*)(big + (size_t)2 * TT * 512 * 2); p.wi = (float*)(big + (size_t)3 * TT * 512 * 2);
    if (off > ws_size) { fprintf(stderr, "workspace too small: need %zu have %zu\n", off, ws_size); return; }
#if MK_COOP
    int lo = 0, hi = 15;
    void* args[] = {&p, &lo, &hi};
    hipError_t e = hipLaunchCooperativeKernel((const void*)mk, dim3(grid), dim3(256), args, LDS_BYTES, stream);
    if (e != hipSuccess) fprintf(stderr, "cooperative launch failed: %s (grid %d)\n", hipGetErrorString(e), grid);
#else
    for (int ph = 0; ph < 15; ++ph) hipLaunchKernelGGL(mk, dim3(grid), dim3(256), LDS_BYTES, stream, p, ph, ph + 1);
#endif
}
```

```cpp
#include <hip/hip_runtime.h>
#include <hip/hip_cooperative_groups.h>
#include <cstdio>
#include <cstdint>
namespace cg = cooperative_groups;

#ifndef MK_COOP
#define MK_COOP 1
#endif

typedef unsigned short bf16_t;
typedef short bf16x8 __attribute__((ext_vector_type(8)));
typedef float f32x4 __attribute__((ext_vector_type(4)));
typedef float f32x16 __attribute__((ext_vector_type(16)));
typedef unsigned u32x4 __attribute__((ext_vector_type(4)));

constexpr int DM = 1024, TP = 16384, TSM = 1024, TT = TP + TSM;
constexpr int NIN = 2376, NINP = 2432, DFF = 2816, NGU = 5632;
constexpr int SP = 4096, SS = 4160;
constexpr int LDS_BYTES = 4 * SS * 4 + 4 * 256 * 2;
constexpr float ALPHA = 1.4142135623730951f;
constexpr float LN_EPS = 1e-5f;

constexpr size_t O_YP = 0, O_YS = 16777216, O_KP = 17825792, O_VP = 22020096, O_KIP = 26214400, O_CP = 28311552,
                 O_KS = 28434432, O_VS = 28696576, O_KIS = 28958720, O_CS = 29089792;

struct Params {
    const float *x_prompt, *x_sample, *cache_k, *cache_v, *cache_ki, *state_conv;
    const float *w_in, *conv_w, *conv_b, *cln_g, *cln_b, *w_o, *ln1_g, *ln1_b, *w_gu, *w_dn, *ln2_g, *ln2_b;
    float* out;
    bf16_t *win_t, *wo_t, *wgu_t, *wdn_t;
    float2* trig;
    bf16_t *kp, *vp, *kip, *ks, *vs, *kis;
    bf16_t* ab;
    float* F;
    bf16_t *act, *u, *q, *qi;
    float* wi;
    unsigned* bar;
};

__device__ __forceinline__ unsigned pk_bf16(float lo, float hi) { unsigned r; asm volatile("v_cvt_pk_bf16_f32 %0, %1, %2" : "=v"(r) : "v"(lo), "v"(hi)); return r; }
__device__ __forceinline__ float bf_lo(unsigned v) { return __uint_as_float(v << 16); }
__device__ __forceinline__ float bf_hi(unsigned v) { return __uint_as_float(v & 0xffff0000u); }
__device__ __forceinline__ int opaque_tid() { int t = threadIdx.x; asm volatile("" : "+v"(t)); return t; }
__device__ __forceinline__ unsigned tokey(float f) { unsigned u = __float_as_uint(f); return (u & 0x80000000u) ? ~u : (u | 0x80000000u); }
__device__ __forceinline__ float sigmoidf_(float x) { return 1.0f / (1.0f + __expf(-x)); }

__device__ __forceinline__ int perm_in(int n) {
    const int g = n >> 6, w = n & 63;
    if (g < 16) return (w < 32) ? (32 * g + w) : (512 + 32 * g + (w - 32));
    const int c = 1024 + (g - 16) * 64 + w;
    return c < NIN ? c : -1;
}
__device__ __forceinline__ int perm_gu(int n) { const int g = n >> 6, w = n & 63; return (w < 32) ? (32 * g + w) : (DFF + 32 * g + (w - 32)); }

template <int MODE>
__device__ void transpose_tiles(const float* __restrict__ W, bf16_t* __restrict__ Wt, int K, int N, int Np, float* lds, int& cursor) {
    const int tk = K >> 6, tn = Np >> 6, nt = tk * tn, tid = opaque_tid();
    for (int t = 0; t < nt; ++t, ++cursor) {
        if ((cursor % (int)gridDim.x) != (int)blockIdx.x) continue;
        const int k0 = (t / tn) << 6, n0 = (t % tn) << 6;
        __syncthreads();
#pragma unroll
        for (int i = 0; i < 16; ++i) {
            const int k = i * 4 + (tid >> 6), n = tid & 63;
            int c = n0 + n; if (MODE == 1) c = perm_in(c); else if (MODE == 2) c = perm_gu(c);
            lds[k * 65 + n] = (c >= 0) ? W[(size_t)(k0 + k) * N + c] : 0.f;
        }
        __syncthreads();
#pragma unroll
        for (int i = 0; i < 8; ++i) {
            const int n = i * 8 + (tid >> 5), k = (tid & 31) * 2;
            *(unsigned*)(Wt + (size_t)(n0 + n) * K + k0 + k) = pk_bf16(lds[k * 65 + n], lds[(k + 1) * 65 + n]);
        }
    }
}

__device__ void convert_chunks(const float* __restrict__ src, bf16_t* __restrict__ dst, int nb, int chunk8  , int dst_stride8  ) {
    const int total = nb * chunk8;
    for (int i = blockIdx.x * 256 + opaque_tid(); i < total; i += gridDim.x * 256) {
        const int b = i / chunk8, r = i - b * chunk8;
        const float4 a = *(const float4*)(src + (size_t)i * 8), c = *(const float4*)(src + (size_t)i * 8 + 4);
        uint4 o; o.x = pk_bf16(a.x, a.y); o.y = pk_bf16(a.z, a.w); o.z = pk_bf16(c.x, c.y); o.w = pk_bf16(c.z, c.w);
        *(uint4*)(dst + ((size_t)b * dst_stride8 + r) * 8) = o;
    }
}
__device__ void convert_cache(const Params& p, int l) {
    convert_chunks(p.cache_k + (size_t)l * 16 * 4096 * 128, p.ks, 16, 4096 * 16, SS * 16);
    convert_chunks(p.cache_v + (size_t)l * 16 * 4096 * 128, p.vs, 16, 4096 * 16, SS * 16);
    convert_chunks(p.cache_ki + (size_t)l * 16 * 4096 * 64, p.kis, 16, 4096 * 8, SS * 8);
}

__device__ void phase0(const Params& p, unsigned char* lds) {
    int cursor = 0;
    for (int l = 0; l < 2; ++l) {
        transpose_tiles<1>(p.w_in + (size_t)l * DM * NIN, p.win_t + (size_t)l * NINP * DM, DM, NIN, NINP, (float*)lds, cursor);
        transpose_tiles<0>(p.w_o + (size_t)l * DM * DM, p.wo_t + (size_t)l * DM * DM, DM, DM, DM, (float*)lds, cursor);
        transpose_tiles<2>(p.w_gu + (size_t)l * DM * NGU, p.wgu_t + (size_t)l * NGU * DM, DM, NGU, NGU, (float*)lds, cursor);
        transpose_tiles<0>(p.w_dn + (size_t)l * DFF * DM, p.wdn_t + (size_t)l * DM * DFF, DFF, DM, DM, (float*)lds, cursor);
    }
    __syncthreads();
    convert_chunks(p.x_prompt, p.ab, 1, TP * 128, TP * 128);
    convert_chunks(p.x_sample, p.ab + (size_t)TP * DM, 1, TSM * 128, TSM * 128);
    convert_cache(p, 0);
    for (int i = blockIdx.x * 256 + opaque_tid(); i < SS * 32; i += gridDim.x * 256) {
        const int pos = i >> 5, f = i & 31;
        const float inv = exp2f(-(float)f * (13.287712379549449f / 32.0f));
        const float angf = (float)pos * inv;
        const double rev = (double)angf * 0.15915494309189535;
        const double fr = rev - __builtin_rint(rev);
        const float ang = (float)(fr * 6.283185307179586);
        p.trig[i] = make_float2(__cosf(ang), __sinf(ang));
    }
}

template <class Epi>
__device__ __forceinline__ void gemm_tile(const bf16_t* __restrict__ A, const bf16_t* __restrict__ Bt, int K, int row0, int col0, unsigned char* lds, const Epi& epi) {
    const int tid = opaque_tid(), lane = tid & 63, wid = tid >> 6, wr = wid >> 1, wc = wid & 1, fr = lane & 15, fq = lane >> 4;
    const int sc = tid & 7, sr = tid >> 3;
    const bf16_t* ag = A + (size_t)(row0 + sr) * K + sc * 8;
    const bf16_t* bg = Bt + (size_t)(col0 + sr) * K + sc * 8;
    u32x4 ra[4], rb[4];
    f32x4 acc[4][4];
#pragma unroll
    for (int m = 0; m < 4; ++m)
#pragma unroll
        for (int n = 0; n < 4; ++n) acc[m][n] = (f32x4){0.f, 0.f, 0.f, 0.f};
    const int soff = sr * 128 + ((sc ^ ((sr >> 1) & 7)) << 4);
    const int nk = K >> 6;
#pragma unroll
    for (int i = 0; i < 4; ++i) { ra[i] = *(const u32x4*)(ag + (size_t)i * 32 * K); rb[i] = *(const u32x4*)(bg + (size_t)i * 32 * K); }
    __syncthreads();
#pragma unroll
    for (int i = 0; i < 4; ++i) { *(u32x4*)(lds + soff + i * 4096) = ra[i]; *(u32x4*)(lds + 16384 + soff + i * 4096) = rb[i]; }
    __syncthreads();
    const int swz = (fr >> 1) & 7;
    for (int kt = 0; kt < nk; ++kt) {
        if (kt + 1 < nk) {
#pragma unroll
            for (int i = 0; i < 4; ++i) { ra[i] = *(const u32x4*)(ag + (size_t)i * 32 * K + (kt + 1) * 64); rb[i] = *(const u32x4*)(bg + (size_t)i * 32 * K + (kt + 1) * 64); }
        }
        const unsigned char* ba = lds + (kt & 1) * 32768;
        const unsigned char* bb = ba + 16384;
#pragma unroll
        for (int ks = 0; ks < 2; ++ks) {
            bf16x8 af[4], bfr[4];
            const int ch = ((ks * 4 + fq) ^ swz) << 4;
#pragma unroll
            for (int m = 0; m < 4; ++m) af[m] = *(const bf16x8*)(ba + (wr * 64 + m * 16 + fr) * 128 + ch);
#pragma unroll
            for (int n = 0; n < 4; ++n) bfr[n] = *(const bf16x8*)(bb + (wc * 64 + n * 16 + fr) * 128 + ch);
#pragma unroll
            for (int m = 0; m < 4; ++m)
#pragma unroll
                for (int n = 0; n < 4; ++n) acc[m][n] = __builtin_amdgcn_mfma_f32_16x16x32_bf16(bfr[n], af[m], acc[m][n], 0, 0, 0);
        }
        if (kt + 1 < nk) {
            unsigned char* d = lds + ((kt + 1) & 1) * 32768;
#pragma unroll
            for (int i = 0; i < 4; ++i) { *(u32x4*)(d + soff + i * 4096) = ra[i]; *(u32x4*)(d + 16384 + soff + i * 4096) = rb[i]; }
        }
        __syncthreads();
    }
    epi(acc, row0 + wr * 64, col0 + wc * 64, fr, fq);
}

template <class Epi>
__device__ void gemm_phase(const bf16_t* A, const bf16_t* Bt, int K, int nN, unsigned char* lds, const Epi& epi) {
    const int nt = (TT / 128) * nN;
    for (int t = blockIdx.x; t < nt; t += gridDim.x) {
        const int mt = t / nN, ntile = t - mt * nN;
        gemm_tile(A, Bt, K, mt * 128, ntile * 128, lds, epi);
    }
}

__device__ __forceinline__ void tok_decode(int row, bool& isS, int& b, int& t, int& pos) {
    isS = row >= TP;
    if (!isS) { b = row >> 12; t = row & 4095; pos = t; } else { const int r = row - TP; b = r >> 6; t = r & 63; pos = 4096 + t; }
}

struct EpiIn {
    Params p; int l;
    __device__ __forceinline__ void operator()(f32x4 (&acc)[4][4], int rbase, int cbase, int fr, int fq) const {
        const int G = cbase >> 6;
#pragma unroll
        for (int m = 0; m < 4; ++m) {
            const int row = rbase + m * 16 + fr;
            bool isS; int b, t, pos; tok_decode(row, isS, b, t, pos);
            if (G < 16) {
                const int tl = isS ? t - 34 : t - 4066;
#pragma unroll
                for (int n = 0; n < 2; ++n) {
                    const int ch = 32 * G + n * 16 + fq * 4;
                    float u[4];
#pragma unroll
                    for (int j = 0; j < 4; ++j) u[j] = acc[m][n][j] * sigmoidf_(acc[m][n + 2][j]);
                    uint2 w; w.x = pk_bf16(u[0], u[1]); w.y = pk_bf16(u[2], u[3]);
                    *(uint2*)(p.u + (size_t)row * 512 + ch) = w;
                    if (tl >= 0) {
                        float* o = p.out + (isS ? O_CS + ((size_t)(l * 16 + b) * 30 + tl) * 512 : O_CP + ((size_t)(l * 4 + b) * 30 + tl) * 512) + ch;
                        *(float4*)o = make_float4(u[0], u[1], u[2], u[3]);
                    }
                }
            } else if (G == 26 || G == 27) {
                const int kvh = G - 26;
                float* o = p.out + (isS ? O_VS + (((size_t)(l * 16 + b) * 64 + t) * 2 + kvh) * 64 : O_VP + (((size_t)(l * 4 + b) * 4096 + t) * 2 + kvh) * 64);
                bf16_t* vb = (isS ? p.vs + ((size_t)b * SS + 4096 + t) * 128 : p.vp + ((size_t)b * SP + t) * 128) + kvh * 64;
#pragma unroll
                for (int n = 0; n < 4; ++n) {
                    const int d = n * 16 + fq * 4;
                    *(float4*)(o + d) = make_float4(acc[m][n][0], acc[m][n][1], acc[m][n][2], acc[m][n][3]);
                    uint2 w; w.x = pk_bf16(acc[m][n][0], acc[m][n][1]); w.y = pk_bf16(acc[m][n][2], acc[m][n][3]);
                    *(uint2*)(vb + d) = w;
                }
            } else if (G == 37) {
                if (fq < 2) {
                    const float s = 0.35355339059327373f * 0.125f;
                    *(float4*)(p.wi + (size_t)row * 8 + fq * 4) = make_float4(acc[m][0][0] * s, acc[m][0][1] * s, acc[m][0][2] * s, acc[m][0][3] * s);
                }
            } else {
                float o1[2][4], o2[2][4];
#pragma unroll
                for (int n = 0; n < 2; ++n) {
                    const float4* tp = (const float4*)(p.trig + (size_t)pos * 32 + n * 16 + fq * 4);
                    const float4 t0 = tp[0], t1 = tp[1];
                    const float cs[4] = {t0.x, t0.z, t1.x, t1.z}, sn[4] = {t0.y, t0.w, t1.y, t1.w};
#pragma unroll
                    for (int j = 0; j < 4; ++j) {
                        const float x1 = acc[m][n][j], x2 = acc[m][n + 2][j];
                        o1[n][j] = x1 * cs[j] - x2 * sn[j];
                        o2[n][j] = x2 * cs[j] + x1 * sn[j];
                    }
                }
                if (G < 24 || (G >= 28 && G < 36)) {
                    const bool isq = G < 24;
                    const float s = isq ? 0.125f * 1.4426950408889634f : 1.0f;
                    bf16_t* dst = (isq ? p.q + (size_t)row * 512 + (G - 16) * 64 : p.qi + (size_t)row * 512 + (G - 28) * 64);
#pragma unroll
                    for (int n = 0; n < 2; ++n) {
                        const int d = n * 16 + fq * 4;
                        uint2 w; w.x = pk_bf16(o1[n][0] * s, o1[n][1] * s); w.y = pk_bf16(o1[n][2] * s, o1[n][3] * s);
                        *(uint2*)(dst + d) = w;
                        w.x = pk_bf16(o2[n][0] * s, o2[n][1] * s); w.y = pk_bf16(o2[n][2] * s, o2[n][3] * s);
                        *(uint2*)(dst + d + 32) = w;
                    }
                } else if (G == 24 || G == 25) {
                    const int kvh = G - 24;
                    float* o = p.out + (isS ? O_KS + (((size_t)(l * 16 + b) * 64 + t) * 2 + kvh) * 64 : O_KP + (((size_t)(l * 4 + b) * 4096 + t) * 2 + kvh) * 64);
                    bf16_t* kb = (isS ? p.ks + ((size_t)b * SS + 4096 + t) * 128 : p.kp + ((size_t)b * SP + t) * 128) + kvh * 64;
#pragma unroll
                    for (int n = 0; n < 2; ++n) {
                        const int d = n * 16 + fq * 4;
                        *(float4*)(o + d) = make_float4(o1[n][0], o1[n][1], o1[n][2], o1[n][3]);
                        *(float4*)(o + d + 32) = make_float4(o2[n][0], o2[n][1], o2[n][2], o2[n][3]);
                        uint2 w; w.x = pk_bf16(o1[n][0], o1[n][1]); w.y = pk_bf16(o1[n][2], o1[n][3]);
                        *(uint2*)(kb + d) = w;
                        w.x = pk_bf16(o2[n][0], o2[n][1]); w.y = pk_bf16(o2[n][2], o2[n][3]);
                        *(uint2*)(kb + d + 32) = w;
                    }
                } else {
                    float* o = p.out + (isS ? O_KIS + ((size_t)(l * 16 + b) * 64 + t) * 64 : O_KIP + ((size_t)(l * 4 + b) * 4096 + t) * 64);
                    bf16_t* kb = (isS ? p.kis + ((size_t)b * SS + 4096 + t) * 64 : p.kip + ((size_t)b * SP + t) * 64);
#pragma unroll
                    for (int n = 0; n < 2; ++n) {
                        const int d = n * 16 + fq * 4;
                        *(float4*)(o + d) = make_float4(o1[n][0], o1[n][1], o1[n][2], o1[n][3]);
                        *(float4*)(o + d + 32) = make_float4(o2[n][0], o2[n][1], o2[n][2], o2[n][3]);
                        uint2 w; w.x = pk_bf16(o1[n][0], o1[n][1]); w.y = pk_bf16(o1[n][2], o1[n][3]);
                        *(uint2*)(kb + d) = w;
                        w.x = pk_bf16(o2[n][0], o2[n][1]); w.y = pk_bf16(o2[n][2], o2[n][3]);
                        *(uint2*)(kb + d + 32) = w;
                    }
                }
            }
        }
    }
};

struct EpiWo {
    Params p; int l;
    __device__ __forceinline__ void operator()(f32x4 (&acc)[4][4], int rbase, int cbase, int fr, int fq) const {
#pragma unroll
        for (int m = 0; m < 4; ++m) {
            const int row = rbase + m * 16 + fr;
            const float* xr = (l == 0) ? ((row < TP) ? p.x_prompt + (size_t)row * DM : p.x_sample + (size_t)(row - TP) * DM) : p.F + (size_t)row * DM;
            float* fo = p.F + (size_t)row * DM;
#pragma unroll
            for (int n = 0; n < 4; ++n) {
                const int c = cbase + n * 16 + fq * 4;
                const float4 x = *(const float4*)(xr + c);
                *(float4*)(fo + c) = make_float4(ALPHA * x.x + acc[m][n][0], ALPHA * x.y + acc[m][n][1], ALPHA * x.z + acc[m][n][2], ALPHA * x.w + acc[m][n][3]);
            }
        }
    }
};
struct EpiGu {
    Params p;
    __device__ __forceinline__ void operator()(f32x4 (&acc)[4][4], int rbase, int cbase, int fr, int fq) const {
        const int G = cbase >> 6;
#pragma unroll
        for (int m = 0; m < 4; ++m) {
            const int row = rbase + m * 16 + fr;
#pragma unroll
            for (int n = 0; n < 2; ++n) {
                float a[4];
#pragma unroll
                for (int j = 0; j < 4; ++j) { const float g = acc[m][n][j]; a[j] = g * sigmoidf_(g) * acc[m][n + 2][j]; }
                uint2 w; w.x = pk_bf16(a[0], a[1]); w.y = pk_bf16(a[2], a[3]);
                *(uint2*)(p.act + (size_t)row * DFF + 32 * G + n * 16 + fq * 4) = w;
            }
        }
    }
};
struct EpiDn {
    Params p;
    __device__ __forceinline__ void operator()(f32x4 (&acc)[4][4], int rbase, int cbase, int fr, int fq) const {
#pragma unroll
        for (int m = 0; m < 4; ++m) {
            float* fo = p.F + (size_t)(rbase + m * 16 + fr) * DM;
#pragma unroll
            for (int n = 0; n < 4; ++n) {
                const int c = cbase + n * 16 + fq * 4;
                const float4 x = *(const float4*)(fo + c);
                *(float4*)(fo + c) = make_float4(ALPHA * x.x + acc[m][n][0], ALPHA * x.y + acc[m][n][1], ALPHA * x.z + acc[m][n][2], ALPHA * x.w + acc[m][n][3]);
            }
        }
    }
};

__device__ void ln_phase(const Params& p, int l, int which) {
    const int tid = opaque_tid(), lane = tid & 63, wid = tid >> 6;
    const float* g = (which == 1 ? p.ln1_g : p.ln2_g) + l * DM;
    const float* bb = (which == 1 ? p.ln1_b : p.ln2_b) + l * DM;
    const bool fin = (which == 2 && l == 1);
    for (int row = blockIdx.x * 4 + wid; row < TT; row += gridDim.x * 4) {
        float* fr = p.F + (size_t)row * DM;
        float4 v[4];
        float s = 0.f;
#pragma unroll
        for (int i = 0; i < 4; ++i) { v[i] = *(const float4*)(fr + i * 256 + lane * 4); s += (v[i].x + v[i].y) + (v[i].z + v[i].w); }
#pragma unroll
        for (int o = 32; o >= 1; o >>= 1) s += __shfl_xor(s, o);
        const float mean = s * (1.0f / 1024.0f);
        float q = 0.f;
#pragma unroll
        for (int i = 0; i < 4; ++i) { const float a = v[i].x - mean, b = v[i].y - mean, c = v[i].z - mean, d = v[i].w - mean; q += (a * a + b * b) + (c * c + d * d); }
#pragma unroll
        for (int o = 32; o >= 1; o >>= 1) q += __shfl_xor(q, o);
        const float rstd = rsqrtf(q * (1.0f / 1024.0f) + LN_EPS);
#pragma unroll
        for (int i = 0; i < 4; ++i) {
            const int c = i * 256 + lane * 4;
            const float4 gg = *(const float4*)(g + c), be = *(const float4*)(bb + c);
            const float4 o = make_float4((v[i].x - mean) * rstd * gg.x + be.x, (v[i].y - mean) * rstd * gg.y + be.y, (v[i].z - mean) * rstd * gg.z + be.z, (v[i].w - mean) * rstd * gg.w + be.w);
            if (fin) *(float4*)(p.out + (size_t)row * DM + c) = o;
            else {
                *(float4*)(fr + c) = o;
                uint2 w; w.x = pk_bf16(o.x, o.y); w.y = pk_bf16(o.z, o.w);
                *(uint2*)(p.ab + (size_t)row * DM + c) = w;
            }
        }
    }
}

__device__ void conv_unit(const Params& p, int l, int cu, unsigned char* lds) {
    const int tid = opaque_tid(), lane = tid & 63, wid = tid >> 6;
    const int row0 = cu * 32;
    bool isS; int b, t0, pos; tok_decode(row0, isS, b, t0, pos);
    const int seq_row0 = row0 - t0;
    unsigned* xs = (unsigned*)lds;
    float* red = (float*)(lds + 62 * 1024);
    const unsigned* ug = (const unsigned*)p.u;
    __syncthreads();
#pragma unroll 2
    for (int i = 0; i < 62; ++i) {
        const int tok = t0 - 30 + i;
        unsigned v = 0u;
        if (tok >= 0) v = ug[(size_t)(seq_row0 + tok) * 256 + tid];
        else if (isS) { const float2 s = *(const float2*)(p.state_conv + ((size_t)(l * 16 + b) * 30 + (30 + tok)) * 512 + 2 * tid); v = pk_bf16(s.x, s.y); }
        xs[i * 256 + tid] = v;
    }
    float cw0[31], cw1[31];
#pragma unroll
    for (int w = 0; w < 31; ++w) { const float2 c = *(const float2*)(p.conv_w + ((size_t)l * 31 + w) * 512 + 2 * tid); cw0[w] = c.x; cw1[w] = c.y; }
    const float2 cb = *(const float2*)(p.conv_b + l * 512 + 2 * tid);
#pragma unroll 1
    for (int t = 0; t < 32; ++t) {
        float a0 = cb.x, a1 = cb.y;
        const unsigned* xr = xs + t * 256 + tid;
#pragma unroll
        for (int w = 0; w < 31; ++w) { const unsigned v = xr[w * 256]; a0 += bf_lo(v) * cw0[w]; a1 += bf_hi(v) * cw1[w]; }
        float s = a0 + a1, q = a0 * a0 + a1 * a1;
#pragma unroll
        for (int o = 32; o >= 1; o >>= 1) { s += __shfl_xor(s, o); q += __shfl_xor(q, o); }
        if (lane == 0) { red[(wid * 32 + t) * 2] = s; red[(wid * 32 + t) * 2 + 1] = q; }
        xs[t * 256 + tid] = pk_bf16(a0, a1);
    }
    __syncthreads();
    const float2 lg = *(const float2*)(p.cln_g + l * 512 + 2 * tid);
    const float2 lb = *(const float2*)(p.cln_b + l * 512 + 2 * tid);
#pragma unroll 4
    for (int t = 0; t < 32; ++t) {
        const float s = (red[t * 2] + red[(32 + t) * 2]) + (red[(64 + t) * 2] + red[(96 + t) * 2]);
        const float q = (red[t * 2 + 1] + red[(32 + t) * 2 + 1]) + (red[(64 + t) * 2 + 1] + red[(96 + t) * 2 + 1]);
        const float mean = s * (1.0f / 512.0f);
        const float var = fmaxf(q * (1.0f / 512.0f) - mean * mean, 0.f);
        const float rstd = rsqrtf(var + LN_EPS);
        const unsigned v = xs[t * 256 + tid];
        float a = (bf_lo(v) - mean) * rstd * lg.x + lb.x, c = (bf_hi(v) - mean) * rstd * lg.y + lb.y;
        a = a * sigmoidf_(a); c = c * sigmoidf_(c);
        *(unsigned*)(p.ab + (size_t)(row0 + t) * DM + 2 * tid) = pk_bf16(a, c);
    }
    __syncthreads();
}

__device__ void attn_unit(const Params& p, int isS, int b, int t0, unsigned char* lds) {
    const int tid = opaque_tid(), lane = tid & 63, wid = tid >> 6, r = lane & 31, hh = lane >> 5;
    unsigned* sc = (unsigned*)lds;
    unsigned short* idxl = (unsigned short*)(lds + 4 * SS * 4) + wid * 256;
    const int row0 = isS ? TP + b * 64 + t0 : b * 4096 + t0;
    const int S = isS ? SS : ((t0 >> 6) + 1) * 64;
    const bf16_t* KI = isS ? p.kis + (size_t)b * SS * 64 : p.kip + (size_t)b * SP * 64;
    const bf16_t* Kc = isS ? p.ks + (size_t)b * SS * 128 : p.kp + (size_t)b * SP * 128;
    const bf16_t* Vc = isS ? p.vs + (size_t)b * SS * 128 : p.vp + (size_t)b * SP * 128;
    __syncthreads();
    {
        bf16x8 qf[4];
#pragma unroll
        for (int ks = 0; ks < 4; ++ks) qf[ks] = *(const bf16x8*)(p.qi + (size_t)(row0 + (r >> 3)) * 512 + (r & 7) * 64 + ks * 16 + hh * 8);
        float w[4][4];
#pragma unroll
        for (int q = 0; q < 4; ++q) { const float4 t = *(const float4*)(p.wi + (size_t)(row0 + q) * 8 + 4 * hh); w[q][0] = t.x; w[q][1] = t.y; w[q][2] = t.z; w[q][3] = t.w; }
        const int ntile = S >> 5;
        for (int kt = wid; kt < ntile; kt += 4) {
            const bf16_t* kr = KI + (size_t)(kt * 32 + r) * 64 + hh * 8;
            bf16x8 kf[4];
#pragma unroll
            for (int ks = 0; ks < 4; ++ks) kf[ks] = *(const bf16x8*)(kr + ks * 16);
            f32x16 d;
#pragma unroll
            for (int i = 0; i < 16; ++i) d[i] = 0.f;
#pragma unroll
            for (int ks = 0; ks < 4; ++ks) d = __builtin_amdgcn_mfma_f32_32x32x16_bf16(qf[ks], kf[ks], d, 0, 0, 0);
            float s[4];
#pragma unroll
            for (int q = 0; q < 4; ++q) {
                s[q] = (w[q][0] * fmaxf(d[4 * q], 0.f) + w[q][1] * fmaxf(d[4 * q + 1], 0.f)) + (w[q][2] * fmaxf(d[4 * q + 2], 0.f) + w[q][3] * fmaxf(d[4 * q + 3], 0.f));
                s[q] += __shfl_xor(s[q], 32);
                s[q] += 0.0f;
            }
            const float a0 = hh ? s[2] : s[0], a1 = hh ? s[3] : s[1];
            sc[(hh * 2) * SS + kt * 32 + r] = tokey(a0);
            sc[(hh * 2 + 1) * SS + kt * 32 + r] = tokey(a1);
        }
    }
    __syncthreads();
    const int Ksel = S < 256 ? S : 256;
    if (S <= 256) {
        for (int i = lane; i < S; i += 64) idxl[i] = (unsigned short)i;
    } else {
        unsigned key[65];
        const unsigned* myr = sc + wid * SS;
        const int nslot = S >> 6;
#pragma unroll
        for (int s = 0; s < 65; ++s) key[s] = (s < nslot) ? myr[s * 64 + lane] : 0u;
        unsigned P = 0; bool exact = false;
        for (int bit = 31; bit >= 0; --bit) {
            const unsigned C = P | (1u << bit);
            int cnt = 0;
#pragma unroll
            for (int s = 0; s < 65; ++s) cnt += __builtin_popcountll(__ballot(key[s] >= C));
            if (cnt >= 256) { P = C; if (cnt == 256) { exact = true; break; } }
        }
        const unsigned Tg = exact ? P - 1u : P;
        const unsigned long long lt = (1ull << lane) - 1ull;
        int base = 0;
#pragma unroll
        for (int s = 0; s < 65; ++s) {
            const bool g = key[s] > Tg;
            const unsigned long long m = __ballot(g);
            if (g) idxl[base + __builtin_popcountll(m & lt)] = (unsigned short)(s * 64 + lane);
            base += __builtin_popcountll(m);
        }
        const int need = 256 - base;
        if (need > 0) {
            int tb = 0;
#pragma unroll
            for (int s = 0; s < 65; ++s) {
                const bool e = (key[s] == Tg) && (s < nslot);
                const unsigned long long m = __ballot(e);
                const int rk = tb + __builtin_popcountll(m & lt);
                if (e && rk < need) idxl[base + rk] = (unsigned short)(s * 64 + lane);
                tb += __builtin_popcountll(m);
            }
        }
    }
    __syncthreads();
    const int row = row0 + wid;
    float* Pl = (float*)(sc + wid * SS);
    {
        bf16x8 qa[8];
#pragma unroll
        for (int ks = 0; ks < 8; ++ks) {
            const int kk = ks * 16 + hh * 8, g = kk >> 6, d = kk & 63;
            const bool valid = (r < 8) && ((r >> 2) == g);
            bf16x8 z;
#pragma unroll
            for (int j = 0; j < 8; ++j) z[j] = 0;
            qa[ks] = valid ? *(const bf16x8*)(p.q + (size_t)row * 512 + r * 64 + d) : z;
        }
#pragma unroll 1
        for (int tile = 0; tile < 8; ++tile) {
            const int key = tile * 32 + r;
            const int id = (key < Ksel) ? (int)idxl[key] : 0;
            const bf16_t* kr = Kc + (size_t)id * 128 + hh * 8;
            bf16x8 kf[8];
#pragma unroll
            for (int ks = 0; ks < 8; ++ks) kf[ks] = *(const bf16x8*)(kr + ks * 16);
            f32x16 d;
#pragma unroll
            for (int i = 0; i < 16; ++i) d[i] = 0.f;
#pragma unroll
            for (int ks = 0; ks < 8; ++ks) d = __builtin_amdgcn_mfma_f32_32x32x16_bf16(qa[ks], kf[ks], d, 0, 0, 0);
            const bool ok = key < Ksel;
            *(float4*)(Pl + key * 8 + 4 * hh) = make_float4(ok ? d[0] : -INFINITY, ok ? d[1] : -INFINITY, ok ? d[2] : -INFINITY, ok ? d[3] : -INFINITY);
        }
    }
    {
        float lg[8][4];
#pragma unroll
        for (int tile = 0; tile < 8; ++tile) { const float4 t = *(const float4*)(Pl + (tile * 32 + r) * 8 + 4 * hh); lg[tile][0] = t.x; lg[tile][1] = t.y; lg[tile][2] = t.z; lg[tile][3] = t.w; }
#pragma unroll
        for (int i = 0; i < 4; ++i) {
            float mx = lg[0][i];
#pragma unroll
            for (int tile = 1; tile < 8; ++tile) mx = fmaxf(mx, lg[tile][i]);
#pragma unroll
            for (int o = 16; o >= 1; o >>= 1) mx = fmaxf(mx, __shfl_xor(mx, o));
            float sm = 0.f;
#pragma unroll
            for (int tile = 0; tile < 8; ++tile) { lg[tile][i] = exp2f(lg[tile][i] - mx); sm += lg[tile][i]; }
#pragma unroll
            for (int o = 16; o >= 1; o >>= 1) sm += __shfl_xor(sm, o);
            const float inv = 1.0f / sm;
#pragma unroll
            for (int tile = 0; tile < 8; ++tile) lg[tile][i] *= inv;
        }
#pragma unroll
        for (int tile = 0; tile < 8; ++tile) *(float4*)(Pl + (tile * 32 + r) * 8 + 4 * hh) = make_float4(lg[tile][0], lg[tile][1], lg[tile][2], lg[tile][3]);
    }
    __syncthreads();
    {
        const int g = lane >> 5;
        float o0[4] = {0.f, 0.f, 0.f, 0.f}, o1[4] = {0.f, 0.f, 0.f, 0.f};
        for (int k0 = 0; k0 < Ksel; k0 += 8) {
            unsigned vv[8];
#pragma unroll
            for (int j = 0; j < 8; ++j) { const int id = idxl[k0 + j]; vv[j] = *(const unsigned*)(Vc + (size_t)id * 128 + 2 * lane); }
#pragma unroll
            for (int j = 0; j < 8; ++j) {
                const float4 pp = *(const float4*)(Pl + (k0 + j) * 8 + 4 * g);
                const float v0 = bf_lo(vv[j]), v1 = bf_hi(vv[j]);
                o0[0] += pp.x * v0; o1[0] += pp.x * v1; o0[1] += pp.y * v0; o1[1] += pp.y * v1;
                o0[2] += pp.z * v0; o1[2] += pp.z * v1; o0[3] += pp.w * v0; o1[3] += pp.w * v1;
            }
        }
#pragma unroll
        for (int i = 0; i < 4; ++i) *(unsigned*)(p.ab + (size_t)row * DM + 512 + (4 * g + i) * 64 + 2 * (lane & 31)) = pk_bf16(o0[i], o1[i]);
    }
}

__device__ void mixer_phase(const Params& p, int l, unsigned char* lds) {
    const int G = gridDim.x;
    {
        const int NU = 4352;
        for (int rd = 0; rd * G < NU; ++rd) {
            const int i = rd * G + ((rd & 1) ? (G - 1 - (int)blockIdx.x) : (int)blockIdx.x);
            if (i >= NU) continue;
            int isS, b, t0;
            if (i < 256) { isS = 1; b = i >> 4; t0 = (i & 15) * 4; }
            else { const int j = i - 256, c = 63 - (j >> 6), rr = j & 63; isS = 0; b = rr >> 4; t0 = c * 64 + (rr & 15) * 4; }
            attn_unit(p, isS, b, t0, lds);
        }
    }
    __syncthreads();
    for (int i = G - 1 - (int)blockIdx.x; i < 544; i += G) conv_unit(p, l, i, lds);
}


#define XB_TMO      128
#define XB_XCNT(j)  (256  + 64 * (j))
#define XB_XSUB(j)  (1280 + 64 * (j))
#define XB_XGEN(j)  (2304 + 64 * (j))
#define XB_TOP      3328
#define XB_TOPGEN   3392
#define XCD_BAR_WORDS 3456
#define XB_SPIN_CAP (1u << 20)
__device__ __forceinline__ unsigned xb_ld(unsigned* p)              { return __hip_atomic_load(p, __ATOMIC_RELAXED, __HIP_MEMORY_SCOPE_AGENT); }
__device__ __forceinline__ unsigned xb_add(unsigned* p, unsigned v) { return __hip_atomic_fetch_add(p, v, __ATOMIC_RELAXED, __HIP_MEMORY_SCOPE_AGENT); }
__device__ __forceinline__ unsigned xb_xcc_id() { return (unsigned)__builtin_amdgcn_s_getreg((3 << 11) | 20) & 0xFu; }
#define XB_SPIN(cond, bar) do { unsigned _sp = 0; while (cond) { __builtin_amdgcn_s_sleep(1); \
    if ((++_sp & 255u) == 0u) { if (xb_ld(&(bar)[XB_TMO])) break; if (_sp > XB_SPIN_CAP) { atomicAdd(&(bar)[XB_TMO], 1u); break; } } } } while (0)
struct XcdBarrier { unsigned* bar; unsigned x; volatile unsigned* st; };
__device__ __forceinline__ XcdBarrier xcd_barrier_post(unsigned* bar, volatile unsigned* st) {
    XcdBarrier b; b.bar = bar; b.x = xb_xcc_id(); b.st = st;
    if (threadIdx.x == 0) (void)xb_add(&bar[XB_XCNT(b.x)], 1u);
    return b;
}
__device__ __forceinline__ void xcd_barrier_complete(unsigned* bar, unsigned x, unsigned& nloc, unsigned& nx) {
    const unsigned G = gridDim.x * gridDim.y * gridDim.z;
    unsigned sum, cnt, mine, sp = 0u;
    for (;;) {
        sum = 0u; cnt = 0u; mine = 0u;
#pragma unroll
        for (unsigned j = 0; j < 16; ++j) { const unsigned c = xb_ld(&bar[XB_XCNT(j)]); sum += c; cnt += (c > 0u) ? 1u : 0u; mine = (j == x) ? c : mine; }
        if (sum == G) break;
        __builtin_amdgcn_s_sleep(1);
        if ((++sp & 255u) == 0u) { if (xb_ld(&bar[XB_TMO])) break; if (sp > XB_SPIN_CAP) { atomicAdd(&bar[XB_TMO], 1u); break; } }
    }
    nloc = mine > 0u ? mine : 1u; nx = cnt > 0u ? cnt : 1u;
}
__device__ __forceinline__ void xcd_barrier(const XcdBarrier& b) {
    asm volatile("s_waitcnt vmcnt(0)" ::: "memory");
    __syncthreads();
    if (threadIdx.x == 0) {
        unsigned* bar = b.bar;
        __builtin_amdgcn_s_waitcnt(0);
        unsigned nloc = b.st[0], nx = b.st[1];
        if (nloc == 0u) { xcd_barrier_complete(bar, b.x, nloc, nx); b.st[0] = nloc; b.st[1] = nx; }
        const unsigned old = xb_add(&bar[XB_XSUB(b.x)], 1u);
        const unsigned gen = old / nloc;
        if (old + 1u == (gen + 1u) * nloc) {
            __builtin_amdgcn_fence(__ATOMIC_RELEASE, "agent");
            asm volatile("s_waitcnt vmcnt(0)" ::: "memory");
            const unsigned og = xb_add(&bar[XB_TOP], 1u);
            const unsigned tg = og / nx;
            if (og + 1u == (tg + 1u) * nx) xb_add(&bar[XB_TOPGEN], 1u);
            else XB_SPIN(xb_ld(&bar[XB_TOPGEN]) == tg, bar);
            __builtin_amdgcn_fence(__ATOMIC_ACQUIRE, "agent");
            xb_add(&bar[XB_XGEN(b.x)], 1u);
            asm volatile("s_waitcnt vmcnt(0)" ::: "memory");
        } else {
            XB_SPIN(xb_ld(&bar[XB_XGEN(b.x)]) == gen, bar);
            __builtin_amdgcn_fence(__ATOMIC_ACQUIRE, "agent");
            asm volatile("s_waitcnt vmcnt(0)" ::: "memory");
        }
    }
    __syncthreads();
}

__device__ void run_phase(const Params& p, int ph, unsigned char* lds) {
#ifndef TEST_K
    if (ph == 0) { phase0(p, lds); return; }
#else
    if (TEST_K == 7) { phase0(p, lds); return; }
#endif
    const int l = (ph - 1) / 7, k = (ph - 1) % 7;
#ifdef TEST_K
    if (k != TEST_K) return;
#endif
    switch (k) {
        case 0: { EpiIn e{p, l}; gemm_phase(p.ab, p.win_t + (size_t)l * NINP * DM, DM, NINP / 128, lds, e); } break;
        case 1: mixer_phase(p, l, lds); break;
        case 2: { EpiWo e{p, l}; gemm_phase(p.ab, p.wo_t + (size_t)l * DM * DM, DM, DM / 128, lds, e); } break;
        case 3: ln_phase(p, l, 1); if (l == 0) convert_cache(p, 1); break;
        case 4: { EpiGu e{p}; gemm_phase(p.ab, p.wgu_t + (size_t)l * NGU * DM, DM, NGU / 128, lds, e); } break;
        case 5: { EpiDn e{p}; gemm_phase(p.act, p.wdn_t + (size_t)l * DM * DFF, DFF, DM / 128, lds, e); } break;
        case 6: ln_phase(p, l, 2); break;
    }
}

__global__ void __launch_bounds__(256, 2) mk(Params p, int ph_lo, int ph_hi) {
    extern __shared__ __attribute__((aligned(16))) unsigned char lds[];
#if MK_COOP
    volatile unsigned* st = (volatile unsigned*)(lds + LDS_BYTES);
    if (threadIdx.x == 0) { st[0] = 0u; st[1] = 0u; st[2] = 0u; st[3] = 0u; }
    __syncthreads();
    XcdBarrier xb = xcd_barrier_post(p.bar, st);
#endif
    for (int ph = ph_lo; ph < ph_hi; ++ph) {
        run_phase(p, ph, lds);
#if MK_COOP
        if (ph + 1 < ph_hi) xcd_barrier(xb);
#endif
    }
}

static inline size_t al256(size_t x) { return (x + 255) & ~(size_t)255; }

extern "C" void kernel_launch(void* const* d_in, const int* in_sizes, int n_in, void* d_out, int out_size, void* d_ws, size_t ws_size, hipStream_t stream) {
    static int grid = 0;
    if (grid == 0) {
        int dev = 0, cus = 0, per_cu = 0;
        hipGetDevice(&dev);
        hipDeviceGetAttribute(&cus, hipDeviceAttributeMultiprocessorCount, dev);
        if (hipFuncSetAttribute((const void*)mk, hipFuncAttributeMaxDynamicSharedMemorySize, LDS_BYTES + 16) != hipSuccess) { fprintf(stderr, "hipFuncSetAttribute failed\n"); grid = -1; return; }
        hipOccupancyMaxActiveBlocksPerMultiprocessor(&per_cu, (const void*)mk, 256, LDS_BYTES + 16);
        if (per_cu < 1) { fprintf(stderr, "occupancy query says %d\n", per_cu); grid = -1; return; }
        if (per_cu > 2) per_cu = 2;
        grid = cus * per_cu;
        fprintf(stderr, "grid %d (cus %d x %d)\n", grid, cus, per_cu);
    }
    if (grid < 0) return;
    Params p{};
    const float* const* in = (const float* const*)d_in;
    p.x_prompt = in[0]; p.x_sample = in[1]; p.cache_k = in[2]; p.cache_v = in[3]; p.cache_ki = in[4]; p.state_conv = in[5];
    p.w_in = in[6]; p.conv_w = in[7]; p.conv_b = in[8]; p.cln_g = in[9]; p.cln_b = in[10]; p.w_o = in[11]; p.ln1_g = in[12]; p.ln1_b = in[13];
    p.w_gu = in[14]; p.w_dn = in[15]; p.ln2_g = in[16]; p.ln2_b = in[17];
    p.out = (float*)d_out;
    unsigned char* w = (unsigned char*)d_ws; size_t off = 0;
    auto take = [&](size_t bytes) { unsigned char* r = w + off; off = al256(off + bytes); return r; };
    p.win_t = (bf16_t*)take((size_t)2 * NINP * DM * 2);
    p.wo_t = (bf16_t*)take((size_t)2 * DM * DM * 2);
    p.wgu_t = (bf16_t*)take((size_t)2 * NGU * DM * 2);
    p.wdn_t = (bf16_t*)take((size_t)2 * DM * DFF * 2);
    p.trig = (float2*)take((size_t)SS * 32 * 8);
    p.kp = (bf16_t*)take((size_t)4 * SP * 128 * 2); p.vp = (bf16_t*)take((size_t)4 * SP * 128 * 2); p.kip = (bf16_t*)take((size_t)4 * SP * 64 * 2);
    p.ks = (bf16_t*)take((size_t)16 * SS * 128 * 2); p.vs = (bf16_t*)take((size_t)16 * SS * 128 * 2); p.kis = (bf16_t*)take((size_t)16 * SS * 64 * 2);
    p.ab = (bf16_t*)take((size_t)TT * DM * 2);
    p.F = (float*)take((size_t)TT * DM * 4);
    unsigned char* big = take((size_t)TT * DFF * 2);
    p.act = (bf16_t*)big;
    p.u = (bf16_t*)big; p.q = (bf16_t*)(big + (size_t)TT * 512 * 2); p.qi = (bf16_t*)(big + (size_t)2 * TT * 512 * 2); p.wi = (float*)(big + (size_t)3 * TT * 512 * 2);
    p.bar = (unsigned*)take((size_t)XCD_BAR_WORDS * 4);
    if (off > ws_size) { fprintf(stderr, "workspace too small: need %zu have %zu\n", off, ws_size); return; }
#if MK_COOP
    if (hipMemsetAsync(p.bar, 0, (size_t)XCD_BAR_WORDS * 4, stream) != hipSuccess) { fprintf(stderr, "memset failed\n"); return; }
    int lo = 0, hi = 15;
    void* args[] = {&p, &lo, &hi};
    hipError_t e = hipLaunchCooperativeKernel((const void*)mk, dim3(grid), dim3(256), args, LDS_BYTES + 16, stream);
    if (e != hipSuccess) fprintf(stderr, "cooperative launch failed: %s (grid %d)\n", hipGetErrorString(e), grid);
#else
    for (int ph = 0; ph < 15; ++ph) hipLaunchKernelGGL(mk, dim3(grid), dim3(256), LDS_BYTES + 16, stream, p, ph, ph + 1);
#endif
}
```

```cpp
#include <hip/hip_runtime.h>
#include <hip/hip_cooperative_groups.h>
#include <cstdio>
#include <cstdint>
namespace cg = cooperative_groups;

#ifndef DUP_PART
#define DUP_PART 0
#endif
#ifndef MK_COOP
#define MK_COOP 1
#endif

typedef unsigned short bf16_t;
typedef short bf16x8 __attribute__((ext_vector_type(8)));
typedef float f32x4 __attribute__((ext_vector_type(4)));
typedef float f32x16 __attribute__((ext_vector_type(16)));
typedef unsigned u32x4 __attribute__((ext_vector_type(4)));

constexpr int DM = 1024, TP = 16384, TSM = 1024, TT = TP + TSM;
constexpr int NIN = 2376, NINP = 2432, DFF = 2816, NGU = 5632;
constexpr int SP = 4096, SS = 4160;
constexpr int LDS_BYTES = 4 * SS * 4 + 4 * 256 * 2;
constexpr float ALPHA = 1.4142135623730951f;
constexpr float LN_EPS = 1e-5f;

constexpr size_t O_YP = 0, O_YS = 16777216, O_KP = 17825792, O_VP = 22020096, O_KIP = 26214400, O_CP = 28311552,
                 O_KS = 28434432, O_VS = 28696576, O_KIS = 28958720, O_CS = 29089792;

struct Params {
    const float *x_prompt, *x_sample, *cache_k, *cache_v, *cache_ki, *state_conv;
    const float *w_in, *conv_w, *conv_b, *cln_g, *cln_b, *w_o, *ln1_g, *ln1_b, *w_gu, *w_dn, *ln2_g, *ln2_b;
    float* out;
    bf16_t *win_t, *wo_t, *wgu_t, *wdn_t;
    float2* trig;
    bf16_t *kp, *vp, *kip, *ks, *vs, *kis;
    bf16_t* ab;
    float* F;
    bf16_t *act, *u, *q, *qi;
    float* wi;
    unsigned* bar;
};

__device__ __forceinline__ unsigned pk_bf16(float lo, float hi) { unsigned r; asm volatile("v_cvt_pk_bf16_f32 %0, %1, %2" : "=v"(r) : "v"(lo), "v"(hi)); return r; }
__device__ __forceinline__ float bf_lo(unsigned v) { return __uint_as_float(v << 16); }
__device__ __forceinline__ float bf_hi(unsigned v) { return __uint_as_float(v & 0xffff0000u); }
__device__ __forceinline__ int opaque_tid() { int t = threadIdx.x; asm volatile("" : "+v"(t)); return t; }
__device__ __forceinline__ unsigned tokey(float f) { unsigned u = __float_as_uint(f); return (u & 0x80000000u) ? ~u : (u | 0x80000000u); }
__device__ __forceinline__ float sigmoidf_(float x) { return 1.0f / (1.0f + __expf(-x)); }

__device__ __forceinline__ int perm_in(int n) {
    const int g = n >> 6, w = n & 63;
    if (g < 16) return (w < 32) ? (32 * g + w) : (512 + 32 * g + (w - 32));
    const int c = 1024 + (g - 16) * 64 + w;
    return c < NIN ? c : -1;
}
__device__ __forceinline__ int perm_gu(int n) { const int g = n >> 6, w = n & 63; return (w < 32) ? (32 * g + w) : (DFF + 32 * g + (w - 32)); }

template <int MODE>
__device__ void transpose_tiles(const float* __restrict__ W, bf16_t* __restrict__ Wt, int K, int N, int Np, float* lds, int& cursor) {
    const int tk = K >> 6, tn = Np >> 6, nt = tk * tn, tid = opaque_tid();
    for (int t = 0; t < nt; ++t, ++cursor) {
        if ((cursor % (int)gridDim.x) != (int)blockIdx.x) continue;
        const int k0 = (t / tn) << 6, n0 = (t % tn) << 6;
        __syncthreads();
#pragma unroll
        for (int i = 0; i < 16; ++i) {
            const int k = i * 4 + (tid >> 6), n = tid & 63;
            int c = n0 + n; if (MODE == 1) c = perm_in(c); else if (MODE == 2) c = perm_gu(c);
            lds[k * 65 + n] = (c >= 0) ? W[(size_t)(k0 + k) * N + c] : 0.f;
        }
        __syncthreads();
#pragma unroll
        for (int i = 0; i < 8; ++i) {
            const int n = i * 8 + (tid >> 5), k = (tid & 31) * 2;
            *(unsigned*)(Wt + (size_t)(n0 + n) * K + k0 + k) = pk_bf16(lds[k * 65 + n], lds[(k + 1) * 65 + n]);
        }
    }
}

__device__ void convert_chunks(const float* __restrict__ src, bf16_t* __restrict__ dst, int nb, int chunk8  , int dst_stride8  ) {
    const int total = nb * chunk8;
    for (int i = blockIdx.x * 256 + opaque_tid(); i < total; i += gridDim.x * 256) {
        const int b = i / chunk8, r = i - b * chunk8;
        const float4 a = *(const float4*)(src + (size_t)i * 8), c = *(const float4*)(src + (size_t)i * 8 + 4);
        uint4 o; o.x = pk_bf16(a.x, a.y); o.y = pk_bf16(a.z, a.w); o.z = pk_bf16(c.x, c.y); o.w = pk_bf16(c.z, c.w);
        *(uint4*)(dst + ((size_t)b * dst_stride8 + r) * 8) = o;
    }
}
__device__ void convert_cache(const Params& p, int l) {
    convert_chunks(p.cache_k + (size_t)l * 16 * 4096 * 128, p.ks, 16, 4096 * 16, SS * 16);
    convert_chunks(p.cache_v + (size_t)l * 16 * 4096 * 128, p.vs, 16, 4096 * 16, SS * 16);
    convert_chunks(p.cache_ki + (size_t)l * 16 * 4096 * 64, p.kis, 16, 4096 * 8, SS * 8);
}

__device__ void phase0(const Params& p, unsigned char* lds) {
    int cursor = 0;
    for (int l = 0; l < 2; ++l) {
        transpose_tiles<1>(p.w_in + (size_t)l * DM * NIN, p.win_t + (size_t)l * NINP * DM, DM, NIN, NINP, (float*)lds, cursor);
        transpose_tiles<0>(p.w_o + (size_t)l * DM * DM, p.wo_t + (size_t)l * DM * DM, DM, DM, DM, (float*)lds, cursor);
        transpose_tiles<2>(p.w_gu + (size_t)l * DM * NGU, p.wgu_t + (size_t)l * NGU * DM, DM, NGU, NGU, (float*)lds, cursor);
        transpose_tiles<0>(p.w_dn + (size_t)l * DFF * DM, p.wdn_t + (size_t)l * DM * DFF, DFF, DM, DM, (float*)lds, cursor);
    }
    __syncthreads();
    convert_chunks(p.x_prompt, p.ab, 1, TP * 128, TP * 128);
    convert_chunks(p.x_sample, p.ab + (size_t)TP * DM, 1, TSM * 128, TSM * 128);
    convert_cache(p, 0);
    for (int i = blockIdx.x * 256 + opaque_tid(); i < SS * 32; i += gridDim.x * 256) {
        const int pos = i >> 5, f = i & 31;
        const float inv = exp2f(-(float)f * (13.287712379549449f / 32.0f));
        const float angf = (float)pos * inv;
        const double rev = (double)angf * 0.15915494309189535;
        const double fr = rev - __builtin_rint(rev);
        const float ang = (float)(fr * 6.283185307179586);
        p.trig[i] = make_float2(__cosf(ang), __sinf(ang));
    }
}

template <class Epi>
__device__ __forceinline__ void gemm_tile(const bf16_t* __restrict__ A, const bf16_t* __restrict__ Bt, int K, int row0, int col0, unsigned char* lds, const Epi& epi) {
    const int tid = opaque_tid(), lane = tid & 63, wid = tid >> 6, wr = wid >> 1, wc = wid & 1, fr = lane & 15, fq = lane >> 4;
    const int sc = tid & 7, sr = tid >> 3;
    const bf16_t* ag = A + (size_t)(row0 + sr) * K + sc * 8;
    const bf16_t* bg = Bt + (size_t)(col0 + sr) * K + sc * 8;
    u32x4 ra[4], rb[4];
    f32x4 acc[4][4];
#pragma unroll
    for (int m = 0; m < 4; ++m)
#pragma unroll
        for (int n = 0; n < 4; ++n) acc[m][n] = (f32x4){0.f, 0.f, 0.f, 0.f};
    const int soff = sr * 128 + ((sc ^ ((sr >> 1) & 7)) << 4);
    const int nk = K >> 6;
#pragma unroll
    for (int i = 0; i < 4; ++i) { ra[i] = *(const u32x4*)(ag + (size_t)i * 32 * K); rb[i] = *(const u32x4*)(bg + (size_t)i * 32 * K); }
    __syncthreads();
#pragma unroll
    for (int i = 0; i < 4; ++i) { *(u32x4*)(lds + soff + i * 4096) = ra[i]; *(u32x4*)(lds + 16384 + soff + i * 4096) = rb[i]; }
    __syncthreads();
    const int swz = (fr >> 1) & 7;
    for (int kt = 0; kt < nk; ++kt) {
        if (kt + 1 < nk) {
#pragma unroll
            for (int i = 0; i < 4; ++i) { ra[i] = *(const u32x4*)(ag + (size_t)i * 32 * K + (kt + 1) * 64); rb[i] = *(const u32x4*)(bg + (size_t)i * 32 * K + (kt + 1) * 64); }
        }
        const unsigned char* ba = lds + (kt & 1) * 32768;
        const unsigned char* bb = ba + 16384;
#pragma unroll
        for (int ks = 0; ks < 2; ++ks) {
            bf16x8 af[4], bfr[4];
            const int ch = ((ks * 4 + fq) ^ swz) << 4;
#pragma unroll
            for (int m = 0; m < 4; ++m) af[m] = *(const bf16x8*)(ba + (wr * 64 + m * 16 + fr) * 128 + ch);
#pragma unroll
            for (int n = 0; n < 4; ++n) bfr[n] = *(const bf16x8*)(bb + (wc * 64 + n * 16 + fr) * 128 + ch);
#pragma unroll
            for (int m = 0; m < 4; ++m)
#pragma unroll
                for (int n = 0; n < 4; ++n) acc[m][n] = __builtin_amdgcn_mfma_f32_16x16x32_bf16(bfr[n], af[m], acc[m][n], 0, 0, 0);
        }
        if (kt + 1 < nk) {
            unsigned char* d = lds + ((kt + 1) & 1) * 32768;
#pragma unroll
            for (int i = 0; i < 4; ++i) { *(u32x4*)(d + soff + i * 4096) = ra[i]; *(u32x4*)(d + 16384 + soff + i * 4096) = rb[i]; }
        }
        __syncthreads();
    }
    epi(acc, row0 + wr * 64, col0 + wc * 64, fr, fq);
}

template <class Epi>
__device__ void gemm_phase(const bf16_t* A, const bf16_t* Bt, int K, int nN, unsigned char* lds, const Epi& epi) {
    const int nt = (TT / 128) * nN;
    for (int t = blockIdx.x; t < nt; t += gridDim.x) {
        const int mt = t / nN, ntile = t - mt * nN;
        gemm_tile(A, Bt, K, mt * 128, ntile * 128, lds, epi);
    }
}

__device__ __forceinline__ void tok_decode(int row, bool& isS, int& b, int& t, int& pos) {
    isS = row >= TP;
    if (!isS) { b = row >> 12; t = row & 4095; pos = t; } else { const int r = row - TP; b = r >> 6; t = r & 63; pos = 4096 + t; }
}

struct EpiIn {
    Params p; int l;
    __device__ __forceinline__ void operator()(f32x4 (&acc)[4][4], int rbase, int cbase, int fr, int fq) const {
        const int G = cbase >> 6;
#pragma unroll
        for (int m = 0; m < 4; ++m) {
            const int row = rbase + m * 16 + fr;
            bool isS; int b, t, pos; tok_decode(row, isS, b, t, pos);
            if (G < 16) {
                const int tl = isS ? t - 34 : t - 4066;
#pragma unroll
                for (int n = 0; n < 2; ++n) {
                    const int ch = 32 * G + n * 16 + fq * 4;
                    float u[4];
#pragma unroll
                    for (int j = 0; j < 4; ++j) u[j] = acc[m][n][j] * sigmoidf_(acc[m][n + 2][j]);
                    uint2 w; w.x = pk_bf16(u[0], u[1]); w.y = pk_bf16(u[2], u[3]);
                    *(uint2*)(p.u + (size_t)row * 512 + ch) = w;
                    if (tl >= 0) {
                        float* o = p.out + (isS ? O_CS + ((size_t)(l * 16 + b) * 30 + tl) * 512 : O_CP + ((size_t)(l * 4 + b) * 30 + tl) * 512) + ch;
                        *(float4*)o = make_float4(u[0], u[1], u[2], u[3]);
                    }
                }
            } else if (G == 26 || G == 27) {
                const int kvh = G - 26;
                float* o = p.out + (isS ? O_VS + (((size_t)(l * 16 + b) * 64 + t) * 2 + kvh) * 64 : O_VP + (((size_t)(l * 4 + b) * 4096 + t) * 2 + kvh) * 64);
                bf16_t* vb = (isS ? p.vs + ((size_t)b * SS + 4096 + t) * 128 : p.vp + ((size_t)b * SP + t) * 128) + kvh * 64;
#pragma unroll
                for (int n = 0; n < 4; ++n) {
                    const int d = n * 16 + fq * 4;
                    *(float4*)(o + d) = make_float4(acc[m][n][0], acc[m][n][1], acc[m][n][2], acc[m][n][3]);
                    uint2 w; w.x = pk_bf16(acc[m][n][0], acc[m][n][1]); w.y = pk_bf16(acc[m][n][2], acc[m][n][3]);
                    *(uint2*)(vb + d) = w;
                }
            } else if (G == 37) {
                if (fq < 2) {
                    const float s = 0.35355339059327373f * 0.125f;
                    *(float4*)(p.wi + (size_t)row * 8 + fq * 4) = make_float4(acc[m][0][0] * s, acc[m][0][1] * s, acc[m][0][2] * s, acc[m][0][3] * s);
                }
            } else {
                float o1[2][4], o2[2][4];
#pragma unroll
                for (int n = 0; n < 2; ++n) {
                    const float4* tp = (const float4*)(p.trig + (size_t)pos * 32 + n * 16 + fq * 4);
                    const float4 t0 = tp[0], t1 = tp[1];
                    const float cs[4] = {t0.x, t0.z, t1.x, t1.z}, sn[4] = {t0.y, t0.w, t1.y, t1.w};
#pragma unroll
                    for (int j = 0; j < 4; ++j) {
                        const float x1 = acc[m][n][j], x2 = acc[m][n + 2][j];
                        o1[n][j] = x1 * cs[j] - x2 * sn[j];
                        o2[n][j] = x2 * cs[j] + x1 * sn[j];
                    }
                }
                if (G < 24 || (G >= 28 && G < 36)) {
                    const bool isq = G < 24;
                    const float s = isq ? 0.125f * 1.4426950408889634f : 1.0f;
                    bf16_t* dst = (isq ? p.q + (size_t)row * 512 + (G - 16) * 64 : p.qi + (size_t)row * 512 + (G - 28) * 64);
#pragma unroll
                    for (int n = 0; n < 2; ++n) {
                        const int d = n * 16 + fq * 4;
                        uint2 w; w.x = pk_bf16(o1[n][0] * s, o1[n][1] * s); w.y = pk_bf16(o1[n][2] * s, o1[n][3] * s);
                        *(uint2*)(dst + d) = w;
                        w.x = pk_bf16(o2[n][0] * s, o2[n][1] * s); w.y = pk_bf16(o2[n][2] * s, o2[n][3] * s);
                        *(uint2*)(dst + d + 32) = w;
                    }
                } else if (G == 24 || G == 25) {
                    const int kvh = G - 24;
                    float* o = p.out + (isS ? O_KS + (((size_t)(l * 16 + b) * 64 + t) * 2 + kvh) * 64 : O_KP + (((size_t)(l * 4 + b) * 4096 + t) * 2 + kvh) * 64);
                    bf16_t* kb = (isS ? p.ks + ((size_t)b * SS + 4096 + t) * 128 : p.kp + ((size_t)b * SP + t) * 128) + kvh * 64;
#pragma unroll
                    for (int n = 0; n < 2; ++n) {
                        const int d = n * 16 + fq * 4;
                        *(float4*)(o + d) = make_float4(o1[n][0], o1[n][1], o1[n][2], o1[n][3]);
                        *(float4*)(o + d + 32) = make_float4(o2[n][0], o2[n][1], o2[n][2], o2[n][3]);
                        uint2 w; w.x = pk_bf16(o1[n][0], o1[n][1]); w.y = pk_bf16(o1[n][2], o1[n][3]);
                        *(uint2*)(kb + d) = w;
                        w.x = pk_bf16(o2[n][0], o2[n][1]); w.y = pk_bf16(o2[n][2], o2[n][3]);
                        *(uint2*)(kb + d + 32) = w;
                    }
                } else {
                    float* o = p.out + (isS ? O_KIS + ((size_t)(l * 16 + b) * 64 + t) * 64 : O_KIP + ((size_t)(l * 4 + b) * 4096 + t) * 64);
                    bf16_t* kb = (isS ? p.kis + ((size_t)b * SS + 4096 + t) * 64 : p.kip + ((size_t)b * SP + t) * 64);
#pragma unroll
                    for (int n = 0; n < 2; ++n) {
                        const int d = n * 16 + fq * 4;
                        *(float4*)(o + d) = make_float4(o1[n][0], o1[n][1], o1[n][2], o1[n][3]);
                        *(float4*)(o + d + 32) = make_float4(o2[n][0], o2[n][1], o2[n][2], o2[n][3]);
                        uint2 w; w.x = pk_bf16(o1[n][0], o1[n][1]); w.y = pk_bf16(o1[n][2], o1[n][3]);
                        *(uint2*)(kb + d) = w;
                        w.x = pk_bf16(o2[n][0], o2[n][1]); w.y = pk_bf16(o2[n][2], o2[n][3]);
                        *(uint2*)(kb + d + 32) = w;
                    }
                }
            }
        }
    }
};

struct EpiWo {
    Params p; int l;
    __device__ __forceinline__ void operator()(f32x4 (&acc)[4][4], int rbase, int cbase, int fr, int fq) const {
#pragma unroll
        for (int m = 0; m < 4; ++m) {
            const int row = rbase + m * 16 + fr;
            const float* xr = (l == 0) ? ((row < TP) ? p.x_prompt + (size_t)row * DM : p.x_sample + (size_t)(row - TP) * DM) : p.F + (size_t)row * DM;
            float* fo = p.F + (size_t)row * DM;
#pragma unroll
            for (int n = 0; n < 4; ++n) {
                const int c = cbase + n * 16 + fq * 4;
                const float4 x = *(const float4*)(xr + c);
                *(float4*)(fo + c) = make_float4(ALPHA * x.x + acc[m][n][0], ALPHA * x.y + acc[m][n][1], ALPHA * x.z + acc[m][n][2], ALPHA * x.w + acc[m][n][3]);
            }
        }
    }
};
struct EpiGu {
    Params p;
    __device__ __forceinline__ void operator()(f32x4 (&acc)[4][4], int rbase, int cbase, int fr, int fq) const {
        const int G = cbase >> 6;
#pragma unroll
        for (int m = 0; m < 4; ++m) {
            const int row = rbase + m * 16 + fr;
#pragma unroll
            for (int n = 0; n < 2; ++n) {
                float a[4];
#pragma unroll
                for (int j = 0; j < 4; ++j) { const float g = acc[m][n][j]; a[j] = g * sigmoidf_(g) * acc[m][n + 2][j]; }
                uint2 w; w.x = pk_bf16(a[0], a[1]); w.y = pk_bf16(a[2], a[3]);
                *(uint2*)(p.act + (size_t)row * DFF + 32 * G + n * 16 + fq * 4) = w;
            }
        }
    }
};
struct EpiDn {
    Params p;
    __device__ __forceinline__ void operator()(f32x4 (&acc)[4][4], int rbase, int cbase, int fr, int fq) const {
#pragma unroll
        for (int m = 0; m < 4; ++m) {
            float* fo = p.F + (size_t)(rbase + m * 16 + fr) * DM;
#pragma unroll
            for (int n = 0; n < 4; ++n) {
                const int c = cbase + n * 16 + fq * 4;
                const float4 x = *(const float4*)(fo + c);
                *(float4*)(fo + c) = make_float4(ALPHA * x.x + acc[m][n][0], ALPHA * x.y + acc[m][n][1], ALPHA * x.z + acc[m][n][2], ALPHA * x.w + acc[m][n][3]);
            }
        }
    }
};

__device__ void ln_phase(const Params& p, int l, int which) {
    const int tid = opaque_tid(), lane = tid & 63, wid = tid >> 6;
    const float* g = (which == 1 ? p.ln1_g : p.ln2_g) + l * DM;
    const float* bb = (which == 1 ? p.ln1_b : p.ln2_b) + l * DM;
    const bool fin = (which == 2 && l == 1);
    for (int row = blockIdx.x * 4 + wid; row < TT; row += gridDim.x * 4) {
        float* fr = p.F + (size_t)row * DM;
        float4 v[4];
        float s = 0.f;
#pragma unroll
        for (int i = 0; i < 4; ++i) { v[i] = *(const float4*)(fr + i * 256 + lane * 4); s += (v[i].x + v[i].y) + (v[i].z + v[i].w); }
#pragma unroll
        for (int o = 32; o >= 1; o >>= 1) s += __shfl_xor(s, o);
        const float mean = s * (1.0f / 1024.0f);
        float q = 0.f;
#pragma unroll
        for (int i = 0; i < 4; ++i) { const float a = v[i].x - mean, b = v[i].y - mean, c = v[i].z - mean, d = v[i].w - mean; q += (a * a + b * b) + (c * c + d * d); }
#pragma unroll
        for (int o = 32; o >= 1; o >>= 1) q += __shfl_xor(q, o);
        const float rstd = rsqrtf(q * (1.0f / 1024.0f) + LN_EPS);
#pragma unroll
        for (int i = 0; i < 4; ++i) {
            const int c = i * 256 + lane * 4;
            const float4 gg = *(const float4*)(g + c), be = *(const float4*)(bb + c);
            const float4 o = make_float4((v[i].x - mean) * rstd * gg.x + be.x, (v[i].y - mean) * rstd * gg.y + be.y, (v[i].z - mean) * rstd * gg.z + be.z, (v[i].w - mean) * rstd * gg.w + be.w);
            if (fin) *(float4*)(p.out + (size_t)row * DM + c) = o;
            else {
                *(float4*)(fr + c) = o;
                uint2 w; w.x = pk_bf16(o.x, o.y); w.y = pk_bf16(o.z, o.w);
                *(uint2*)(p.ab + (size_t)row * DM + c) = w;
            }
        }
    }
}

__device__ __forceinline__ void conv_unit(const Params& p, int l, int cu, unsigned char* lds) {
    const int tid = opaque_tid(), lane = tid & 63, wid = tid >> 6;
    const int row0 = cu * 16;
    bool isS; int b, t0, pos; tok_decode(row0, isS, b, t0, pos);
    const int seq_row0 = row0 - t0;
    unsigned* xs = (unsigned*)lds;
    float* red = (float*)(lds + 46 * 1024);
    const unsigned* ug = (const unsigned*)p.u;
    __syncthreads();
    {
        const int nneg = t0 < 30 ? 30 - t0 : 0;
#pragma unroll
        for (int i = 0; i < 46; ++i) {
            const int tok = t0 - 30 + i;
            const int tokc = tok < 0 ? 0 : tok;
            unsigned v = ug[(size_t)(seq_row0 + tokc) * 256 + tid];
            if (i < 30 && i < nneg) {
                v = 0u;
                if (isS) { const float2 s = *(const float2*)(p.state_conv + ((size_t)(l * 16 + b) * 30 + (30 + tok)) * 512 + 2 * tid); v = pk_bf16(s.x, s.y); }
            }
            xs[i * 256 + tid] = v;
        }
    }
    float cw0[31], cw1[31];
#pragma unroll
    for (int w = 0; w < 31; ++w) { const float2 c = *(const float2*)(p.conv_w + ((size_t)l * 31 + w) * 512 + 2 * tid); cw0[w] = c.x; cw1[w] = c.y; }
    const float2 cb = *(const float2*)(p.conv_b + l * 512 + 2 * tid);
#pragma unroll 2
    for (int t = 0; t < 16; ++t) {
        float a0 = cb.x, a1 = cb.y;
        const unsigned* xr = xs + t * 256 + tid;
#pragma unroll
        for (int w = 0; w < 31; ++w) { const unsigned v = xr[w * 256]; a0 += bf_lo(v) * cw0[w]; a1 += bf_hi(v) * cw1[w]; }
        float s = a0 + a1, q = a0 * a0 + a1 * a1;
#pragma unroll
        for (int o = 32; o >= 1; o >>= 1) { s += __shfl_xor(s, o); q += __shfl_xor(q, o); }
        if (lane == 0) { red[(wid * 16 + t) * 2] = s; red[(wid * 16 + t) * 2 + 1] = q; }
        xs[t * 256 + tid] = pk_bf16(a0, a1);
    }
    __syncthreads();
    const float2 lg = *(const float2*)(p.cln_g + l * 512 + 2 * tid);
    const float2 lb = *(const float2*)(p.cln_b + l * 512 + 2 * tid);
#pragma unroll 4
    for (int t = 0; t < 16; ++t) {
        const float s = (red[t * 2] + red[(16 + t) * 2]) + (red[(32 + t) * 2] + red[(48 + t) * 2]);
        const float q = (red[t * 2 + 1] + red[(16 + t) * 2 + 1]) + (red[(32 + t) * 2 + 1] + red[(48 + t) * 2 + 1]);
        const float mean = s * (1.0f / 512.0f);
        const float var = fmaxf(q * (1.0f / 512.0f) - mean * mean, 0.f);
        const float rstd = rsqrtf(var + LN_EPS);
        const unsigned v = xs[t * 256 + tid];
        float a = (bf_lo(v) - mean) * rstd * lg.x + lb.x, c = (bf_hi(v) - mean) * rstd * lg.y + lb.y;
        a = a * sigmoidf_(a); c = c * sigmoidf_(c);
        *(unsigned*)(p.ab + (size_t)(row0 + t) * DM + 2 * tid) = pk_bf16(a, c);
    }
    __syncthreads();
}

__device__ __forceinline__ void attn_unit(const Params& p, int isS, int b, int t0, unsigned char* lds) {
    const int tid = opaque_tid(), lane = tid & 63, wid = tid >> 6, r = lane & 31, hh = lane >> 5;
    unsigned* sc = (unsigned*)lds;
    unsigned short* idxl = (unsigned short*)(lds + 4 * SS * 4) + wid * 256;
    const int row0 = isS ? TP + b * 64 + t0 : b * 4096 + t0;
    const int S = isS ? SS : ((t0 >> 6) + 1) * 64;
    const bf16_t* KI = isS ? p.kis + (size_t)b * SS * 64 : p.kip + (size_t)b * SP * 64;
    const bf16_t* Kc = isS ? p.ks + (size_t)b * SS * 128 : p.kp + (size_t)b * SP * 128;
    const bf16_t* Vc = isS ? p.vs + (size_t)b * SS * 128 : p.vp + (size_t)b * SP * 128;
    __syncthreads();
    {
        bf16x8 qf[4];
#pragma unroll
        for (int ks = 0; ks < 4; ++ks) qf[ks] = *(const bf16x8*)(p.qi + (size_t)(row0 + (r >> 3)) * 512 + (r & 7) * 64 + ks * 16 + hh * 8);
        float w[4][4];
#pragma unroll
        for (int q = 0; q < 4; ++q) { const float4 t = *(const float4*)(p.wi + (size_t)(row0 + q) * 8 + 4 * hh); w[q][0] = t.x; w[q][1] = t.y; w[q][2] = t.z; w[q][3] = t.w; }
        const int ntile = S >> 5;
        auto ldk = [&](int kt, bf16x8 (&kf)[4]) {
            const bf16_t* kr = KI + (size_t)(kt * 32 + r) * 64 + hh * 8;
#pragma unroll
            for (int ks = 0; ks < 4; ++ks) kf[ks] = *(const bf16x8*)(kr + ks * 16);
        };
        auto comp = [&](int kt, const bf16x8 (&kf)[4]) {
            f32x16 d;
#pragma unroll
            for (int i = 0; i < 16; ++i) d[i] = 0.f;
#pragma unroll
            for (int ks = 0; ks < 4; ++ks) d = __builtin_amdgcn_mfma_f32_32x32x16_bf16(qf[ks], kf[ks], d, 0, 0, 0);
            float s[4];
#pragma unroll
            for (int q = 0; q < 4; ++q) {
                s[q] = (w[q][0] * fmaxf(d[4 * q], 0.f) + w[q][1] * fmaxf(d[4 * q + 1], 0.f)) + (w[q][2] * fmaxf(d[4 * q + 2], 0.f) + w[q][3] * fmaxf(d[4 * q + 3], 0.f));
                s[q] += __shfl_xor(s[q], 32);
                s[q] += 0.0f;
            }
            const float a0 = hh ? s[2] : s[0], a1 = hh ? s[3] : s[1];
            sc[(hh * 2) * SS + kt * 32 + r] = tokey(a0);
            sc[(hh * 2 + 1) * SS + kt * 32 + r] = tokey(a1);
        };
        for (int rep = 0; rep < (DUP_PART == 1 ? 2 : 1); ++rep) {
        bf16x8 ka[4], kb[4];
        int kt = wid;
        if (kt < ntile) ldk(kt, ka);
        for (; kt < ntile; kt += 8) {
            if (kt + 4 < ntile) ldk(kt + 4, kb);
            comp(kt, ka);
            if (kt + 8 < ntile) ldk(kt + 8, ka);
            if (kt + 4 < ntile) comp(kt + 4, kb);
        }
        }
    }
    __syncthreads();
    const int Ksel = S < 256 ? S : 256;
    for (int rep = 0; rep < (DUP_PART == 2 ? 2 : 1); ++rep)
    if (S <= 256) {
        for (int i = lane; i < S; i += 64) idxl[i] = (unsigned short)i;
    } else {
        unsigned key[65];
        const unsigned* myr = sc + wid * SS;
        const int nslot = S >> 6;
#pragma unroll
        for (int s = 0; s < 65; ++s) key[s] = (s < nslot) ? myr[s * 64 + lane] : 0u;
        unsigned P = 0; bool exact = false;
        for (int bit = 31; bit >= 0; --bit) {
            const unsigned C = P | (1u << bit);
            int cnt = 0;
#pragma unroll
            for (int sg = 0; sg < 13; ++sg) {
                if (sg * 5 < nslot) {
#pragma unroll
                    for (int s = sg * 5; s < sg * 5 + 5; ++s) cnt += __builtin_popcountll(__ballot(key[s] >= C));
                }
            }
            if (cnt >= 256) { P = C; if (cnt == 256) { exact = true; break; } }
        }
        const unsigned Tg = exact ? P - 1u : P;
        const unsigned long long lt = (1ull << lane) - 1ull;
        int base = 0;
#pragma unroll
        for (int sg = 0; sg < 13; ++sg) {
            if (sg * 5 < nslot) {
#pragma unroll
                for (int s = sg * 5; s < sg * 5 + 5; ++s) {
                    const bool g = key[s] > Tg;
                    const unsigned long long m = __ballot(g);
                    if (g) idxl[base + __builtin_popcountll(m & lt)] = (unsigned short)(s * 64 + lane);
                    base += __builtin_popcountll(m);
                }
            }
        }
        const int need = 256 - base;
        if (need > 0) {
            int tb = 0;
#pragma unroll
            for (int s = 0; s < 65; ++s) {
                const bool e = (key[s] == Tg) && (s < nslot);
                const unsigned long long m = __ballot(e);
                const int rk = tb + __builtin_popcountll(m & lt);
                if (e && rk < need) idxl[base + rk] = (unsigned short)(s * 64 + lane);
                tb += __builtin_popcountll(m);
            }
        }
    }
    __syncthreads();
    const int row = row0 + wid;
    float* Pl = (float*)(sc + wid * SS);
    for (int rep = 0; rep < (DUP_PART == 3 ? 2 : 1); ++rep) {
    {
        bf16x8 qa[8];
#pragma unroll
        for (int ks = 0; ks < 8; ++ks) {
            const int kk = ks * 16 + hh * 8, g = kk >> 6, d = kk & 63;
            const bool valid = (r < 8) && ((r >> 2) == g);
            bf16x8 z;
#pragma unroll
            for (int j = 0; j < 8; ++j) z[j] = 0;
            qa[ks] = valid ? *(const bf16x8*)(p.q + (size_t)row * 512 + r * 64 + d) : z;
        }
        auto ldq = [&](int tile, bf16x8 (&kf)[8]) {
            const int key = tile * 32 + r;
            const int id = (key < Ksel) ? (int)idxl[key] : 0;
            const bf16_t* kr = Kc + (size_t)id * 128 + hh * 8;
#pragma unroll
            for (int ks = 0; ks < 8; ++ks) kf[ks] = *(const bf16x8*)(kr + ks * 16);
        };
        auto cmq = [&](int tile, const bf16x8 (&kf)[8]) {
            const int key = tile * 32 + r;
            f32x16 d;
#pragma unroll
            for (int i = 0; i < 16; ++i) d[i] = 0.f;
#pragma unroll
            for (int ks = 0; ks < 8; ++ks) d = __builtin_amdgcn_mfma_f32_32x32x16_bf16(qa[ks], kf[ks], d, 0, 0, 0);
            const bool ok = key < Ksel;
            *(float4*)(Pl + key * 8 + 4 * hh) = make_float4(ok ? d[0] : -INFINITY, ok ? d[1] : -INFINITY, ok ? d[2] : -INFINITY, ok ? d[3] : -INFINITY);
        };
        bf16x8 ka[8], kb[8];
        ldq(0, ka);
#pragma unroll 1
        for (int tile = 0; tile < 8; tile += 2) {
            ldq(tile + 1, kb);
            cmq(tile, ka);
            if (tile + 2 < 8) ldq(tile + 2, ka);
            cmq(tile + 1, kb);
        }
    }
    {
        float lg[8][4];
#pragma unroll
        for (int tile = 0; tile < 8; ++tile) { const float4 t = *(const float4*)(Pl + (tile * 32 + r) * 8 + 4 * hh); lg[tile][0] = t.x; lg[tile][1] = t.y; lg[tile][2] = t.z; lg[tile][3] = t.w; }
#pragma unroll
        for (int i = 0; i < 4; ++i) {
            float mx = lg[0][i];
#pragma unroll
            for (int tile = 1; tile < 8; ++tile) mx = fmaxf(mx, lg[tile][i]);
#pragma unroll
            for (int o = 16; o >= 1; o >>= 1) mx = fmaxf(mx, __shfl_xor(mx, o));
            float sm = 0.f;
#pragma unroll
            for (int tile = 0; tile < 8; ++tile) { lg[tile][i] = exp2f(lg[tile][i] - mx); sm += lg[tile][i]; }
#pragma unroll
            for (int o = 16; o >= 1; o >>= 1) sm += __shfl_xor(sm, o);
            const float inv = 1.0f / sm;
#pragma unroll
            for (int tile = 0; tile < 8; ++tile) lg[tile][i] *= inv;
        }
#pragma unroll
        for (int tile = 0; tile < 8; ++tile) *(float4*)(Pl + (tile * 32 + r) * 8 + 4 * hh) = make_float4(lg[tile][0], lg[tile][1], lg[tile][2], lg[tile][3]);
    }
    }
    __syncthreads();
    {
        const int sub = lane & 15, kq = lane >> 4, g = sub >> 3;
        typedef float f32x2 __attribute__((ext_vector_type(2)));
        f32x2 acc[4][4];
        for (int rep = 0; rep < (DUP_PART == 4 ? 2 : 1); ++rep) {
#pragma unroll
        for (int h = 0; h < 4; ++h)
#pragma unroll
            for (int i = 0; i < 4; ++i) acc[h][i] = (f32x2){0.f, 0.f};
        auto ldv = [&](int k0, u32x4 (&v)[8]) {
#pragma unroll
            for (int j = 0; j < 8; ++j) { const int id = idxl[k0 + 4 * j + kq]; v[j] = *(const u32x4*)(Vc + (size_t)id * 128 + sub * 8); }
        };
        auto cmv = [&](int k0, const u32x4 (&v)[8]) {
#pragma unroll
            for (int j = 0; j < 8; ++j) {
                const float4 pp = *(const float4*)(Pl + (k0 + 4 * j + kq) * 8 + 4 * g);
                const float ph[4] = {pp.x, pp.y, pp.z, pp.w};
#pragma unroll
                for (int i = 0; i < 4; ++i) {
                    const f32x2 vv = (f32x2){bf_lo(v[j][i]), bf_hi(v[j][i])};
#pragma unroll
                    for (int h = 0; h < 4; ++h) acc[h][i] += vv * ph[h];
                }
            }
        };
        u32x4 va[8], vb[8];
        ldv(0, va);
#pragma unroll 1
        for (int k0 = 0; k0 < Ksel; k0 += 64) {
            if (k0 + 32 < Ksel) ldv(k0 + 32, vb);
            cmv(k0, va);
            if (k0 + 64 < Ksel) ldv(k0 + 64, va);
            if (k0 + 32 < Ksel) cmv(k0 + 32, vb);
        }
        }
#pragma unroll
        for (int h = 0; h < 4; ++h)
#pragma unroll
            for (int i = 0; i < 4; ++i) {
                float x = acc[h][i].x, y = acc[h][i].y;
                x += __shfl_xor(x, 16); y += __shfl_xor(y, 16);
                x += __shfl_xor(x, 32); y += __shfl_xor(y, 32);
                acc[h][i] = (f32x2){x, y};
            }
        if (kq == 0) {
#pragma unroll
            for (int h = 0; h < 4; ++h) {
                u32x4 w;
                w.x = pk_bf16(acc[h][0].x, acc[h][0].y); w.y = pk_bf16(acc[h][1].x, acc[h][1].y);
                w.z = pk_bf16(acc[h][2].x, acc[h][2].y); w.w = pk_bf16(acc[h][3].x, acc[h][3].y);
                *(u32x4*)(p.ab + (size_t)row * DM + 512 + (4 * g + h) * 64 + (sub & 7) * 8) = w;
            }
        }
    }
}

__device__ __forceinline__ void mixer_unit(const Params& p, int l, int pair, int u, unsigned char* lds) {
    if (u < 1088) {
        int isS, b, t0;
        if (u < 64) { isS = 1; b = 4 * pair + (u >> 4); t0 = (u & 15) * 4; }
        else { const int j = u - 64; isS = 0; b = pair; t0 = (63 - (j >> 4)) * 64 + (j & 15) * 4; }
        attn_unit(p, isS, b, t0, lds);
    } else { const int j = u - 1088; conv_unit(p, l, (j < 256) ? pair * 256 + j : 1024 + pair * 16 + (j - 256), lds); }
}
__device__ __forceinline__ void mixer_phase(const Params& p, int l, unsigned char* lds) {
    const int G = gridDim.x;
    const bool fast = (G == 512);
    const int x = blockIdx.x & 7, jb = blockIdx.x >> 3, rb = (x & 1) * 64 + jb;
    const int nrd = fast ? 11 : (4 * 1360 + G - 1) / G;
    for (int rd = 0; rd < nrd; ++rd) {
        int pair, u; bool valid;
        if (fast) { u = rd * 128 + ((rd & 1) ? (127 - rb) : rb); pair = x >> 1; valid = u < 1360; }
        else { const int i = rd * G + (int)blockIdx.x; valid = i < 4 * 1360; pair = i / 1360; u = i - pair * 1360; }
        if (valid) mixer_unit(p, l, pair, u, lds);
    }
}

#define XB_TMO      128
#define XB_XCNT(j)  (256  + 64 * (j))
#define XB_XSUB(j)  (1280 + 64 * (j))
#define XB_XGEN(j)  (2304 + 64 * (j))
#define XB_TOP      3328
#define XB_TOPGEN   3392
#define XCD_BAR_WORDS 3456
#define XB_SPIN_CAP (1u << 20)
__device__ __forceinline__ unsigned xb_ld(unsigned* p)              { return __hip_atomic_load(p, __ATOMIC_RELAXED, __HIP_MEMORY_SCOPE_AGENT); }
__device__ __forceinline__ unsigned xb_add(unsigned* p, unsigned v) { return __hip_atomic_fetch_add(p, v, __ATOMIC_RELAXED, __HIP_MEMORY_SCOPE_AGENT); }
__device__ __forceinline__ unsigned xb_xcc_id() { return (unsigned)__builtin_amdgcn_s_getreg((3 << 11) | 20) & 0xFu; }
#define XB_SPIN(cond, bar) do { unsigned _sp = 0; while (cond) { __builtin_amdgcn_s_sleep(1); \
    if ((++_sp & 255u) == 0u) { if (xb_ld(&(bar)[XB_TMO])) break; if (_sp > XB_SPIN_CAP) { atomicAdd(&(bar)[XB_TMO], 1u); break; } } } } while (0)
struct XcdBarrier { unsigned* bar; unsigned x; volatile unsigned* st; };
__device__ __forceinline__ XcdBarrier xcd_barrier_post(unsigned* bar, volatile unsigned* st) {
    XcdBarrier b; b.bar = bar; b.x = xb_xcc_id(); b.st = st;
    if (threadIdx.x == 0) (void)xb_add(&bar[XB_XCNT(b.x)], 1u);
    return b;
}
__device__ __forceinline__ void xcd_barrier_complete(unsigned* bar, unsigned x, unsigned& nloc, unsigned& nx) {
    const unsigned G = gridDim.x * gridDim.y * gridDim.z;
    unsigned sum, cnt, mine, sp = 0u;
    for (;;) {
        sum = 0u; cnt = 0u; mine = 0u;
#pragma unroll
        for (unsigned j = 0; j < 16; ++j) { const unsigned c = xb_ld(&bar[XB_XCNT(j)]); sum += c; cnt += (c > 0u) ? 1u : 0u; mine = (j == x) ? c : mine; }
        if (sum == G) break;
        __builtin_amdgcn_s_sleep(1);
        if ((++sp & 255u) == 0u) { if (xb_ld(&bar[XB_TMO])) break; if (sp > XB_SPIN_CAP) { atomicAdd(&bar[XB_TMO], 1u); break; } }
    }
    nloc = mine > 0u ? mine : 1u; nx = cnt > 0u ? cnt : 1u;
}
__device__ __forceinline__ void xcd_barrier(const XcdBarrier& b) {
    asm volatile("s_waitcnt vmcnt(0)" ::: "memory");
    __syncthreads();
    if (threadIdx.x == 0) {
        unsigned* bar = b.bar;
        __builtin_amdgcn_s_waitcnt(0);
        unsigned nloc = b.st[0], nx = b.st[1];
        if (nloc == 0u) { xcd_barrier_complete(bar, b.x, nloc, nx); b.st[0] = nloc; b.st[1] = nx; }
        const unsigned old = xb_add(&bar[XB_XSUB(b.x)], 1u);
        const unsigned gen = old / nloc;
        if (old + 1u == (gen + 1u) * nloc) {
            __builtin_amdgcn_fence(__ATOMIC_RELEASE, "agent");
            asm volatile("s_waitcnt vmcnt(0)" ::: "memory");
            const unsigned og = xb_add(&bar[XB_TOP], 1u);
            const unsigned tg = og / nx;
            if (og + 1u == (tg + 1u) * nx) xb_add(&bar[XB_TOPGEN], 1u);
            else XB_SPIN(xb_ld(&bar[XB_TOPGEN]) == tg, bar);
            __builtin_amdgcn_fence(__ATOMIC_ACQUIRE, "agent");
            xb_add(&bar[XB_XGEN(b.x)], 1u);
            asm volatile("s_waitcnt vmcnt(0)" ::: "memory");
        } else {
            XB_SPIN(xb_ld(&bar[XB_XGEN(b.x)]) == gen, bar);
            __builtin_amdgcn_fence(__ATOMIC_ACQUIRE, "agent");
            asm volatile("s_waitcnt vmcnt(0)" ::: "memory");
        }
    }
    __syncthreads();
}

__device__ void run_phase(const Params& p, int ph, unsigned char* lds) {
#ifndef TEST_K
    if (ph == 0) { phase0(p, lds); return; }
#else
    if (TEST_K == 7) { phase0(p, lds); return; }
#endif
    const int l = (ph - 1) / 7, k = (ph - 1) % 7;
#ifdef TEST_K
    if (k != TEST_K) return;
#endif
    switch (k) {
        case 0: { EpiIn e{p, l}; gemm_phase(p.ab, p.win_t + (size_t)l * NINP * DM, DM, NINP / 128, lds, e); } break;
        case 1: mixer_phase(p, l, lds); break;
        case 2: { EpiWo e{p, l}; gemm_phase(p.ab, p.wo_t + (size_t)l * DM * DM, DM, DM / 128, lds, e); } break;
        case 3: ln_phase(p, l, 1); if (l == 0) convert_cache(p, 1); break;
        case 4: { EpiGu e{p}; gemm_phase(p.ab, p.wgu_t + (size_t)l * NGU * DM, DM, NGU / 128, lds, e); } break;
        case 5: { EpiDn e{p}; gemm_phase(p.act, p.wdn_t + (size_t)l * DM * DFF, DFF, DM / 128, lds, e); } break;
        case 6: ln_phase(p, l, 2); break;
    }
}

__global__ void __launch_bounds__(256, 2) mk(Params p, int ph_lo, int ph_hi) {
    extern __shared__ __attribute__((aligned(16))) unsigned char lds[];
#if MK_COOP
    volatile unsigned* st = (volatile unsigned*)(lds + LDS_BYTES);
    if (threadIdx.x == 0) { st[0] = 0u; st[1] = 0u; st[2] = 0u; st[3] = 0u; }
    __syncthreads();
    XcdBarrier xb = xcd_barrier_post(p.bar, st);
#endif
    for (int ph = ph_lo; ph < ph_hi; ++ph) {
        int reps = 1;
#ifdef DUP_K
        if (ph > 0 && (ph - 1) % 7 == DUP_K) reps = 2;
#endif
        for (int rp = 0; rp < reps; ++rp) { run_phase(p, ph, lds); __syncthreads(); }
#if MK_COOP
        if (ph + 1 < ph_hi) xcd_barrier(xb);
#endif
    }
}

static inline size_t al256(size_t x) { return (x + 255) & ~(size_t)255; }

extern "C" void kernel_launch(void* const* d_in, const int* in_sizes, int n_in, void* d_out, int out_size, void* d_ws, size_t ws_size, hipStream_t stream) {
    static int grid = 0;
    if (grid == 0) {
        int dev = 0, cus = 0, per_cu = 0;
        hipGetDevice(&dev);
        hipDeviceGetAttribute(&cus, hipDeviceAttributeMultiprocessorCount, dev);
        if (hipFuncSetAttribute((const void*)mk, hipFuncAttributeMaxDynamicSharedMemorySize, LDS_BYTES + 16) != hipSuccess) { fprintf(stderr, "hipFuncSetAttribute failed\n"); grid = -1; return; }
        hipOccupancyMaxActiveBlocksPerMultiprocessor(&per_cu, (const void*)mk, 256, LDS_BYTES + 16);
        if (per_cu < 1) { fprintf(stderr, "occupancy query says %d\n", per_cu); grid = -1; return; }
        if (per_cu > 2) per_cu = 2;
        grid = cus * per_cu;
        fprintf(stderr, "grid %d (cus %d x %d)\n", grid, cus, per_cu);
    }
    if (grid < 0) return;
    Params p{};
    const float* const* in = (const float* const*)d_in;
    p.x_prompt = in[0]; p.x_sample = in[1]; p.cache_k = in[2]; p.cache_v = in[3]; p.cache_ki = in[4]; p.state_conv = in[5];
    p.w_in = in[6]; p.conv_w = in[7]; p.conv_b = in[8]; p.cln_g = in[9]; p.cln_b = in[10]; p.w_o = in[11]; p.ln1_g = in[12]; p.ln1_b = in[13];
    p.w_gu = in[14]; p.w_dn = in[15]; p.ln2_g = in[16]; p.ln2_b = in[17];
    p.out = (float*)d_out;
    unsigned char* w = (unsigned char*)d_ws; size_t off = 0;
    auto take = [&](size_t bytes) { unsigned char* r = w + off; off = al256(off + bytes); return r; };
    p.win_t = (bf16_t*)take((size_t)2 * NINP * DM * 2);
    p.wo_t = (bf16_t*)take((size_t)2 * DM * DM * 2);
    p.wgu_t = (bf16_t*)take((size_t)2 * NGU * DM * 2);
    p.wdn_t = (bf16_t*)take((size_t)2 * DM * DFF * 2);
    p.trig = (float2*)take((size_t)SS * 32 * 8);
    p.kp = (bf16_t*)take((size_t)4 * SP * 128 * 2); p.vp = (bf16_t*)take((size_t)4 * SP * 128 * 2); p.kip = (bf16_t*)take((size_t)4 * SP * 64 * 2);
    p.ks = (bf16_t*)take((size_t)16 * SS * 128 * 2); p.vs = (bf16_t*)take((size_t)16 * SS * 128 * 2); p.kis = (bf16_t*)take((size_t)16 * SS * 64 * 2);
    p.ab = (bf16_t*)take((size_t)TT * DM * 2);
    p.F = (float*)take((size_t)TT * DM * 4);
    unsigned char* big = take((size_t)TT * DFF * 2);
    p.act = (bf16_t*)big;
    p.u = (bf16_t*)big; p.q = (bf16_t*)(big + (size_t)TT * 512 * 2); p.qi = (bf16_t*)(big + (size_t)2 * TT * 512 * 2); p.wi = (float*)(big + (size_t)3 * TT * 512 * 2);
    p.bar = (unsigned*)take((size_t)XCD_BAR_WORDS * 4);
    if (off > ws_size) { fprintf(stderr, "workspace too small: need %zu have %zu\n", off, ws_size); return; }
#if MK_COOP
    if (hipMemsetAsync(p.bar, 0, (size_t)XCD_BAR_WORDS * 4, stream) != hipSuccess) { fprintf(stderr, "memset failed\n"); return; }
    int lo = 0, hi = 15;
    void* args[] = {&p, &lo, &hi};
    hipError_t e = hipLaunchCooperativeKernel((const void*)mk, dim3(grid), dim3(256), args, LDS_BYTES + 16, stream);
    if (e != hipSuccess) fprintf(stderr, "cooperative launch failed: %s (grid %d)\n", hipGetErrorString(e), grid);
#else
    for (int ph = 0; ph < 15; ++ph) hipLaunchKernelGGL(mk, dim3(grid), dim3(256), LDS_BYTES + 16, stream, p, ph, ph + 1);
#endif
}
```

```cpp
#include <hip/hip_runtime.h>
#include <hip/hip_cooperative_groups.h>
#include <cstdio>
#include <cstdint>
namespace cg = cooperative_groups;

#ifndef DUP_PART
#define DUP_PART 0
#endif
#ifndef MK_COOP
#define MK_COOP 1
#endif

typedef unsigned short bf16_t;
typedef short bf16x8 __attribute__((ext_vector_type(8)));
typedef float f32x4 __attribute__((ext_vector_type(4)));
typedef float f32x16 __attribute__((ext_vector_type(16)));
typedef unsigned u32x4 __attribute__((ext_vector_type(4)));

constexpr int DM = 1024, TP = 16384, TSM = 1024, TT = TP + TSM;
constexpr int NIN = 2376, NINP = 2432, DFF = 2816, NGU = 5632;
constexpr int SP = 4096, SS = 4160;
constexpr int LDS_BYTES = 4 * SS * 4 + 4 * 256 * 2;
constexpr float ALPHA = 1.4142135623730951f;
constexpr float LN_EPS = 1e-5f;

constexpr size_t O_YP = 0, O_YS = 16777216, O_KP = 17825792, O_VP = 22020096, O_KIP = 26214400, O_CP = 28311552,
                 O_KS = 28434432, O_VS = 28696576, O_KIS = 28958720, O_CS = 29089792;

struct Params {
    const float *x_prompt, *x_sample, *cache_k, *cache_v, *cache_ki, *state_conv;
    const float *w_in, *conv_w, *conv_b, *cln_g, *cln_b, *w_o, *ln1_g, *ln1_b, *w_gu, *w_dn, *ln2_g, *ln2_b;
    float* out;
    bf16_t *win_t, *wo_t, *wgu_t, *wdn_t;
    float2* trig;
    bf16_t *kp, *vp, *kip, *ks, *vs, *kis;
    bf16_t* ab;
    float* F;
    bf16_t *act, *u, *q, *qi;
    float* wi;
    unsigned* bar;
};

__device__ __forceinline__ unsigned pk_bf16(float lo, float hi) { unsigned r; asm volatile("v_cvt_pk_bf16_f32 %0, %1, %2" : "=v"(r) : "v"(lo), "v"(hi)); return r; }
__device__ __forceinline__ float bf_lo(unsigned v) { return __uint_as_float(v << 16); }
__device__ __forceinline__ float bf_hi(unsigned v) { return __uint_as_float(v & 0xffff0000u); }
__device__ __forceinline__ int opaque_tid() { int t = threadIdx.x; asm volatile("" : "+v"(t)); return t; }
__device__ __forceinline__ unsigned tokey(float f) { unsigned u = __float_as_uint(f); return (u & 0x80000000u) ? ~u : (u | 0x80000000u); }
__device__ __forceinline__ float sigmoidf_(float x) { return 1.0f / (1.0f + __expf(-x)); }

__device__ __forceinline__ int perm_in(int n) {
    const int g = n >> 6, w = n & 63;
    if (g < 16) return (w < 32) ? (32 * g + w) : (512 + 32 * g + (w - 32));
    const int c = 1024 + (g - 16) * 64 + w;
    return c < NIN ? c : -1;
}
__device__ __forceinline__ int perm_gu(int n) { const int g = n >> 6, w = n & 63; return (w < 32) ? (32 * g + w) : (DFF + 32 * g + (w - 32)); }

template <int MODE>
__device__ void transpose_tiles(const float* __restrict__ W, bf16_t* __restrict__ Wt, int K, int N, int Np, float* lds, int& cursor) {
    const int tk = K >> 6, tn = Np >> 6, nt = tk * tn, tid = opaque_tid();
    int first = (int)blockIdx.x - cursor; if (first < 0) first += gridDim.x;
    cursor = (cursor + nt) % (int)gridDim.x;
    for (int t = first; t < nt; t += gridDim.x) {
        const int k0 = (t / tn) << 6, n0 = (t % tn) << 6;
        __syncthreads();
#pragma unroll
        for (int i = 0; i < 16; ++i) {
            const int k = i * 4 + (tid >> 6), n = tid & 63;
            int c = n0 + n; if (MODE == 1) c = perm_in(c); else if (MODE == 2) c = perm_gu(c);
            lds[k * 65 + n] = (c >= 0) ? W[(size_t)(k0 + k) * N + c] : 0.f;
        }
        __syncthreads();
#pragma unroll
        for (int i = 0; i < 8; ++i) {
            const int n = i * 8 + (tid >> 5), k = (tid & 31) * 2;
            *(unsigned*)(Wt + (size_t)(n0 + n) * K + k0 + k) = pk_bf16(lds[k * 65 + n], lds[(k + 1) * 65 + n]);
        }
    }
}

__device__ void convert_chunks(const float* __restrict__ src, bf16_t* __restrict__ dst, int nb, int chunk8  , int dst_stride8  ) {
    const int total = nb * chunk8;
    for (int i = blockIdx.x * 256 + opaque_tid(); i < total; i += gridDim.x * 256) {
        const int b = i / chunk8, r = i - b * chunk8;
        const float4 a = *(const float4*)(src + (size_t)i * 8), c = *(const float4*)(src + (size_t)i * 8 + 4);
        uint4 o; o.x = pk_bf16(a.x, a.y); o.y = pk_bf16(a.z, a.w); o.z = pk_bf16(c.x, c.y); o.w = pk_bf16(c.z, c.w);
        *(uint4*)(dst + ((size_t)b * dst_stride8 + r) * 8) = o;
    }
}
__device__ void convert_cache(const Params& p, int l) {
    convert_chunks(p.cache_k + (size_t)l * 16 * 4096 * 128, p.ks, 16, 4096 * 16, SS * 16);
    convert_chunks(p.cache_v + (size_t)l * 16 * 4096 * 128, p.vs, 16, 4096 * 16, SS * 16);
    convert_chunks(p.cache_ki + (size_t)l * 16 * 4096 * 64, p.kis, 16, 4096 * 8, SS * 8);
}

__device__ void phase0(const Params& p, unsigned char* lds) {
    int cursor = 0;
    for (int l = 0; l < 2; ++l) {
        transpose_tiles<1>(p.w_in + (size_t)l * DM * NIN, p.win_t + (size_t)l * NINP * DM, DM, NIN, NINP, (float*)lds, cursor);
        transpose_tiles<0>(p.w_o + (size_t)l * DM * DM, p.wo_t + (size_t)l * DM * DM, DM, DM, DM, (float*)lds, cursor);
        transpose_tiles<2>(p.w_gu + (size_t)l * DM * NGU, p.wgu_t + (size_t)l * NGU * DM, DM, NGU, NGU, (float*)lds, cursor);
        transpose_tiles<0>(p.w_dn + (size_t)l * DFF * DM, p.wdn_t + (size_t)l * DM * DFF, DFF, DM, DM, (float*)lds, cursor);
    }
    __syncthreads();
    convert_chunks(p.x_prompt, p.ab, 1, TP * 128, TP * 128);
    convert_chunks(p.x_sample, p.ab + (size_t)TP * DM, 1, TSM * 128, TSM * 128);
    convert_cache(p, 0);
    for (int i = blockIdx.x * 256 + opaque_tid(); i < SS * 32; i += gridDim.x * 256) {
        const int pos = i >> 5, f = i & 31;
        const float inv = exp2f(-(float)f * (13.287712379549449f / 32.0f));
        const float angf = (float)pos * inv;
        const double rev = (double)angf * 0.15915494309189535;
        const double fr = rev - __builtin_rint(rev);
        const float ang = (float)(fr * 6.283185307179586);
        p.trig[i] = make_float2(__cosf(ang), __sinf(ang));
    }
}

template <class Epi>
__device__ __forceinline__ void gemm_tile(const bf16_t* __restrict__ A, const bf16_t* __restrict__ Bt, int K, int row0, int col0, unsigned char* lds, const Epi& epi) {
    const int tid = opaque_tid(), lane = tid & 63, wid = tid >> 6, wr = wid >> 1, wc = wid & 1, fr = lane & 15, fq = lane >> 4;
    const int sc = tid & 7, sr = tid >> 3;
    const bf16_t* ag = A + (size_t)(row0 + sr) * K + sc * 8;
    const bf16_t* bg = Bt + (size_t)(col0 + sr) * K + sc * 8;
    u32x4 ra[4], rb[4];
    f32x4 acc[4][4];
#pragma unroll
    for (int m = 0; m < 4; ++m)
#pragma unroll
        for (int n = 0; n < 4; ++n) acc[m][n] = (f32x4){0.f, 0.f, 0.f, 0.f};
    const int soff = sr * 128 + ((sc ^ ((sr >> 1) & 7)) << 4);
    const int nk = K >> 6;
#pragma unroll
    for (int i = 0; i < 4; ++i) { ra[i] = *(const u32x4*)(ag + (size_t)i * 32 * K); rb[i] = *(const u32x4*)(bg + (size_t)i * 32 * K); }
    __syncthreads();
#pragma unroll
    for (int i = 0; i < 4; ++i) { *(u32x4*)(lds + soff + i * 4096) = ra[i]; *(u32x4*)(lds + 16384 + soff + i * 4096) = rb[i]; }
    __syncthreads();
    const int swz = (fr >> 1) & 7;
    for (int kt = 0; kt < nk; ++kt) {
        if (kt + 1 < nk) {
#pragma unroll
            for (int i = 0; i < 4; ++i) { ra[i] = *(const u32x4*)(ag + (size_t)i * 32 * K + (kt + 1) * 64); rb[i] = *(const u32x4*)(bg + (size_t)i * 32 * K + (kt + 1) * 64); }
        }
        const unsigned char* ba = lds + (kt & 1) * 32768;
        const unsigned char* bb = ba + 16384;
#pragma unroll
        for (int ks = 0; ks < 2; ++ks) {
            bf16x8 af[4], bfr[4];
            const int ch = ((ks * 4 + fq) ^ swz) << 4;
#pragma unroll
            for (int m = 0; m < 4; ++m) af[m] = *(const bf16x8*)(ba + (wr * 64 + m * 16 + fr) * 128 + ch);
#pragma unroll
            for (int n = 0; n < 4; ++n) bfr[n] = *(const bf16x8*)(bb + (wc * 64 + n * 16 + fr) * 128 + ch);
#pragma unroll
            for (int m = 0; m < 4; ++m)
#pragma unroll
                for (int n = 0; n < 4; ++n) acc[m][n] = __builtin_amdgcn_mfma_f32_16x16x32_bf16(bfr[n], af[m], acc[m][n], 0, 0, 0);
        }
        if (kt + 1 < nk) {
            unsigned char* d = lds + ((kt + 1) & 1) * 32768;
#pragma unroll
            for (int i = 0; i < 4; ++i) { *(u32x4*)(d + soff + i * 4096) = ra[i]; *(u32x4*)(d + 16384 + soff + i * 4096) = rb[i]; }
        }
        __syncthreads();
    }
    epi(acc, row0 + wr * 64, col0 + wc * 64, fr, fq);
}

template <class Epi>
__device__ void gemm_phase(const bf16_t* A, const bf16_t* Bt, int K, int nN, unsigned char* lds, const Epi& epi) {
    const int nt = (TT / 128) * nN;
    for (int t = blockIdx.x; t < nt; t += gridDim.x) {
        const int mt = t / nN, ntile = t - mt * nN;
        gemm_tile(A, Bt, K, mt * 128, ntile * 128, lds, epi);
    }
}

__device__ __forceinline__ void tok_decode(int row, bool& isS, int& b, int& t, int& pos) {
    isS = row >= TP;
    if (!isS) { b = row >> 12; t = row & 4095; pos = t; } else { const int r = row - TP; b = r >> 6; t = r & 63; pos = 4096 + t; }
}

struct EpiIn {
    Params p; int l;
    __device__ __forceinline__ void operator()(f32x4 (&acc)[4][4], int rbase, int cbase, int fr, int fq) const {
        const int G = cbase >> 6;
#pragma unroll
        for (int m = 0; m < 4; ++m) {
            const int row = rbase + m * 16 + fr;
            bool isS; int b, t, pos; tok_decode(row, isS, b, t, pos);
            if (G < 16) {
                const int tl = isS ? t - 34 : t - 4066;
#pragma unroll
                for (int n = 0; n < 2; ++n) {
                    const int ch = 32 * G + n * 16 + fq * 4;
                    float u[4];
#pragma unroll
                    for (int j = 0; j < 4; ++j) u[j] = acc[m][n][j] * sigmoidf_(acc[m][n + 2][j]);
                    uint2 w; w.x = pk_bf16(u[0], u[1]); w.y = pk_bf16(u[2], u[3]);
                    *(uint2*)(p.u + (size_t)row * 512 + ch) = w;
                    if (tl >= 0) {
                        float* o = p.out + (isS ? O_CS + ((size_t)(l * 16 + b) * 30 + tl) * 512 : O_CP + ((size_t)(l * 4 + b) * 30 + tl) * 512) + ch;
                        *(float4*)o = make_float4(u[0], u[1], u[2], u[3]);
                    }
                }
            } else if (G == 26 || G == 27) {
                const int kvh = G - 26;
                float* o = p.out + (isS ? O_VS + (((size_t)(l * 16 + b) * 64 + t) * 2 + kvh) * 64 : O_VP + (((size_t)(l * 4 + b) * 4096 + t) * 2 + kvh) * 64);
                bf16_t* vb = (isS ? p.vs + ((size_t)b * SS + 4096 + t) * 128 : p.vp + ((size_t)b * SP + t) * 128) + kvh * 64;
#pragma unroll
                for (int n = 0; n < 4; ++n) {
                    const int d = n * 16 + fq * 4;
                    *(float4*)(o + d) = make_float4(acc[m][n][0], acc[m][n][1], acc[m][n][2], acc[m][n][3]);
                    uint2 w; w.x = pk_bf16(acc[m][n][0], acc[m][n][1]); w.y = pk_bf16(acc[m][n][2], acc[m][n][3]);
                    *(uint2*)(vb + d) = w;
                }
            } else if (G == 37) {
                if (fq < 2) {
                    const float s = 0.35355339059327373f * 0.125f;
                    *(float4*)(p.wi + (size_t)row * 8 + fq * 4) = make_float4(acc[m][0][0] * s, acc[m][0][1] * s, acc[m][0][2] * s, acc[m][0][3] * s);
                }
            } else {
                float o1[2][4], o2[2][4];
#pragma unroll
                for (int n = 0; n < 2; ++n) {
                    const float4* tp = (const float4*)(p.trig + (size_t)pos * 32 + n * 16 + fq * 4);
                    const float4 t0 = tp[0], t1 = tp[1];
                    const float cs[4] = {t0.x, t0.z, t1.x, t1.z}, sn[4] = {t0.y, t0.w, t1.y, t1.w};
#pragma unroll
                    for (int j = 0; j < 4; ++j) {
                        const float x1 = acc[m][n][j], x2 = acc[m][n + 2][j];
                        o1[n][j] = x1 * cs[j] - x2 * sn[j];
                        o2[n][j] = x2 * cs[j] + x1 * sn[j];
                    }
                }
                if (G < 24 || (G >= 28 && G < 36)) {
                    const bool isq = G < 24;
                    const float s = isq ? 0.125f * 1.4426950408889634f : 1.0f;
                    bf16_t* dst = (isq ? p.q + (size_t)row * 512 + (G - 16) * 64 : p.qi + (size_t)row * 512 + (G - 28) * 64);
#pragma unroll
                    for (int n = 0; n < 2; ++n) {
                        const int d = n * 16 + fq * 4;
                        uint2 w; w.x = pk_bf16(o1[n][0] * s, o1[n][1] * s); w.y = pk_bf16(o1[n][2] * s, o1[n][3] * s);
                        *(uint2*)(dst + d) = w;
                        w.x = pk_bf16(o2[n][0] * s, o2[n][1] * s); w.y = pk_bf16(o2[n][2] * s, o2[n][3] * s);
                        *(uint2*)(dst + d + 32) = w;
                    }
                } else if (G == 24 || G == 25) {
                    const int kvh = G - 24;
                    float* o = p.out + (isS ? O_KS + (((size_t)(l * 16 + b) * 64 + t) * 2 + kvh) * 64 : O_KP + (((size_t)(l * 4 + b) * 4096 + t) * 2 + kvh) * 64);
                    bf16_t* kb = (isS ? p.ks + ((size_t)b * SS + 4096 + t) * 128 : p.kp + ((size_t)b * SP + t) * 128) + kvh * 64;
#pragma unroll
                    for (int n = 0; n < 2; ++n) {
                        const int d = n * 16 + fq * 4;
                        *(float4*)(o + d) = make_float4(o1[n][0], o1[n][1], o1[n][2], o1[n][3]);
                        *(float4*)(o + d + 32) = make_float4(o2[n][0], o2[n][1], o2[n][2], o2[n][3]);
                        uint2 w; w.x = pk_bf16(o1[n][0], o1[n][1]); w.y = pk_bf16(o1[n][2], o1[n][3]);
                        *(uint2*)(kb + d) = w;
                        w.x = pk_bf16(o2[n][0], o2[n][1]); w.y = pk_bf16(o2[n][2], o2[n][3]);
                        *(uint2*)(kb + d + 32) = w;
                    }
                } else {
                    float* o = p.out + (isS ? O_KIS + ((size_t)(l * 16 + b) * 64 + t) * 64 : O_KIP + ((size_t)(l * 4 + b) * 4096 + t) * 64);
                    bf16_t* kb = (isS ? p.kis + ((size_t)b * SS + 4096 + t) * 64 : p.kip + ((size_t)b * SP + t) * 64);
#pragma unroll
                    for (int n = 0; n < 2; ++n) {
                        const int d = n * 16 + fq * 4;
                        *(float4*)(o + d) = make_float4(o1[n][0], o1[n][1], o1[n][2], o1[n][3]);
                        *(float4*)(o + d + 32) = make_float4(o2[n][0], o2[n][1], o2[n][2], o2[n][3]);
                        uint2 w; w.x = pk_bf16(o1[n][0], o1[n][1]); w.y = pk_bf16(o1[n][2], o1[n][3]);
                        *(uint2*)(kb + d) = w;
                        w.x = pk_bf16(o2[n][0], o2[n][1]); w.y = pk_bf16(o2[n][2], o2[n][3]);
                        *(uint2*)(kb + d + 32) = w;
                    }
                }
            }
        }
    }
};

struct EpiWo {
    Params p; int l;
    __device__ __forceinline__ void operator()(f32x4 (&acc)[4][4], int rbase, int cbase, int fr, int fq) const {
#pragma unroll
        for (int m = 0; m < 4; ++m) {
            const int row = rbase + m * 16 + fr;
            const float* xr = (l == 0) ? ((row < TP) ? p.x_prompt + (size_t)row * DM : p.x_sample + (size_t)(row - TP) * DM) : p.F + (size_t)row * DM;
            float* fo = p.F + (size_t)row * DM;
#pragma unroll
            for (int n = 0; n < 4; ++n) {
                const int c = cbase + n * 16 + fq * 4;
                const float4 x = *(const float4*)(xr + c);
                *(float4*)(fo + c) = make_float4(ALPHA * x.x + acc[m][n][0], ALPHA * x.y + acc[m][n][1], ALPHA * x.z + acc[m][n][2], ALPHA * x.w + acc[m][n][3]);
            }
        }
    }
};
struct EpiGu {
    Params p;
    __device__ __forceinline__ void operator()(f32x4 (&acc)[4][4], int rbase, int cbase, int fr, int fq) const {
        const int G = cbase >> 6;
#pragma unroll
        for (int m = 0; m < 4; ++m) {
            const int row = rbase + m * 16 + fr;
#pragma unroll
            for (int n = 0; n < 2; ++n) {
                float a[4];
#pragma unroll
                for (int j = 0; j < 4; ++j) { const float g = acc[m][n][j]; a[j] = g * sigmoidf_(g) * acc[m][n + 2][j]; }
                uint2 w; w.x = pk_bf16(a[0], a[1]); w.y = pk_bf16(a[2], a[3]);
                *(uint2*)(p.act + (size_t)row * DFF + 32 * G + n * 16 + fq * 4) = w;
            }
        }
    }
};
struct EpiDn {
    Params p;
    __device__ __forceinline__ void operator()(f32x4 (&acc)[4][4], int rbase, int cbase, int fr, int fq) const {
#pragma unroll
        for (int m = 0; m < 4; ++m) {
            float* fo = p.F + (size_t)(rbase + m * 16 + fr) * DM;
#pragma unroll
            for (int n = 0; n < 4; ++n) {
                const int c = cbase + n * 16 + fq * 4;
                const float4 x = *(const float4*)(fo + c);
                *(float4*)(fo + c) = make_float4(ALPHA * x.x + acc[m][n][0], ALPHA * x.y + acc[m][n][1], ALPHA * x.z + acc[m][n][2], ALPHA * x.w + acc[m][n][3]);
            }
        }
    }
};

__device__ void ln_phase(const Params& p, int l, int which) {
    const int tid = opaque_tid(), lane = tid & 63, wid = tid >> 6;
    const float* g = (which == 1 ? p.ln1_g : p.ln2_g) + l * DM;
    const float* bb = (which == 1 ? p.ln1_b : p.ln2_b) + l * DM;
    const bool fin = (which == 2 && l == 1);
    for (int row = blockIdx.x * 4 + wid; row < TT; row += gridDim.x * 4) {
        float* fr = p.F + (size_t)row * DM;
        float4 v[4];
        float s = 0.f;
#pragma unroll
        for (int i = 0; i < 4; ++i) { v[i] = *(const float4*)(fr + i * 256 + lane * 4); s += (v[i].x + v[i].y) + (v[i].z + v[i].w); }
#pragma unroll
        for (int o = 32; o >= 1; o >>= 1) s += __shfl_xor(s, o);
        const float mean = s * (1.0f / 1024.0f);
        float q = 0.f;
#pragma unroll
        for (int i = 0; i < 4; ++i) { const float a = v[i].x - mean, b = v[i].y - mean, c = v[i].z - mean, d = v[i].w - mean; q += (a * a + b * b) + (c * c + d * d); }
#pragma unroll
        for (int o = 32; o >= 1; o >>= 1) q += __shfl_xor(q, o);
        const float rstd = rsqrtf(q * (1.0f / 1024.0f) + LN_EPS);
#pragma unroll
        for (int i = 0; i < 4; ++i) {
            const int c = i * 256 + lane * 4;
            const float4 gg = *(const float4*)(g + c), be = *(const float4*)(bb + c);
            const float4 o = make_float4((v[i].x - mean) * rstd * gg.x + be.x, (v[i].y - mean) * rstd * gg.y + be.y, (v[i].z - mean) * rstd * gg.z + be.z, (v[i].w - mean) * rstd * gg.w + be.w);
            if (fin) *(float4*)(p.out + (size_t)row * DM + c) = o;
            else {
                *(float4*)(fr + c) = o;
                uint2 w; w.x = pk_bf16(o.x, o.y); w.y = pk_bf16(o.z, o.w);
                *(uint2*)(p.ab + (size_t)row * DM + c) = w;
            }
        }
    }
}

__device__ __forceinline__ void conv_unit(const Params& p, int l, int cu, unsigned char* lds) {
    const int tid = opaque_tid(), lane = tid & 63, wid = tid >> 6;
    const int row0 = cu * 16;
    bool isS; int b, t0, pos; tok_decode(row0, isS, b, t0, pos);
    const int seq_row0 = row0 - t0;
    unsigned* xs = (unsigned*)lds;
    float* red = (float*)(lds + 46 * 1024);
    const unsigned* ug = (const unsigned*)p.u;
    __syncthreads();
    {
        const int nneg = t0 < 30 ? 30 - t0 : 0;
#pragma unroll
        for (int i = 0; i < 46; ++i) {
            const int tok = t0 - 30 + i;
            const int tokc = tok < 0 ? 0 : tok;
            unsigned v = ug[(size_t)(seq_row0 + tokc) * 256 + tid];
            if (i < 30 && i < nneg) {
                v = 0u;
                if (isS) { const float2 s = *(const float2*)(p.state_conv + ((size_t)(l * 16 + b) * 30 + (30 + tok)) * 512 + 2 * tid); v = pk_bf16(s.x, s.y); }
            }
            xs[i * 256 + tid] = v;
        }
    }
    float cw0[31], cw1[31];
#pragma unroll
    for (int w = 0; w < 31; ++w) { const float2 c = *(const float2*)(p.conv_w + ((size_t)l * 31 + w) * 512 + 2 * tid); cw0[w] = c.x; cw1[w] = c.y; }
    const float2 cb = *(const float2*)(p.conv_b + l * 512 + 2 * tid);
#pragma unroll 2
    for (int t = 0; t < 16; ++t) {
        float a0 = cb.x, a1 = cb.y;
        const unsigned* xr = xs + t * 256 + tid;
#pragma unroll
        for (int w = 0; w < 31; ++w) { const unsigned v = xr[w * 256]; a0 += bf_lo(v) * cw0[w]; a1 += bf_hi(v) * cw1[w]; }
        float s = a0 + a1, q = a0 * a0 + a1 * a1;
#pragma unroll
        for (int o = 32; o >= 1; o >>= 1) { s += __shfl_xor(s, o); q += __shfl_xor(q, o); }
        if (lane == 0) { red[(wid * 16 + t) * 2] = s; red[(wid * 16 + t) * 2 + 1] = q; }
        xs[t * 256 + tid] = pk_bf16(a0, a1);
    }
    __syncthreads();
    const float2 lg = *(const float2*)(p.cln_g + l * 512 + 2 * tid);
    const float2 lb = *(const float2*)(p.cln_b + l * 512 + 2 * tid);
#pragma unroll 4
    for (int t = 0; t < 16; ++t) {
        const float s = (red[t * 2] + red[(16 + t) * 2]) + (red[(32 + t) * 2] + red[(48 + t) * 2]);
        const float q = (red[t * 2 + 1] + red[(16 + t) * 2 + 1]) + (red[(32 + t) * 2 + 1] + red[(48 + t) * 2 + 1]);
        const float mean = s * (1.0f / 512.0f);
        const float var = fmaxf(q * (1.0f / 512.0f) - mean * mean, 0.f);
        const float rstd = rsqrtf(var + LN_EPS);
        const unsigned v = xs[t * 256 + tid];
        float a = (bf_lo(v) - mean) * rstd * lg.x + lb.x, c = (bf_hi(v) - mean) * rstd * lg.y + lb.y;
        a = a * sigmoidf_(a); c = c * sigmoidf_(c);
        *(unsigned*)(p.ab + (size_t)(row0 + t) * DM + 2 * tid) = pk_bf16(a, c);
    }
    __syncthreads();
}

__device__ __forceinline__ void attn_unit(const Params& p, int isS, int b, int t0, unsigned char* lds) {
    const int tid = opaque_tid(), lane = tid & 63, wid = tid >> 6, r = lane & 31, hh = lane >> 5;
    unsigned* sc = (unsigned*)lds;
    unsigned short* idxl = (unsigned short*)(lds + 4 * SS * 4) + wid * 256;
    const int row0 = isS ? TP + b * 64 + t0 : b * 4096 + t0;
    const int S = isS ? SS : ((t0 >> 6) + 1) * 64;
    const bf16_t* KI = isS ? p.kis + (size_t)b * SS * 64 : p.kip + (size_t)b * SP * 64;
    const bf16_t* Kc = isS ? p.ks + (size_t)b * SS * 128 : p.kp + (size_t)b * SP * 128;
    const bf16_t* Vc = isS ? p.vs + (size_t)b * SS * 128 : p.vp + (size_t)b * SP * 128;
    __syncthreads();
    {
        bf16x8 qf[4];
#pragma unroll
        for (int ks = 0; ks < 4; ++ks) qf[ks] = *(const bf16x8*)(p.qi + (size_t)(row0 + (r >> 3)) * 512 + (r & 7) * 64 + ks * 16 + hh * 8);
        float w[4][4];
#pragma unroll
        for (int q = 0; q < 4; ++q) { const float4 t = *(const float4*)(p.wi + (size_t)(row0 + q) * 8 + 4 * hh); w[q][0] = t.x; w[q][1] = t.y; w[q][2] = t.z; w[q][3] = t.w; }
        const int ntile = S >> 5;
        auto ldk = [&](int kt, bf16x8 (&kf)[4]) {
            const bf16_t* kr = KI + (size_t)(kt * 32 + r) * 64 + hh * 8;
#pragma unroll
            for (int ks = 0; ks < 4; ++ks) kf[ks] = *(const bf16x8*)(kr + ks * 16);
        };
        auto comp = [&](int kt, const bf16x8 (&kf)[4]) {
            f32x16 d;
#pragma unroll
            for (int i = 0; i < 16; ++i) d[i] = 0.f;
#pragma unroll
            for (int ks = 0; ks < 4; ++ks) d = __builtin_amdgcn_mfma_f32_32x32x16_bf16(qf[ks], kf[ks], d, 0, 0, 0);
            float s[4];
#pragma unroll
            for (int q = 0; q < 4; ++q) {
                s[q] = (w[q][0] * fmaxf(d[4 * q], 0.f) + w[q][1] * fmaxf(d[4 * q + 1], 0.f)) + (w[q][2] * fmaxf(d[4 * q + 2], 0.f) + w[q][3] * fmaxf(d[4 * q + 3], 0.f));
                s[q] += __shfl_xor(s[q], 32);
                s[q] += 0.0f;
            }
            const float a0 = hh ? s[2] : s[0], a1 = hh ? s[3] : s[1];
            sc[(hh * 2) * SS + kt * 32 + r] = tokey(a0);
            sc[(hh * 2 + 1) * SS + kt * 32 + r] = tokey(a1);
        };
        for (int rep = 0; rep < (DUP_PART == 1 ? 2 : 1); ++rep) {
        bf16x8 ka[4], kb[4];
        int kt = wid;
        if (kt < ntile) ldk(kt, ka);
        for (; kt < ntile; kt += 8) {
            if (kt + 4 < ntile) ldk(kt + 4, kb);
            comp(kt, ka);
            if (kt + 8 < ntile) ldk(kt + 8, ka);
            if (kt + 4 < ntile) comp(kt + 4, kb);
        }
        }
    }
    __syncthreads();
    const int Ksel = S < 256 ? S : 256;
    for (int rep = 0; rep < (DUP_PART == 2 ? 2 : 1); ++rep)
    if (S <= 256) {
        for (int i = lane; i < S; i += 64) idxl[i] = (unsigned short)i;
    } else {
        unsigned key[65];
        const unsigned* myr = sc + wid * SS;
        const int nslot = S >> 6;
#pragma unroll
        for (int s = 0; s < 65; ++s) key[s] = (s < nslot) ? myr[s * 64 + lane] : 0u;
        unsigned P = 0; bool exact = false;
        for (int bit = 31; bit >= 0; --bit) {
            const unsigned C = P | (1u << bit);
            int cnt = 0;
#pragma unroll
            for (int sg = 0; sg < 13; ++sg) {
                if (sg * 5 < nslot) {
#pragma unroll
                    for (int s = sg * 5; s < sg * 5 + 5; ++s) cnt += __builtin_popcountll(__ballot(key[s] >= C));
                }
            }
            if (cnt >= 256) { P = C; if (cnt == 256) { exact = true; break; } }
        }
        const unsigned Tg = exact ? P - 1u : P;
        const unsigned long long lt = (1ull << lane) - 1ull;
        int base = 0;
#pragma unroll
        for (int sg = 0; sg < 13; ++sg) {
            if (sg * 5 < nslot) {
#pragma unroll
                for (int s = sg * 5; s < sg * 5 + 5; ++s) {
                    const bool g = key[s] > Tg;
                    const unsigned long long m = __ballot(g);
                    if (g) idxl[base + __builtin_popcountll(m & lt)] = (unsigned short)(s * 64 + lane);
                    base += __builtin_popcountll(m);
                }
            }
        }
        const int need = 256 - base;
        if (need > 0) {
            int tb = 0;
#pragma unroll
            for (int s = 0; s < 65; ++s) {
                const bool e = (key[s] == Tg) && (s < nslot);
                const unsigned long long m = __ballot(e);
                const int rk = tb + __builtin_popcountll(m & lt);
                if (e && rk < need) idxl[base + rk] = (unsigned short)(s * 64 + lane);
                tb += __builtin_popcountll(m);
            }
        }
    }
    __syncthreads();
    const int row = row0 + wid;
    float* Pl = (float*)(sc + wid * SS);
    for (int rep = 0; rep < (DUP_PART == 3 ? 2 : 1); ++rep) {
    {
        bf16x8 qa[8];
#pragma unroll
        for (int ks = 0; ks < 8; ++ks) {
            const int kk = ks * 16 + hh * 8, g = kk >> 6, d = kk & 63;
            const bool valid = (r < 8) && ((r >> 2) == g);
            bf16x8 z;
#pragma unroll
            for (int j = 0; j < 8; ++j) z[j] = 0;
            qa[ks] = valid ? *(const bf16x8*)(p.q + (size_t)row * 512 + r * 64 + d) : z;
        }
        auto ldq = [&](int tile, bf16x8 (&kf)[8]) {
            const int key = tile * 32 + r;
            const int id = (key < Ksel) ? (int)idxl[key] : 0;
            const bf16_t* kr = Kc + (size_t)id * 128 + hh * 8;
#pragma unroll
            for (int ks = 0; ks < 8; ++ks) kf[ks] = *(const bf16x8*)(kr + ks * 16);
        };
        auto cmq = [&](int tile, const bf16x8 (&kf)[8]) {
            const int key = tile * 32 + r;
            f32x16 d;
#pragma unroll
            for (int i = 0; i < 16; ++i) d[i] = 0.f;
#pragma unroll
            for (int ks = 0; ks < 8; ++ks) d = __builtin_amdgcn_mfma_f32_32x32x16_bf16(qa[ks], kf[ks], d, 0, 0, 0);
            const bool ok = key < Ksel;
            *(float4*)(Pl + key * 8 + 4 * hh) = make_float4(ok ? d[0] : -INFINITY, ok ? d[1] : -INFINITY, ok ? d[2] : -INFINITY, ok ? d[3] : -INFINITY);
        };
        bf16x8 ka[8], kb[8];
        ldq(0, ka);
#pragma unroll 1
        for (int tile = 0; tile < 8; tile += 2) {
            ldq(tile + 1, kb);
            cmq(tile, ka);
            if (tile + 2 < 8) ldq(tile + 2, ka);
            cmq(tile + 1, kb);
        }
    }
    {
        float lg[8][4];
#pragma unroll
        for (int tile = 0; tile < 8; ++tile) { const float4 t = *(const float4*)(Pl + (tile * 32 + r) * 8 + 4 * hh); lg[tile][0] = t.x; lg[tile][1] = t.y; lg[tile][2] = t.z; lg[tile][3] = t.w; }
#pragma unroll
        for (int i = 0; i < 4; ++i) {
            float mx = lg[0][i];
#pragma unroll
            for (int tile = 1; tile < 8; ++tile) mx = fmaxf(mx, lg[tile][i]);
#pragma unroll
            for (int o = 16; o >= 1; o >>= 1) mx = fmaxf(mx, __shfl_xor(mx, o));
            float sm = 0.f;
#pragma unroll
            for (int tile = 0; tile < 8; ++tile) { lg[tile][i] = exp2f(lg[tile][i] - mx); sm += lg[tile][i]; }
#pragma unroll
            for (int o = 16; o >= 1; o >>= 1) sm += __shfl_xor(sm, o);
            const float inv = 1.0f / sm;
#pragma unroll
            for (int tile = 0; tile < 8; ++tile) lg[tile][i] *= inv;
        }
#pragma unroll
        for (int tile = 0; tile < 8; ++tile) *(float4*)(Pl + (tile * 32 + r) * 8 + 4 * hh) = make_float4(lg[tile][0], lg[tile][1], lg[tile][2], lg[tile][3]);
    }
    }
    __syncthreads();
    {
        const int sub = lane & 15, kq = lane >> 4, g = sub >> 3;
        typedef float f32x2 __attribute__((ext_vector_type(2)));
        f32x2 acc[4][4];
        for (int rep = 0; rep < (DUP_PART == 4 ? 2 : 1); ++rep) {
#pragma unroll
        for (int h = 0; h < 4; ++h)
#pragma unroll
            for (int i = 0; i < 4; ++i) acc[h][i] = (f32x2){0.f, 0.f};
        auto ldv = [&](int k0, u32x4 (&v)[8]) {
#pragma unroll
            for (int j = 0; j < 8; ++j) { const int id = idxl[k0 + 4 * j + kq]; v[j] = *(const u32x4*)(Vc + (size_t)id * 128 + sub * 8); }
        };
        auto cmv = [&](int k0, const u32x4 (&v)[8]) {
#pragma unroll
            for (int j = 0; j < 8; ++j) {
                const float4 pp = *(const float4*)(Pl + (k0 + 4 * j + kq) * 8 + 4 * g);
                const float ph[4] = {pp.x, pp.y, pp.z, pp.w};
#pragma unroll
                for (int i = 0; i < 4; ++i) {
                    const f32x2 vv = (f32x2){bf_lo(v[j][i]), bf_hi(v[j][i])};
#pragma unroll
                    for (int h = 0; h < 4; ++h) acc[h][i] += vv * ph[h];
                }
            }
        };
        u32x4 va[8], vb[8];
        ldv(0, va);
#pragma unroll 1
        for (int k0 = 0; k0 < Ksel; k0 += 64) {
            if (k0 + 32 < Ksel) ldv(k0 + 32, vb);
            cmv(k0, va);
            if (k0 + 64 < Ksel) ldv(k0 + 64, va);
            if (k0 + 32 < Ksel) cmv(k0 + 32, vb);
        }
        }
#pragma unroll
        for (int h = 0; h < 4; ++h)
#pragma unroll
            for (int i = 0; i < 4; ++i) {
                float x = acc[h][i].x, y = acc[h][i].y;
                x += __shfl_xor(x, 16); y += __shfl_xor(y, 16);
                x += __shfl_xor(x, 32); y += __shfl_xor(y, 32);
                acc[h][i] = (f32x2){x, y};
            }
        if (kq == 0) {
#pragma unroll
            for (int h = 0; h < 4; ++h) {
                u32x4 w;
                w.x = pk_bf16(acc[h][0].x, acc[h][0].y); w.y = pk_bf16(acc[h][1].x, acc[h][1].y);
                w.z = pk_bf16(acc[h][2].x, acc[h][2].y); w.w = pk_bf16(acc[h][3].x, acc[h][3].y);
                *(u32x4*)(p.ab + (size_t)row * DM + 512 + (4 * g + h) * 64 + (sub & 7) * 8) = w;
            }
        }
    }
}

__device__ __forceinline__ void mixer_unit(const Params& p, int l, int pair, int u, unsigned char* lds) {
    if (u < 1088) {
        int isS, b, t0;
        if (u < 64) { isS = 1; b = 4 * pair + (u >> 4); t0 = (u & 15) * 4; }
        else { const int j = u - 64; isS = 0; b = pair; t0 = (63 - (j >> 4)) * 64 + (j & 15) * 4; }
        attn_unit(p, isS, b, t0, lds);
    } else { const int j = u - 1088; conv_unit(p, l, (j < 256) ? pair * 256 + j : 1024 + pair * 16 + (j - 256), lds); }
}
__device__ __forceinline__ void mixer_phase(const Params& p, int l, unsigned char* lds) {
    const int G = gridDim.x;
    const bool fast = (G == 512);
    const int x = blockIdx.x & 7, jb = blockIdx.x >> 3, rb = (x & 1) * 64 + jb;
    const int nrd = fast ? 11 : (4 * 1360 + G - 1) / G;
    for (int rd = 0; rd < nrd; ++rd) {
        int pair, u; bool valid;
        if (fast) { u = rd * 128 + ((rd & 1) ? (127 - rb) : rb); pair = x >> 1; valid = u < 1360; }
        else { const int i = rd * G + (int)blockIdx.x; valid = i < 4 * 1360; pair = i / 1360; u = i - pair * 1360; }
        if (valid) mixer_unit(p, l, pair, u, lds);
    }
}

#define XB_TMO      128
#define XB_XCNT(j)  (256  + 64 * (j))
#define XB_XSUB(j)  (1280 + 64 * (j))
#define XB_XGEN(j)  (2304 + 64 * (j))
#define XB_TOP      3328
#define XB_TOPGEN   3392
#define XCD_BAR_WORDS 3456
#define XB_SPIN_CAP (1u << 20)
__device__ __forceinline__ unsigned xb_ld(unsigned* p)              { return __hip_atomic_load(p, __ATOMIC_RELAXED, __HIP_MEMORY_SCOPE_AGENT); }
__device__ __forceinline__ unsigned xb_add(unsigned* p, unsigned v) { return __hip_atomic_fetch_add(p, v, __ATOMIC_RELAXED, __HIP_MEMORY_SCOPE_AGENT); }
__device__ __forceinline__ unsigned xb_xcc_id() { return (unsigned)__builtin_amdgcn_s_getreg((3 << 11) | 20) & 0xFu; }
#define XB_SPIN(cond, bar) do { unsigned _sp = 0; while (cond) { __builtin_amdgcn_s_sleep(1); \
    if ((++_sp & 255u) == 0u) { if (xb_ld(&(bar)[XB_TMO])) break; if (_sp > XB_SPIN_CAP) { atomicAdd(&(bar)[XB_TMO], 1u); break; } } } } while (0)
struct XcdBarrier { unsigned* bar; unsigned x; volatile unsigned* st; };
__device__ __forceinline__ XcdBarrier xcd_barrier_post(unsigned* bar, volatile unsigned* st) {
    XcdBarrier b; b.bar = bar; b.x = xb_xcc_id(); b.st = st;
    if (threadIdx.x == 0) (void)xb_add(&bar[XB_XCNT(b.x)], 1u);
    return b;
}
__device__ __forceinline__ void xcd_barrier_complete(unsigned* bar, unsigned x, unsigned& nloc, unsigned& nx) {
    const unsigned G = gridDim.x * gridDim.y * gridDim.z;
    unsigned sum, cnt, mine, sp = 0u;
    for (;;) {
        sum = 0u; cnt = 0u; mine = 0u;
#pragma unroll
        for (unsigned j = 0; j < 16; ++j) { const unsigned c = xb_ld(&bar[XB_XCNT(j)]); sum += c; cnt += (c > 0u) ? 1u : 0u; mine = (j == x) ? c : mine; }
        if (sum == G) break;
        __builtin_amdgcn_s_sleep(1);
        if ((++sp & 255u) == 0u) { if (xb_ld(&bar[XB_TMO])) break; if (sp > XB_SPIN_CAP) { atomicAdd(&bar[XB_TMO], 1u); break; } }
    }
    nloc = mine > 0u ? mine : 1u; nx = cnt > 0u ? cnt : 1u;
}
__device__ __forceinline__ void xcd_barrier(const XcdBarrier& b) {
    asm volatile("s_waitcnt vmcnt(0)" ::: "memory");
    __syncthreads();
    if (threadIdx.x == 0) {
        unsigned* bar = b.bar;
        __builtin_amdgcn_s_waitcnt(0);
        unsigned nloc = b.st[0], nx = b.st[1];
        if (nloc == 0u) { xcd_barrier_complete(bar, b.x, nloc, nx); b.st[0] = nloc; b.st[1] = nx; }
        const unsigned old = xb_add(&bar[XB_XSUB(b.x)], 1u);
        const unsigned gen = old / nloc;
        if (old + 1u == (gen + 1u) * nloc) {
            __builtin_amdgcn_fence(__ATOMIC_RELEASE, "agent");
            asm volatile("s_waitcnt vmcnt(0)" ::: "memory");
            const unsigned og = xb_add(&bar[XB_TOP], 1u);
            const unsigned tg = og / nx;
            if (og + 1u == (tg + 1u) * nx) xb_add(&bar[XB_TOPGEN], 1u);
            else XB_SPIN(xb_ld(&bar[XB_TOPGEN]) == tg, bar);
            __builtin_amdgcn_fence(__ATOMIC_ACQUIRE, "agent");
            xb_add(&bar[XB_XGEN(b.x)], 1u);
            asm volatile("s_waitcnt vmcnt(0)" ::: "memory");
        } else {
            XB_SPIN(xb_ld(&bar[XB_XGEN(b.x)]) == gen, bar);
            __builtin_amdgcn_fence(__ATOMIC_ACQUIRE, "agent");
            asm volatile("s_waitcnt vmcnt(0)" ::: "memory");
        }
    }
    __syncthreads();
}

__device__ void run_phase(const Params& p, int ph, unsigned char* lds) {
#ifndef TEST_K
    if (ph == 0) { phase0(p, lds); return; }
#else
    if (TEST_K == 7) { phase0(p, lds); return; }
#endif
    const int l = (ph - 1) / 7, k = (ph - 1) % 7;
#ifdef TEST_K
    if (k != TEST_K) return;
#endif
    switch (k) {
        case 0: { EpiIn e{p, l}; gemm_phase(p.ab, p.win_t + (size_t)l * NINP * DM, DM, NINP / 128, lds, e); } break;
        case 1: mixer_phase(p, l, lds); break;
        case 2: { EpiWo e{p, l}; gemm_phase(p.ab, p.wo_t + (size_t)l * DM * DM, DM, DM / 128, lds, e); } break;
        case 3: ln_phase(p, l, 1); if (l == 0) convert_cache(p, 1); break;
        case 4: { EpiGu e{p}; gemm_phase(p.ab, p.wgu_t + (size_t)l * NGU * DM, DM, NGU / 128, lds, e); } break;
        case 5: { EpiDn e{p}; gemm_phase(p.act, p.wdn_t + (size_t)l * DM * DFF, DFF, DM / 128, lds, e); } break;
        case 6: ln_phase(p, l, 2); break;
    }
}

__global__ void __launch_bounds__(256, 2) mk(Params p, int ph_lo, int ph_hi) {
    extern __shared__ __attribute__((aligned(16))) unsigned char lds[];
#if MK_COOP
    volatile unsigned* st = (volatile unsigned*)(lds + LDS_BYTES);
    if (threadIdx.x == 0) { st[0] = 0u; st[1] = 0u; st[2] = 0u; st[3] = 0u; }
    __syncthreads();
    XcdBarrier xb = xcd_barrier_post(p.bar, st);
#endif
    for (int ph = ph_lo; ph < ph_hi; ++ph) {
        int reps = 1;
#ifdef DUP_K
        if (ph > 0 && (ph - 1) % 7 == DUP_K) reps = 2;
        if (ph == 0 && DUP_K == 7) reps = 2;
#endif
        for (int rp = 0; rp < reps; ++rp) { run_phase(p, ph, lds); __syncthreads(); }
#if MK_COOP
        if (ph + 1 < ph_hi) xcd_barrier(xb);
#endif
    }
}

static inline size_t al256(size_t x) { return (x + 255) & ~(size_t)255; }

extern "C" void kernel_launch(void* const* d_in, const int* in_sizes, int n_in, void* d_out, int out_size, void* d_ws, size_t ws_size, hipStream_t stream) {
    static int grid = 0;
    if (grid == 0) {
        int dev = 0, cus = 0, per_cu = 0;
        hipGetDevice(&dev);
        hipDeviceGetAttribute(&cus, hipDeviceAttributeMultiprocessorCount, dev);
        if (hipFuncSetAttribute((const void*)mk, hipFuncAttributeMaxDynamicSharedMemorySize, LDS_BYTES + 16) != hipSuccess) { fprintf(stderr, "hipFuncSetAttribute failed\n"); grid = -1; return; }
        hipOccupancyMaxActiveBlocksPerMultiprocessor(&per_cu, (const void*)mk, 256, LDS_BYTES + 16);
        if (per_cu < 1) { fprintf(stderr, "occupancy query says %d\n", per_cu); grid = -1; return; }
        if (per_cu > 2) per_cu = 2;
        grid = cus * per_cu;
        fprintf(stderr, "grid %d (cus %d x %d)\n", grid, cus, per_cu);
    }
    if (grid < 0) return;
    Params p{};
    const float* const* in = (const float* const*)d_in;
    p.x_prompt = in[0]; p.x_sample = in[1]; p.cache_k = in[2]; p.cache_v = in[3]; p.cache_ki = in[4]; p.state_conv = in[5];
    p.w_in = in[6]; p.conv_w = in[7]; p.conv_b = in[8]; p.cln_g = in[9]; p.cln_b = in[10]; p.w_o = in[11]; p.ln1_g = in[12]; p.ln1_b = in[13];
    p.w_gu = in[14]; p.w_dn = in[15]; p.ln2_g = in[16]; p.ln2_b = in[17];
    p.out = (float*)d_out;
    unsigned char* w = (unsigned char*)d_ws; size_t off = 0;
    auto take = [&](size_t bytes) { unsigned char* r = w + off; off = al256(off + bytes); return r; };
    p.win_t = (bf16_t*)take((size_t)2 * NINP * DM * 2);
    p.wo_t = (bf16_t*)take((size_t)2 * DM * DM * 2);
    p.wgu_t = (bf16_t*)take((size_t)2 * NGU * DM * 2);
    p.wdn_t = (bf16_t*)take((size_t)2 * DM * DFF * 2);
    p.trig = (float2*)take((size_t)SS * 32 * 8);
    p.kp = (bf16_t*)take((size_t)4 * SP * 128 * 2); p.vp = (bf16_t*)take((size_t)4 * SP * 128 * 2); p.kip = (bf16_t*)take((size_t)4 * SP * 64 * 2);
    p.ks = (bf16_t*)take((size_t)16 * SS * 128 * 2); p.vs = (bf16_t*)take((size_t)16 * SS * 128 * 2); p.kis = (bf16_t*)take((size_t)16 * SS * 64 * 2);
    p.ab = (bf16_t*)take((size_t)TT * DM * 2);
    p.F = (float*)take((size_t)TT * DM * 4);
    unsigned char* big = take((size_t)TT * DFF * 2);
    p.act = (bf16_t*)big;
    p.u = (bf16_t*)big; p.q = (bf16_t*)(big + (size_t)TT * 512 * 2); p.qi = (bf16_t*)(big + (size_t)2 * TT * 512 * 2); p.wi = (float*)(big + (size_t)3 * TT * 512 * 2);
    p.bar = (unsigned*)take((size_t)XCD_BAR_WORDS * 4);
    if (off > ws_size) { fprintf(stderr, "workspace too small: need %zu have %zu\n", off, ws_size); return; }
#if MK_COOP
    if (hipMemsetAsync(p.bar, 0, (size_t)XCD_BAR_WORDS * 4, stream) != hipSuccess) { fprintf(stderr, "memset failed\n"); return; }
    int lo = 0, hi = 15;
    void* args[] = {&p, &lo, &hi};
    hipError_t e = hipLaunchCooperativeKernel((const void*)mk, dim3(grid), dim3(256), args, LDS_BYTES + 16, stream);
    if (e != hipSuccess) fprintf(stderr, "cooperative launch failed: %s (grid %d)\n", hipGetErrorString(e), grid);
#else
    for (int ph = 0; ph < 15; ++ph) hipLaunchKernelGGL(mk, dim3(grid), dim3(256), LDS_BYTES + 16, stream, p, ph, ph + 1);
#endif
}
```

```cpp
#include <hip/hip_runtime.h>
#include <hip/hip_cooperative_groups.h>
#include <cstdio>
#include <cstdint>
namespace cg = cooperative_groups;

#ifndef DUP_PART
#define DUP_PART 0
#endif
#ifndef MK_COOP
#define MK_COOP 1
#endif

typedef unsigned short bf16_t;
typedef short bf16x8 __attribute__((ext_vector_type(8)));
typedef float f32x4 __attribute__((ext_vector_type(4)));
typedef float f32x16 __attribute__((ext_vector_type(16)));
typedef unsigned u32x4 __attribute__((ext_vector_type(4)));

constexpr int DM = 1024, TP = 16384, TSM = 1024, TT = TP + TSM;
constexpr int NIN = 2376, NINP = 2560, DFF = 2816, NGU = 5632;
constexpr int NTHR = 512, NQ = 8;
constexpr int SP = 4096, SS = 4160;
constexpr int LDS_BYTES = NQ * SS * 4 + NQ * 256 * 2;
constexpr float ALPHA = 1.4142135623730951f;
constexpr float LN_EPS = 1e-5f;

constexpr size_t O_YP = 0, O_YS = 16777216, O_KP = 17825792, O_VP = 22020096, O_KIP = 26214400, O_CP = 28311552,
                 O_KS = 28434432, O_VS = 28696576, O_KIS = 28958720, O_CS = 29089792;

struct Params {
    const float *x_prompt, *x_sample, *cache_k, *cache_v, *cache_ki, *state_conv;
    const float *w_in, *conv_w, *conv_b, *cln_g, *cln_b, *w_o, *ln1_g, *ln1_b, *w_gu, *w_dn, *ln2_g, *ln2_b;
    float* out;
    bf16_t *win_t, *wo_t, *wgu_t, *wdn_t;
    float2* trig;
    bf16_t *kp, *vp, *kip, *ks, *vs, *kis;
    bf16_t* ab;
    float* F;
    bf16_t *act, *u, *q, *qi;
    float* wi;
    unsigned* bar;
};

typedef const __attribute__((address_space(4))) Params KP;
__device__ __forceinline__ KP& kparams() { KP* k = (KP*)__builtin_amdgcn_kernarg_segment_ptr(); asm volatile("" : "+s"(k)); return *k; }
__device__ __forceinline__ unsigned pk_bf16(float lo, float hi) { unsigned r; asm volatile("v_cvt_pk_bf16_f32 %0, %1, %2" : "=v"(r) : "v"(lo), "v"(hi)); return r; }
__device__ __forceinline__ float bf_lo(unsigned v) { return __uint_as_float(v << 16); }
__device__ __forceinline__ float bf_hi(unsigned v) { return __uint_as_float(v & 0xffff0000u); }
__device__ __forceinline__ int opaque_tid() { int t = threadIdx.x; asm volatile("" : "+v"(t)); return t; }
__device__ __forceinline__ unsigned tokey(float f) { unsigned u = __float_as_uint(f); return (u & 0x80000000u) ? ~u : (u | 0x80000000u); }
__device__ __forceinline__ float sigmoidf_(float x) { return 1.0f / (1.0f + __expf(-x)); }

__device__ __forceinline__ int perm_in(int n) {
    const int tile = n >> 8, bj = (n >> 7) & 1, wc = (n >> 5) & 3, i = n & 31;
    if (tile < 4) { const int ch = 128 * tile + 32 * wc + i; return bj ? 512 + ch : ch; }
    if (tile < 6) return 1024 + ((tile - 4) * 4 + wc) * 64 + i + 32 * bj;
    if (tile == 6) return (wc < 2) ? 1536 + wc * 64 + i + 32 * bj : 1664 + 64 * bj + 32 * (wc - 2) + i;
    if (tile < 9) return 1792 + ((tile - 7) * 4 + wc) * 64 + i + 32 * bj;
    if (wc == 0) return 2304 + i + 32 * bj;
    if (wc == 1 && bj == 0 && i < 8) return 2368 + i;
    return -1;
}
__device__ __forceinline__ int perm_gu(int n) { const int tile = n >> 8, bj = (n >> 7) & 1, w = n & 127; const int ch = 128 * tile + w; return bj ? DFF + ch : ch; }

template <int MODE>
__device__ __forceinline__ void transpose_tiles(const float* __restrict__ W, bf16_t* __restrict__ Wt, int K, int N, int Np, float* lds0, int& cursor) {
    const int tk = K >> 6, tn = Np >> 6, nt = tk * tn, tid5 = opaque_tid(), vb = tid5 >> 8, tid = tid5 & 255;
    float* lds = lds0 + vb * (64 * 65);
    const int VG = 2 * (int)gridDim.x;
    int f0 = 2 * (int)blockIdx.x - cursor; if (f0 < 0) f0 += VG;
    int f1 = 2 * (int)blockIdx.x + 1 - cursor; if (f1 < 0) f1 += VG;
    cursor = (cursor + nt) % VG;
    const int fmin = f0 < f1 ? f0 : f1, first = vb ? f1 : f0;
    for (int it = 0; fmin + it * VG < nt; ++it) {
        const int t = first + it * VG;
        const bool on = t < nt;
        const int k0 = on ? (t / tn) << 6 : 0, n0 = on ? (t % tn) << 6 : 0;
        __syncthreads();
        if (on) {
#pragma unroll
            for (int i = 0; i < 16; ++i) {
                const int k = i * 4 + (tid >> 6), n = tid & 63;
                int c = n0 + n; if (MODE == 1) c = perm_in(c); else if (MODE == 2) c = perm_gu(c);
                lds[k * 65 + n] = (c >= 0) ? W[(size_t)(k0 + k) * N + c] : 0.f;
            }
        }
        __syncthreads();
        if (on) {
#pragma unroll
            for (int i = 0; i < 8; ++i) {
                const int n = i * 8 + (tid >> 5), k = (tid & 31) * 2;
                *(unsigned*)(Wt + (size_t)(n0 + n) * K + k0 + k) = pk_bf16(lds[k * 65 + n], lds[(k + 1) * 65 + n]);
            }
        }
    }
}

__device__ __forceinline__ void convert_chunks(const float* __restrict__ src, bf16_t* __restrict__ dst, int nb, int chunk8  , int dst_stride8  ) {
    const int total = nb * chunk8;
    for (int i = blockIdx.x * NTHR + opaque_tid(); i < total; i += gridDim.x * NTHR) {
        const int b = i / chunk8, r = i - b * chunk8;
        const float4 a = *(const float4*)(src + (size_t)i * 8), c = *(const float4*)(src + (size_t)i * 8 + 4);
        uint4 o; o.x = pk_bf16(a.x, a.y); o.y = pk_bf16(a.z, a.w); o.z = pk_bf16(c.x, c.y); o.w = pk_bf16(c.z, c.w);
        *(uint4*)(dst + ((size_t)b * dst_stride8 + r) * 8) = o;
    }
}
__device__ __forceinline__ void convert_cache(KP& p, int l) {
    convert_chunks(p.cache_k + (size_t)l * 16 * 4096 * 128, p.ks, 16, 4096 * 16, SS * 16);
    convert_chunks(p.cache_v + (size_t)l * 16 * 4096 * 128, p.vs, 16, 4096 * 16, SS * 16);
    convert_chunks(p.cache_ki + (size_t)l * 16 * 4096 * 64, p.kis, 16, 4096 * 8, SS * 8);
}

__device__ __forceinline__ void phase0(KP& p, unsigned char* lds) {
    int cursor = 0;
    for (int l = 0; l < 2; ++l) {
        transpose_tiles<1>(p.w_in + (size_t)l * DM * NIN, p.win_t + (size_t)l * NINP * DM, DM, NIN, NINP, (float*)lds, cursor);
        transpose_tiles<0>(p.w_o + (size_t)l * DM * DM, p.wo_t + (size_t)l * DM * DM, DM, DM, DM, (float*)lds, cursor);
        transpose_tiles<2>(p.w_gu + (size_t)l * DM * NGU, p.wgu_t + (size_t)l * NGU * DM, DM, NGU, NGU, (float*)lds, cursor);
        transpose_tiles<0>(p.w_dn + (size_t)l * DFF * DM, p.wdn_t + (size_t)l * DM * DFF, DFF, DM, DM, (float*)lds, cursor);
    }
    __syncthreads();
    convert_chunks(p.x_prompt, p.ab, 1, TP * 128, TP * 128);
    convert_chunks(p.x_sample, p.ab + (size_t)TP * DM, 1, TSM * 128, TSM * 128);
    convert_cache(p, 0);
    for (int i = blockIdx.x * NTHR + opaque_tid(); i < SS * 32; i += gridDim.x * NTHR) {
        const int pos = i >> 5, f = i & 31;
        const float inv = exp2f(-(float)f * (13.287712379549449f / 32.0f));
        const float angf = (float)pos * inv;
        const double rev = (double)angf * 0.15915494309189535;
        const double fr = rev - __builtin_rint(rev);
        const float ang = (float)(fr * 6.283185307179586);
        p.trig[i] = make_float2(__cosf(ang), __sinf(ang));
    }
}

namespace pg8 {
#define PG8_LAS __attribute__((address_space(3)))
typedef unsigned short bf16_t;
typedef short bf16x8 __attribute__((ext_vector_type(8)));
typedef float f32x4 __attribute__((ext_vector_type(4)));
typedef unsigned u32x4 __attribute__((ext_vector_type(4)));
constexpr int BM = 256, BK = 64, HALF = 128, HTB = HALF * BK * 2  , STAGE_BYTES = 8 * HTB, NXCD = 8, WGM = 8;

__host__ __device__ __forceinline__ int lds_byte(int r, int c) { const int st = (r >> 4) * 2 + (c >> 5), rr = r & 15, cc = c & 31, ob = rr * 64 + cc * 2; return st * 1024 + (ob ^ (((ob >> 9) & 1) << 5)); }
__host__ __device__ __forceinline__ void stage_rc(int b, int& R, int& C) { const int st = b / 1024, sb = b % 1024, swz = sb ^ (((sb >> 9) & 1) << 5); R = (st >> 1) * 16 + swz / 64; C = (st & 1) * 32 + (swz % 64) / 2; }
__host__ __device__ __forceinline__ int perm32(int rho) { const int n = rho >> 4, i = rho & 15; return 8 * (i >> 2) + 4 * n + (i & 3); }

struct Unit { int pm, pn; };
struct Gemm { const bf16_t* A; const bf16_t* Bt; int M, N, K; };

struct StaticOrder {
    int nM, nN, nwg, G, c;
    __host__ __device__ void init(int M, int N, int G_, int c_) { nM = M / BM; nN = N / BM; nwg = nM * nN; G = G_; c = c_; }
    __host__ __device__ bool next(int i, Unit& u) const {
        const long L = (long)i * G + c; if (L >= nwg) return false;
        int wgid = (int)L; { const int q = nwg / NXCD, r = nwg % NXCD, xcd = wgid % NXCD, off = wgid / NXCD; wgid = (xcd < r ? xcd * (q + 1) : r * (q + 1) + (xcd - r) * q) + off; }
        const int nig = WGM * nN, gid = wgid / nig, fm = gid * WGM, gsz = (nM - fm) < WGM ? (nM - fm) : WGM;
        u.pm = fm + ((wgid % nig) % gsz); u.pn = (wgid % nig) / gsz; return true;
    }
    __device__ __forceinline__ void a_ready(const Unit&) const {}
    __device__ __forceinline__ void done(const Unit&) const {}
};

__device__ __forceinline__ unsigned cvt_pk_bf16(float lo, float hi) { unsigned r; asm volatile("v_cvt_pk_bf16_f32 %0, %1, %2" : "=v"(r) : "v"(lo), "v"(hi)); return r; }
template <class Epi, class Sched, bool ALIGN_EPI = false, bool SP2 = false>
__device__ __forceinline__ void gemm_phase(PG8_LAS unsigned char* lds, const Gemm g, const Sched& S, const Epi& E) {
    const int tid = opaque_tid(), wid = __builtin_amdgcn_readfirstlane(tid >> 6), lane = tid & 63, wr = wid >> 2, wc = wid & 3, fr = lane & 15, fq = lane >> 4;
    const int K = g.K, nt = K / BK;
    unsigned voffA[2], voffB[2];
#pragma unroll
    for (int i = 0; i < 2; ++i) { int R, C; stage_rc(tid * 16 + i * 8192, R, C); const int Rb = Epi::PERM ? ((R & ~31) + perm32(R & 31)) : R;
        voffA[i] = (unsigned)(R * K + C) * 2u; voffB[i] = (unsigned)(Rb * K + C) * 2u; }
    const size_t kstep = (size_t)(BK * 2);
    const size_t hstep = (size_t)HALF * K * 2;
    const size_t tstep = 2 * hstep;
    const unsigned ldsw = (unsigned)wid * 1024u;
    const int aoff = lds_byte(wr * 64 + fr, fq * 8), boff = lds_byte(wc * 32 + fr, fq * 8);
#define PG8_SA(b, h) (((b) * 2 + (h)) * HTB)
#define PG8_SB(b, h) ((4 + (b) * 2 + (h)) * HTB)
#define PG8_STAGE(bufoff, gbase, voff) do { _Pragma("unroll") for (int _i = 0; _i < 2; ++_i) \
        __builtin_amdgcn_global_load_lds((const unsigned*)((const char*)(gbase) + (voff)[_i]), (PG8_LAS unsigned*)(lds + (bufoff) + ldsw + _i * 8192), 16, 0, 0); } while (0)
#define PG8_LDA(dst, b, h) do { _Pragma("unroll") for (int m = 0; m < 4; ++m) _Pragma("unroll") for (int k = 0; k < 2; ++k) dst[m][k] = *(const PG8_LAS bf16x8*)(lds + PG8_SA(b, h) + aoff + m * 2048 + k * 1024); } while (0)
#define PG8_LDB(dst, b, h) do { _Pragma("unroll") for (int n = 0; n < 2; ++n) _Pragma("unroll") for (int k = 0; k < 2; ++k) dst[n][k] = *(const PG8_LAS bf16x8*)(lds + PG8_SB(b, h) + boff + n * 2048 + k * 1024); } while (0)
#define PG8_MMA(ai, bj, At, Bt) do { __builtin_amdgcn_s_setprio(1); _Pragma("unroll") for (int m = 0; m < 4; ++m) _Pragma("unroll") for (int n = 0; n < 2; ++n) _Pragma("unroll") for (int k = 0; k < 2; ++k) \
        acc[ai][bj][m][n] = __builtin_amdgcn_mfma_f32_16x16x32_bf16(Bt[n][k], At[m][k], acc[ai][bj][m][n], 0, 0, 0); __builtin_amdgcn_s_setprio(0); } while (0)
#define PG8_WAIT_V(n) asm volatile("s_waitcnt vmcnt(" #n ")" ::: "memory")
#define PG8_WAIT_L(n) asm volatile("s_waitcnt lgkmcnt(" #n ")" ::: "memory")
#define PG8_BAR __builtin_amdgcn_s_barrier()
#define PG8_SCHED __builtin_amdgcn_sched_barrier(0)
    Unit cur, nxt; int ui = 0;
    if (!S.next(0, cur)) return;
    f32x4 acc[2][2][4][2];
#pragma unroll
    for (int a = 0; a < 2; ++a)
#pragma unroll
        for (int b = 0; b < 2; ++b)
#pragma unroll
            for (int m = 0; m < 4; ++m)
#pragma unroll
                for (int n = 0; n < 2; ++n) acc[a][b][m][n] = (f32x4){0.f, 0.f, 0.f, 0.f};
    bf16x8 At[4][2], B0[2][2], B1[2][2];
    const char* cA = (const char*)g.A + (size_t)cur.pm * tstep; const char* cB = (const char*)g.Bt + (size_t)cur.pn * tstep;
    S.a_ready(cur);
    if constexpr (SP2) {
        PG8_STAGE(PG8_SB(0, 0), cB, voffB); PG8_STAGE(PG8_SB(0, 1), cB + hstep, voffB); PG8_STAGE(PG8_SA(0, 0), cA, voffA); PG8_STAGE(PG8_SA(0, 1), cA + hstep, voffA);
        if (wr == 1) PG8_BAR;
        PG8_WAIT_V(2); PG8_BAR;
        PG8_STAGE(PG8_SB(1, 0), cB + kstep, voffB); PG8_STAGE(PG8_SA(1, 0), cA + kstep, voffA); PG8_STAGE(PG8_SB(1, 1), cB + hstep + kstep, voffB);
        PG8_WAIT_V(6); PG8_BAR;
    } else {
        PG8_STAGE(PG8_SB(0, 0), cB, voffB); PG8_STAGE(PG8_SA(0, 0), cA, voffA); PG8_STAGE(PG8_SB(0, 1), cB + hstep, voffB); PG8_STAGE(PG8_SA(0, 1), cA + hstep, voffA);
        if (wr == 1) PG8_BAR;
        PG8_WAIT_V(4); PG8_BAR;
        PG8_STAGE(PG8_SB(1, 0), cB + kstep, voffB); PG8_STAGE(PG8_SA(1, 0), cA + kstep, voffA); PG8_STAGE(PG8_SB(1, 1), cB + hstep + kstep, voffB);
        PG8_WAIT_V(6); PG8_BAR;
    }
    for (;;) {
        const bool has_next = S.next(ui + 1, nxt);
        const char* nA = has_next ? (const char*)g.A + (size_t)nxt.pm * tstep : cA; const char* nB = has_next ? (const char*)g.Bt + (size_t)nxt.pn * tstep : cB;
        for (int t = 0; t < nt; t += 2) {
            const bool last = (t == nt - 2);
            const char* a1 = cA + (size_t)(t + 1) * kstep;
            const char* a2 = last ? nA : cA + (size_t)(t + 2) * kstep; const char* b2 = last ? nB : cB + (size_t)(t + 2) * kstep;
            const char* a3 = a2 + kstep; const char* b3 = b2 + kstep;
            if (last && has_next) S.a_ready(nxt);
            if constexpr (SP2) {
            PG8_LDB(B0, 0, 0); PG8_LDB(B1, 0, 1); PG8_SCHED; PG8_LDA(At, 0, 0); PG8_STAGE(PG8_SA(1, 1), a1 + hstep, voffA);
            PG8_WAIT_V(8); PG8_WAIT_L(0); PG8_BAR; PG8_MMA(0, 0, At, B0); PG8_MMA(0, 1, At, B1); PG8_BAR; PG8_SCHED;
            PG8_LDA(At, 0, 1); PG8_STAGE(PG8_SB(0, 0), b2, voffB); PG8_STAGE(PG8_SB(0, 1), b2 + hstep, voffB); PG8_STAGE(PG8_SA(0, 0), a2, voffA);
            PG8_WAIT_V(8); PG8_WAIT_L(0); PG8_BAR; PG8_MMA(1, 0, At, B0); PG8_MMA(1, 1, At, B1); PG8_BAR; PG8_SCHED;
            PG8_LDB(B0, 1, 0); PG8_LDB(B1, 1, 1); PG8_SCHED; PG8_LDA(At, 1, 0); PG8_STAGE(PG8_SA(0, 1), a2 + hstep, voffA);
            PG8_WAIT_V(8); PG8_WAIT_L(0); PG8_BAR; PG8_MMA(0, 0, At, B0); PG8_MMA(0, 1, At, B1); PG8_BAR; PG8_SCHED;
            PG8_LDA(At, 1, 1); PG8_STAGE(PG8_SB(1, 0), b3, voffB); PG8_STAGE(PG8_SB(1, 1), b3 + hstep, voffB); PG8_STAGE(PG8_SA(1, 0), a3, voffA);
            PG8_WAIT_V(8); PG8_WAIT_L(0); PG8_BAR; PG8_MMA(1, 0, At, B0); PG8_MMA(1, 1, At, B1); PG8_BAR; PG8_SCHED;
            } else {
            PG8_LDB(B0, 0, 0); PG8_SCHED; PG8_LDA(At, 0, 0); PG8_STAGE(PG8_SA(1, 1), a1 + hstep, voffA);
            PG8_WAIT_L(8); PG8_BAR; PG8_WAIT_L(0); PG8_MMA(0, 0, At, B0); PG8_BAR; PG8_SCHED;
            PG8_LDB(B1, 0, 1); PG8_STAGE(PG8_SB(0, 0), b2, voffB);
            PG8_BAR; PG8_WAIT_L(0); PG8_MMA(0, 1, At, B1); PG8_BAR;
            PG8_LDA(At, 0, 1); PG8_STAGE(PG8_SA(0, 0), a2, voffA);
            PG8_BAR; PG8_WAIT_L(0); PG8_MMA(1, 0, At, B0); PG8_BAR; PG8_SCHED;
            PG8_STAGE(PG8_SB(0, 1), b2 + hstep, voffB);
            PG8_WAIT_V(6); PG8_BAR; PG8_MMA(1, 1, At, B1); PG8_BAR;
            PG8_LDB(B0, 1, 0); PG8_SCHED; PG8_LDA(At, 1, 0); PG8_STAGE(PG8_SA(0, 1), a2 + hstep, voffA);
            PG8_WAIT_L(8); PG8_BAR; PG8_WAIT_L(0); PG8_MMA(0, 0, At, B0); PG8_BAR; PG8_SCHED;
            PG8_LDB(B1, 1, 1); PG8_STAGE(PG8_SB(1, 0), b3, voffB);
            PG8_BAR; PG8_WAIT_L(0); PG8_MMA(0, 1, At, B1); PG8_BAR;
            PG8_LDA(At, 1, 1); PG8_STAGE(PG8_SA(1, 0), a3, voffA);
            PG8_BAR; PG8_WAIT_L(0); PG8_MMA(1, 0, At, B0); PG8_BAR; PG8_SCHED;
            PG8_STAGE(PG8_SB(1, 1), b3 + hstep, voffB);
            PG8_WAIT_V(6); PG8_BAR; PG8_MMA(1, 1, At, B1); PG8_BAR;
            }
        }
        if constexpr (ALIGN_EPI) { if (wr == 0) PG8_BAR; }
        if constexpr (!Epi::AFTER_DRAIN) { E(acc, cur, wr, wc, fr, fq); S.done(cur); }
        if (!has_next) break;
#pragma unroll
        for (int a = 0; a < 2; ++a)
#pragma unroll
            for (int b = 0; b < 2; ++b)
#pragma unroll
                for (int m = 0; m < 4; ++m)
#pragma unroll
                    for (int n = 0; n < 2; ++n) acc[a][b][m][n] = (f32x4){0.f, 0.f, 0.f, 0.f};
        cur = nxt; cA = nA; cB = nB; ++ui;
        if constexpr (ALIGN_EPI) { if (wr == 1) PG8_BAR; }
    }
    PG8_WAIT_V(0);
    if constexpr (!ALIGN_EPI) { if (wr == 0) PG8_BAR; }
    PG8_BAR;
    if constexpr (Epi::AFTER_DRAIN) { E.fused(acc, cur, wr, wc, fr, fq, lds, wid, lane); S.done(cur); }
#undef PG8_SA
#undef PG8_SB
#undef PG8_STAGE
#undef PG8_LDA
#undef PG8_LDB
#undef PG8_MMA
#undef PG8_WAIT_V
#undef PG8_WAIT_L
#undef PG8_BAR
#undef PG8_SCHED
}
}

#ifndef PG8_SP2
#define PG8_SP2 true
#endif
#ifndef PG8_ALIGN
#define PG8_ALIGN true
#endif

__device__ __forceinline__ void tok_decode(int row, bool& isS, int& b, int& t, int& pos) {
    isS = row >= TP;
    if (!isS) { b = row >> 12; t = row & 4095; pos = t; } else { const int r = row - TP; b = r >> 6; t = r & 63; pos = 4096 + t; }
}
typedef pg8::f32x4 (AccT)[2][2][4][2];

struct EpiIn {
    static constexpr bool PERM = false, AFTER_DRAIN = false;
    int l;
    __device__ __forceinline__ void operator()(const AccT& acc, const pg8::Unit& u, int wr, int wc, int fr, int fq) const {
        KP& p = kparams();
        const int tile = u.pn;
#pragma unroll
        for (int ai = 0; ai < 2; ++ai)
#pragma unroll
        for (int m = 0; m < 4; ++m) {
            const int row = u.pm * 256 + ai * 128 + wr * 64 + m * 16 + fr;
            bool isS; int b, t, pos; tok_decode(row, isS, b, t, pos);
            if (tile < 4) {
                const int tl = isS ? t - 34 : t - 4066;
#pragma unroll
                for (int n = 0; n < 2; ++n) {
                    const int ch = 128 * tile + 32 * wc + n * 16 + fq * 4;
                    float uu[4];
#pragma unroll
                    for (int j = 0; j < 4; ++j) uu[j] = acc[ai][0][m][n][j] * sigmoidf_(acc[ai][1][m][n][j]);
                    uint2 w; w.x = pk_bf16(uu[0], uu[1]); w.y = pk_bf16(uu[2], uu[3]);
                    *(uint2*)(p.u + (size_t)row * 512 + ch) = w;
                    if (tl >= 0) {
                        float* o = p.out + (isS ? O_CS + ((size_t)(l * 16 + b) * 30 + tl) * 512 : O_CP + ((size_t)(l * 4 + b) * 30 + tl) * 512) + ch;
                        *(float4*)o = make_float4(uu[0], uu[1], uu[2], uu[3]);
                    }
                }
            } else if (tile == 6 && wc >= 2) {
#pragma unroll
                for (int bj = 0; bj < 2; ++bj) {
                    float* o = p.out + (isS ? O_VS + (((size_t)(l * 16 + b) * 64 + t) * 2 + bj) * 64 : O_VP + (((size_t)(l * 4 + b) * 4096 + t) * 2 + bj) * 64);
                    bf16_t* vb = (isS ? p.vs + ((size_t)b * SS + 4096 + t) * 128 : p.vp + ((size_t)b * SP + t) * 128) + bj * 64;
#pragma unroll
                    for (int n = 0; n < 2; ++n) {
                        const int d = 32 * (wc - 2) + n * 16 + fq * 4;
                        const pg8::f32x4 a = acc[ai][bj][m][n];
                        *(float4*)(o + d) = make_float4(a[0], a[1], a[2], a[3]);
                        uint2 w; w.x = pk_bf16(a[0], a[1]); w.y = pk_bf16(a[2], a[3]);
                        *(uint2*)(vb + d) = w;
                    }
                }
            } else if (tile == 9 && wc >= 1) {
                if (wc == 1 && fq < 2) {
                    const float s = 0.35355339059327373f * 0.125f;
                    const pg8::f32x4 a = acc[ai][0][m][0];
                    *(float4*)(p.wi + (size_t)row * 8 + fq * 4) = make_float4(a[0] * s, a[1] * s, a[2] * s, a[3] * s);
                }
            } else {
                float o1[2][4], o2[2][4];
#pragma unroll
                for (int n = 0; n < 2; ++n) {
                    const float4* tp = (const float4*)(p.trig + (size_t)pos * 32 + n * 16 + fq * 4);
                    const float4 t0 = tp[0], t1 = tp[1];
                    const float cs[4] = {t0.x, t0.z, t1.x, t1.z}, sn[4] = {t0.y, t0.w, t1.y, t1.w};
#pragma unroll
                    for (int j = 0; j < 4; ++j) {
                        const float x1 = acc[ai][0][m][n][j], x2 = acc[ai][1][m][n][j];
                        o1[n][j] = x1 * cs[j] - x2 * sn[j];
                        o2[n][j] = x2 * cs[j] + x1 * sn[j];
                    }
                }
                if (tile == 4 || tile == 5 || tile == 7 || tile == 8) {
                    const bool isq = tile < 6;
                    const float s = isq ? 0.125f * 1.4426950408889634f : 1.0f;
                    bf16_t* dst = (isq ? p.q + (size_t)row * 512 + ((tile - 4) * 4 + wc) * 64 : p.qi + (size_t)row * 512 + ((tile - 7) * 4 + wc) * 64);
#pragma unroll
                    for (int n = 0; n < 2; ++n) {
                        const int d = n * 16 + fq * 4;
                        uint2 w; w.x = pk_bf16(o1[n][0] * s, o1[n][1] * s); w.y = pk_bf16(o1[n][2] * s, o1[n][3] * s);
                        *(uint2*)(dst + d) = w;
                        w.x = pk_bf16(o2[n][0] * s, o2[n][1] * s); w.y = pk_bf16(o2[n][2] * s, o2[n][3] * s);
                        *(uint2*)(dst + d + 32) = w;
                    }
                } else if (tile == 6) {
                    const int kvh = wc;
                    float* o = p.out + (isS ? O_KS + (((size_t)(l * 16 + b) * 64 + t) * 2 + kvh) * 64 : O_KP + (((size_t)(l * 4 + b) * 4096 + t) * 2 + kvh) * 64);
                    bf16_t* kb = (isS ? p.ks + ((size_t)b * SS + 4096 + t) * 128 : p.kp + ((size_t)b * SP + t) * 128) + kvh * 64;
#pragma unroll
                    for (int n = 0; n < 2; ++n) {
                        const int d = n * 16 + fq * 4;
                        *(float4*)(o + d) = make_float4(o1[n][0], o1[n][1], o1[n][2], o1[n][3]);
                        *(float4*)(o + d + 32) = make_float4(o2[n][0], o2[n][1], o2[n][2], o2[n][3]);
                        uint2 w; w.x = pk_bf16(o1[n][0], o1[n][1]); w.y = pk_bf16(o1[n][2], o1[n][3]);
                        *(uint2*)(kb + d) = w;
                        w.x = pk_bf16(o2[n][0], o2[n][1]); w.y = pk_bf16(o2[n][2], o2[n][3]);
                        *(uint2*)(kb + d + 32) = w;
                    }
                } else {
                    float* o = p.out + (isS ? O_KIS + ((size_t)(l * 16 + b) * 64 + t) * 64 : O_KIP + ((size_t)(l * 4 + b) * 4096 + t) * 64);
                    bf16_t* kb = (isS ? p.kis + ((size_t)b * SS + 4096 + t) * 64 : p.kip + ((size_t)b * SP + t) * 64);
#pragma unroll
                    for (int n = 0; n < 2; ++n) {
                        const int d = n * 16 + fq * 4;
                        *(float4*)(o + d) = make_float4(o1[n][0], o1[n][1], o1[n][2], o1[n][3]);
                        *(float4*)(o + d + 32) = make_float4(o2[n][0], o2[n][1], o2[n][2], o2[n][3]);
                        uint2 w; w.x = pk_bf16(o1[n][0], o1[n][1]); w.y = pk_bf16(o1[n][2], o1[n][3]);
                        *(uint2*)(kb + d) = w;
                        w.x = pk_bf16(o2[n][0], o2[n][1]); w.y = pk_bf16(o2[n][2], o2[n][3]);
                        *(uint2*)(kb + d + 32) = w;
                    }
                }
            }
        }
    }
};

struct EpiWo {
    static constexpr bool PERM = false, AFTER_DRAIN = false;
    int l;
    __device__ __forceinline__ void operator()(const AccT& acc, const pg8::Unit& u, int wr, int wc, int fr, int fq) const {
        KP& p = kparams();
#pragma unroll
        for (int ai = 0; ai < 2; ++ai)
#pragma unroll
        for (int m = 0; m < 4; ++m) {
            const int row = u.pm * 256 + ai * 128 + wr * 64 + m * 16 + fr;
            const float* xr = (l == 0) ? ((row < TP) ? p.x_prompt + (size_t)row * DM : p.x_sample + (size_t)(row - TP) * DM) : p.F + (size_t)row * DM;
            float* fo = p.F + (size_t)row * DM;
#pragma unroll
            for (int bj = 0; bj < 2; ++bj)
#pragma unroll
            for (int n = 0; n < 2; ++n) {
                const int c = u.pn * 256 + bj * 128 + wc * 32 + n * 16 + fq * 4;
                const float4 x = *(const float4*)(xr + c);
                const pg8::f32x4 a = acc[ai][bj][m][n];
                *(float4*)(fo + c) = make_float4(ALPHA * x.x + a[0], ALPHA * x.y + a[1], ALPHA * x.z + a[2], ALPHA * x.w + a[3]);
            }
        }
    }
};
struct EpiGu {
    static constexpr bool PERM = false, AFTER_DRAIN = false;
    int pad_;
    __device__ __forceinline__ void operator()(const AccT& acc, const pg8::Unit& u, int wr, int wc, int fr, int fq) const {
        KP& p = kparams();
#pragma unroll
        for (int ai = 0; ai < 2; ++ai)
#pragma unroll
        for (int m = 0; m < 4; ++m) {
            const int row = u.pm * 256 + ai * 128 + wr * 64 + m * 16 + fr;
#pragma unroll
            for (int n = 0; n < 2; ++n) {
                float a[4];
#pragma unroll
                for (int j = 0; j < 4; ++j) { const float g = acc[ai][0][m][n][j]; a[j] = g * sigmoidf_(g) * acc[ai][1][m][n][j]; }
                uint2 w; w.x = pk_bf16(a[0], a[1]); w.y = pk_bf16(a[2], a[3]);
                *(uint2*)(p.act + (size_t)row * DFF + 128 * u.pn + 32 * wc + n * 16 + fq * 4) = w;
            }
        }
    }
};
struct EpiDn {
    static constexpr bool PERM = false, AFTER_DRAIN = false;
    int pad_;
    __device__ __forceinline__ void operator()(const AccT& acc, const pg8::Unit& u, int wr, int wc, int fr, int fq) const {
        KP& p = kparams();
#pragma unroll
        for (int ai = 0; ai < 2; ++ai)
#pragma unroll
        for (int m = 0; m < 4; ++m) {
            float* fo = p.F + (size_t)(u.pm * 256 + ai * 128 + wr * 64 + m * 16 + fr) * DM;
#pragma unroll
            for (int bj = 0; bj < 2; ++bj)
#pragma unroll
            for (int n = 0; n < 2; ++n) {
                const int c = u.pn * 256 + bj * 128 + wc * 32 + n * 16 + fq * 4;
                const float4 x = *(const float4*)(fo + c);
                const pg8::f32x4 a = acc[ai][bj][m][n];
                *(float4*)(fo + c) = make_float4(ALPHA * x.x + a[0], ALPHA * x.y + a[1], ALPHA * x.z + a[2], ALPHA * x.w + a[3]);
            }
        }
    }
};
template <class Epi>
__device__ __forceinline__ void gemm_run(const bf16_t* A, const bf16_t* Bt, int N, int K, unsigned char* lds, const Epi& e) {
    pg8::Gemm g; g.A = A; g.Bt = Bt; g.M = TT; g.N = N; g.K = K;
    pg8::StaticOrder S; S.init(TT, N, (int)gridDim.x, (int)blockIdx.x);
    pg8::gemm_phase<Epi, pg8::StaticOrder, true, true>((PG8_LAS unsigned char*)lds, g, S, e);
}

__device__ __forceinline__ void ln_phase(KP& p, int l, int which) {
    const int tid = opaque_tid(), lane = tid & 63, wid = tid >> 6;
    const float* g = (which == 1 ? p.ln1_g : p.ln2_g) + l * DM;
    const float* bb = (which == 1 ? p.ln1_b : p.ln2_b) + l * DM;
    const bool fin = (which == 2 && l == 1);
    for (int row = blockIdx.x * 8 + wid; row < TT; row += gridDim.x * 8) {
        float* fr = p.F + (size_t)row * DM;
        float4 v[4];
        float s = 0.f;
#pragma unroll
        for (int i = 0; i < 4; ++i) { v[i] = *(const float4*)(fr + i * 256 + lane * 4); s += (v[i].x + v[i].y) + (v[i].z + v[i].w); }
#pragma unroll
        for (int o = 32; o >= 1; o >>= 1) s += __shfl_xor(s, o);
        const float mean = s * (1.0f / 1024.0f);
        float q = 0.f;
#pragma unroll
        for (int i = 0; i < 4; ++i) { const float a = v[i].x - mean, b = v[i].y - mean, c = v[i].z - mean, d = v[i].w - mean; q += (a * a + b * b) + (c * c + d * d); }
#pragma unroll
        for (int o = 32; o >= 1; o >>= 1) q += __shfl_xor(q, o);
        const float rstd = rsqrtf(q * (1.0f / 1024.0f) + LN_EPS);
#pragma unroll
        for (int i = 0; i < 4; ++i) {
            const int c = i * 256 + lane * 4;
            const float4 gg = *(const float4*)(g + c), be = *(const float4*)(bb + c);
            const float4 o = make_float4((v[i].x - mean) * rstd * gg.x + be.x, (v[i].y - mean) * rstd * gg.y + be.y, (v[i].z - mean) * rstd * gg.z + be.z, (v[i].w - mean) * rstd * gg.w + be.w);
            if (fin) *(float4*)(p.out + (size_t)row * DM + c) = o;
            else {
                *(float4*)(fr + c) = o;
                uint2 w; w.x = pk_bf16(o.x, o.y); w.y = pk_bf16(o.z, o.w);
                *(uint2*)(p.ab + (size_t)row * DM + c) = w;
            }
        }
    }
}

__device__ __forceinline__ void conv_unit(KP& p, int l, int cu, unsigned char* lds) {
    const int tid5 = opaque_tid(), hb = tid5 >> 8, tid = tid5 & 255, lane = tid & 63, wid = tid >> 6;
    const int row0 = cu * 16;
    bool isS; int b, t0, pos; tok_decode(row0, isS, b, t0, pos);
    const int seq_row0 = row0 - t0, tb = t0 + 8 * hb;
    unsigned* xs = (unsigned*)(lds + hb * 40960);
    float* red = (float*)(lds + 81920 + hb * 512);
    const unsigned* ug = (const unsigned*)p.u;
    __syncthreads();
    {
        const int nneg = tb < 30 ? 30 - tb : 0;
#pragma unroll
        for (int i = 0; i < 38; ++i) {
            const int tok = tb - 30 + i;
            const int tokc = tok < 0 ? 0 : tok;
            unsigned v = ug[(size_t)(seq_row0 + tokc) * 256 + tid];
            if (i < 30 && i < nneg) {
                v = 0u;
                if (isS) { const float2 s = *(const float2*)(p.state_conv + ((size_t)(l * 16 + b) * 30 + (30 + tok)) * 512 + 2 * tid); v = pk_bf16(s.x, s.y); }
            }
            xs[i * 256 + tid] = v;
        }
    }
    float cw0[31], cw1[31];
#pragma unroll
    for (int w = 0; w < 31; ++w) { const float2 c = *(const float2*)(p.conv_w + ((size_t)l * 31 + w) * 512 + 2 * tid); cw0[w] = c.x; cw1[w] = c.y; }
    const float2 cb = *(const float2*)(p.conv_b + l * 512 + 2 * tid);
#pragma unroll 2
    for (int t = 0; t < 8; ++t) {
        float a0 = cb.x, a1 = cb.y;
        const unsigned* xr = xs + t * 256 + tid;
#pragma unroll
        for (int w = 0; w < 31; ++w) { const unsigned v = xr[w * 256]; a0 += bf_lo(v) * cw0[w]; a1 += bf_hi(v) * cw1[w]; }
        float s = a0 + a1, q = a0 * a0 + a1 * a1;
#pragma unroll
        for (int o = 32; o >= 1; o >>= 1) { s += __shfl_xor(s, o); q += __shfl_xor(q, o); }
        if (lane == 0) { red[(wid * 8 + t) * 2] = s; red[(wid * 8 + t) * 2 + 1] = q; }
        xs[t * 256 + tid] = pk_bf16(a0, a1);
    }
    __syncthreads();
    const float2 lg = *(const float2*)(p.cln_g + l * 512 + 2 * tid);
    const float2 lb = *(const float2*)(p.cln_b + l * 512 + 2 * tid);
#pragma unroll 4
    for (int t = 0; t < 8; ++t) {
        const float s = (red[t * 2] + red[(8 + t) * 2]) + (red[(16 + t) * 2] + red[(24 + t) * 2]);
        const float q = (red[t * 2 + 1] + red[(8 + t) * 2 + 1]) + (red[(16 + t) * 2 + 1] + red[(24 + t) * 2 + 1]);
        const float mean = s * (1.0f / 512.0f);
        const float var = fmaxf(q * (1.0f / 512.0f) - mean * mean, 0.f);
        const float rstd = rsqrtf(var + LN_EPS);
        const unsigned v = xs[t * 256 + tid];
        float a = (bf_lo(v) - mean) * rstd * lg.x + lb.x, c = (bf_hi(v) - mean) * rstd * lg.y + lb.y;
        a = a * sigmoidf_(a); c = c * sigmoidf_(c);
        *(unsigned*)(p.ab + (size_t)(row0 + 8 * hb + t) * DM + 2 * tid) = pk_bf16(a, c);
    }
    __syncthreads();
}

__device__ __forceinline__ void attn_unit(KP& p, int isS, int b, int t0, unsigned char* lds) {
    const int tid = opaque_tid(), lane = tid & 63, wid = tid >> 6, r = lane & 31, hh = lane >> 5;
    unsigned* sc = (unsigned*)lds;
    unsigned short* idxl = (unsigned short*)(lds + NQ * SS * 4) + wid * 256;
    const int row0 = isS ? TP + b * 64 + t0 : b * 4096 + t0;
    const int S = isS ? SS : ((t0 >> 6) + 1) * 64;
    const bf16_t* KI = isS ? p.kis + (size_t)b * SS * 64 : p.kip + (size_t)b * SP * 64;
    const bf16_t* Kc = isS ? p.ks + (size_t)b * SS * 128 : p.kp + (size_t)b * SP * 128;
    const bf16_t* Vc = isS ? p.vs + (size_t)b * SS * 128 : p.vp + (size_t)b * SP * 128;
    __syncthreads();
    {
        bf16x8 qf[2][4];
#pragma unroll
        for (int gq = 0; gq < 2; ++gq)
#pragma unroll
            for (int ks = 0; ks < 4; ++ks) qf[gq][ks] = *(const bf16x8*)(p.qi + (size_t)(row0 + 4 * gq + (r >> 3)) * 512 + (r & 7) * 64 + ks * 16 + hh * 8);
        float w[8][4];
#pragma unroll
        for (int q = 0; q < 8; ++q) { const float4 t = *(const float4*)(p.wi + (size_t)(row0 + q) * 8 + 4 * hh); w[q][0] = t.x; w[q][1] = t.y; w[q][2] = t.z; w[q][3] = t.w; }
        const int ntile = S >> 5;
        auto ldk = [&](int kt, bf16x8 (&kf)[4]) {
            const bf16_t* kr = KI + (size_t)(kt * 32 + r) * 64 + hh * 8;
#pragma unroll
            for (int ks = 0; ks < 4; ++ks) kf[ks] = *(const bf16x8*)(kr + ks * 16);
        };
        auto comp = [&](int kt, const bf16x8 (&kf)[4]) {
#pragma unroll
            for (int gq = 0; gq < 2; ++gq) {
                f32x16 d;
#pragma unroll
                for (int i = 0; i < 16; ++i) d[i] = 0.f;
#pragma unroll
                for (int ks = 0; ks < 4; ++ks) d = __builtin_amdgcn_mfma_f32_32x32x16_bf16(qf[gq][ks], kf[ks], d, 0, 0, 0);
                float s[4];
#pragma unroll
                for (int q = 0; q < 4; ++q) {
                    const float* wq = w[4 * gq + q];
                    s[q] = (wq[0] * fmaxf(d[4 * q], 0.f) + wq[1] * fmaxf(d[4 * q + 1], 0.f)) + (wq[2] * fmaxf(d[4 * q + 2], 0.f) + wq[3] * fmaxf(d[4 * q + 3], 0.f));
                    s[q] += __shfl_xor(s[q], 32);
                    s[q] += 0.0f;
                }
                const float a0 = hh ? s[2] : s[0], a1 = hh ? s[3] : s[1];
                sc[(4 * gq + hh * 2) * SS + kt * 32 + r] = tokey(a0);
                sc[(4 * gq + hh * 2 + 1) * SS + kt * 32 + r] = tokey(a1);
            }
        };
        bf16x8 ka[4], kb[4];
        int kt = wid;
        if (kt < ntile) ldk(kt, ka);
        for (; kt < ntile; kt += 16) {
            if (kt + 8 < ntile) ldk(kt + 8, kb);
            comp(kt, ka);
            if (kt + 16 < ntile) ldk(kt + 16, ka);
            if (kt + 8 < ntile) comp(kt + 8, kb);
        }
    }
    __syncthreads();
    const int Ksel = S < 256 ? S : 256;
    for (int rep = 0; rep < (DUP_PART == 2 ? 2 : 1); ++rep)
    if (S <= 256) {
        for (int i = lane; i < S; i += 64) idxl[i] = (unsigned short)i;
    } else {
        unsigned key[65];
        const unsigned* myr = sc + wid * SS;
        const int nslot = S >> 6;
#pragma unroll
        for (int s = 0; s < 65; ++s) key[s] = (s < nslot) ? myr[s * 64 + lane] : 0u;
        unsigned P = 0; bool exact = false;
        for (int bit = 31; bit >= 0; --bit) {
            const unsigned C = P | (1u << bit);
            int cnt = 0;
#pragma unroll
            for (int sg = 0; sg < 13; ++sg) {
                if (sg * 5 < nslot) {
#pragma unroll
                    for (int s = sg * 5; s < sg * 5 + 5; ++s) cnt += __builtin_popcountll(__ballot(key[s] >= C));
                }
            }
            if (cnt >= 256) { P = C; if (cnt == 256) { exact = true; break; } }
        }
        const unsigned Tg = exact ? P - 1u : P;
        const unsigned long long lt = (1ull << lane) - 1ull;
        int base = 0;
#pragma unroll
        for (int sg = 0; sg < 13; ++sg) {
            if (sg * 5 < nslot) {
#pragma unroll
                for (int s = sg * 5; s < sg * 5 + 5; ++s) {
                    const bool g = key[s] > Tg;
                    const unsigned long long m = __ballot(g);
                    if (g) idxl[base + __builtin_popcountll(m & lt)] = (unsigned short)(s * 64 + lane);
                    base += __builtin_popcountll(m);
                }
            }
        }
        const int need = 256 - base;
        if (need > 0) {
            int tb = 0;
#pragma unroll
            for (int s = 0; s < 65; ++s) {
                const bool e = (key[s] == Tg) && (s < nslot);
                const unsigned long long m = __ballot(e);
                const int rk = tb + __builtin_popcountll(m & lt);
                if (e && rk < need) idxl[base + rk] = (unsigned short)(s * 64 + lane);
                tb += __builtin_popcountll(m);
            }
        }
    }
    __syncthreads();
    const int row = row0 + wid;
    float* Pl = (float*)(sc + wid * SS);
    for (int rep = 0; rep < (DUP_PART == 3 ? 2 : 1); ++rep) {
    {
        bf16x8 qa[8];
#pragma unroll
        for (int ks = 0; ks < 8; ++ks) {
            const int kk = ks * 16 + hh * 8, g = kk >> 6, d = kk & 63;
            const bool valid = (r < 8) && ((r >> 2) == g);
            bf16x8 z;
#pragma unroll
            for (int j = 0; j < 8; ++j) z[j] = 0;
            qa[ks] = valid ? *(const bf16x8*)(p.q + (size_t)row * 512 + r * 64 + d) : z;
        }
        auto ldq = [&](int tile, bf16x8 (&kf)[8]) {
            const int key = tile * 32 + r;
            const int id = (key < Ksel) ? (int)idxl[key] : 0;
            const bf16_t* kr = Kc + (size_t)id * 128 + hh * 8;
#pragma unroll
            for (int ks = 0; ks < 8; ++ks) kf[ks] = *(const bf16x8*)(kr + ks * 16);
        };
        auto cmq = [&](int tile, const bf16x8 (&kf)[8]) {
            const int key = tile * 32 + r;
            f32x16 d;
#pragma unroll
            for (int i = 0; i < 16; ++i) d[i] = 0.f;
#pragma unroll
            for (int ks = 0; ks < 8; ++ks) d = __builtin_amdgcn_mfma_f32_32x32x16_bf16(qa[ks], kf[ks], d, 0, 0, 0);
            const bool ok = key < Ksel;
            *(float4*)(Pl + key * 8 + 4 * hh) = make_float4(ok ? d[0] : -INFINITY, ok ? d[1] : -INFINITY, ok ? d[2] : -INFINITY, ok ? d[3] : -INFINITY);
        };
        bf16x8 ka[8], kb[8];
        ldq(0, ka);
#pragma unroll 1
        for (int tile = 0; tile < 8; tile += 2) {
            ldq(tile + 1, kb);
            cmq(tile, ka);
            if (tile + 2 < 8) ldq(tile + 2, ka);
            cmq(tile + 1, kb);
        }
    }
    {
        float lg[8][4];
#pragma unroll
        for (int tile = 0; tile < 8; ++tile) { const float4 t = *(const float4*)(Pl + (tile * 32 + r) * 8 + 4 * hh); lg[tile][0] = t.x; lg[tile][1] = t.y; lg[tile][2] = t.z; lg[tile][3] = t.w; }
#pragma unroll
        for (int i = 0; i < 4; ++i) {
            float mx = lg[0][i];
#pragma unroll
            for (int tile = 1; tile < 8; ++tile) mx = fmaxf(mx, lg[tile][i]);
#pragma unroll
            for (int o = 16; o >= 1; o >>= 1) mx = fmaxf(mx, __shfl_xor(mx, o));
            float sm = 0.f;
#pragma unroll
            for (int tile = 0; tile < 8; ++tile) { lg[tile][i] = exp2f(lg[tile][i] - mx); sm += lg[tile][i]; }
#pragma unroll
            for (int o = 16; o >= 1; o >>= 1) sm += __shfl_xor(sm, o);
            const float inv = 1.0f / sm;
#pragma unroll
            for (int tile = 0; tile < 8; ++tile) lg[tile][i] *= inv;
        }
#pragma unroll
        for (int tile = 0; tile < 8; ++tile) *(float4*)(Pl + (tile * 32 + r) * 8 + 4 * hh) = make_float4(lg[tile][0], lg[tile][1], lg[tile][2], lg[tile][3]);
    }
    }
    __syncthreads();
    {
        const int sub = lane & 15, kq = lane >> 4, g = sub >> 3;
        typedef float f32x2 __attribute__((ext_vector_type(2)));
        f32x2 acc[4][4];
        for (int rep = 0; rep < (DUP_PART == 4 ? 2 : 1); ++rep) {
#pragma unroll
        for (int h = 0; h < 4; ++h)
#pragma unroll
            for (int i = 0; i < 4; ++i) acc[h][i] = (f32x2){0.f, 0.f};
        auto ldv = [&](int k0, u32x4 (&v)[8]) {
#pragma unroll
            for (int j = 0; j < 8; ++j) { const int id = idxl[k0 + 4 * j + kq]; v[j] = *(const u32x4*)(Vc + (size_t)id * 128 + sub * 8); }
        };
        auto cmv = [&](int k0, const u32x4 (&v)[8]) {
#pragma unroll
            for (int j = 0; j < 8; ++j) {
                const float4 pp = *(const float4*)(Pl + (k0 + 4 * j + kq) * 8 + 4 * g);
                const float ph[4] = {pp.x, pp.y, pp.z, pp.w};
#pragma unroll
                for (int i = 0; i < 4; ++i) {
                    const f32x2 vv = (f32x2){bf_lo(v[j][i]), bf_hi(v[j][i])};
#pragma unroll
                    for (int h = 0; h < 4; ++h) acc[h][i] += vv * ph[h];
                }
            }
        };
        u32x4 va[8], vb[8];
        ldv(0, va);
#pragma unroll 1
        for (int k0 = 0; k0 < Ksel; k0 += 64) {
            if (k0 + 32 < Ksel) ldv(k0 + 32, vb);
            cmv(k0, va);
            if (k0 + 64 < Ksel) ldv(k0 + 64, va);
            if (k0 + 32 < Ksel) cmv(k0 + 32, vb);
        }
        }
#pragma unroll
        for (int h = 0; h < 4; ++h)
#pragma unroll
            for (int i = 0; i < 4; ++i) {
                float x = acc[h][i].x, y = acc[h][i].y;
                x += __shfl_xor(x, 16); y += __shfl_xor(y, 16);
                x += __shfl_xor(x, 32); y += __shfl_xor(y, 32);
                acc[h][i] = (f32x2){x, y};
            }
        if (kq == 0) {
#pragma unroll
            for (int h = 0; h < 4; ++h) {
                u32x4 w;
                w.x = pk_bf16(acc[h][0].x, acc[h][0].y); w.y = pk_bf16(acc[h][1].x, acc[h][1].y);
                w.z = pk_bf16(acc[h][2].x, acc[h][2].y); w.w = pk_bf16(acc[h][3].x, acc[h][3].y);
                *(u32x4*)(p.ab + (size_t)row * DM + 512 + (4 * g + h) * 64 + (sub & 7) * 8) = w;
            }
        }
    }
}

__device__ __forceinline__ void mixer_unit(KP& p, int l, int pair, int u, unsigned char* lds) {
    if (u < 544) {
        int isS, b, t0;
        if (u < 32) { isS = 1; b = 4 * pair + (u >> 3); t0 = (u & 7) * 8; }
        else { const int j = u - 32; isS = 0; b = pair; t0 = (63 - (j >> 3)) * 64 + (j & 7) * 8; }
        attn_unit(p, isS, b, t0, lds);
    } else { const int j = u - 544; conv_unit(p, l, (j < 256) ? pair * 256 + j : 1024 + pair * 16 + (j - 256), lds); }
}
__device__ __forceinline__ void mixer_phase(KP& p, int l, unsigned char* lds) {
    const int G = gridDim.x;
    const bool fast = (G == 256);
    const int x = blockIdx.x & 7, jb = blockIdx.x >> 3, rb = (x & 1) * 32 + jb;
    const int nrd = fast ? 13 : (4 * 816 + G - 1) / G;
    for (int rd = 0; rd < nrd; ++rd) {
        int pair, u; bool valid;
        if (fast) { u = rd * 64 + ((rd & 1) ? (63 - rb) : rb); pair = x >> 1; valid = u < 816; }
        else { const int i = rd * G + (int)blockIdx.x; valid = i < 4 * 816; pair = i / 816; u = i - pair * 816; }
        if (valid) mixer_unit(p, l, pair, u, lds);
    }
}

#define XB_TMO      128
#define XB_XCNT(j)  (256  + 64 * (j))
#define XB_XSUB(j)  (1280 + 64 * (j))
#define XB_XGEN(j)  (2304 + 64 * (j))
#define XB_TOP      3328
#define XB_TOPGEN   3392
#define XCD_BAR_WORDS 3456
#define XB_SPIN_CAP (1u << 20)
__device__ __forceinline__ unsigned xb_ld(unsigned* p)              { return __hip_atomic_load(p, __ATOMIC_RELAXED, __HIP_MEMORY_SCOPE_AGENT); }
__device__ __forceinline__ unsigned xb_add(unsigned* p, unsigned v) { return __hip_atomic_fetch_add(p, v, __ATOMIC_RELAXED, __HIP_MEMORY_SCOPE_AGENT); }
__device__ __forceinline__ unsigned xb_xcc_id() { return (unsigned)__builtin_amdgcn_s_getreg((3 << 11) | 20) & 0xFu; }
#define XB_SPIN(cond, bar) do { unsigned _sp = 0; while (cond) { __builtin_amdgcn_s_sleep(1); \
    if ((++_sp & 255u) == 0u) { if (xb_ld(&(bar)[XB_TMO])) break; if (_sp > XB_SPIN_CAP) { atomicAdd(&(bar)[XB_TMO], 1u); break; } } } } while (0)
struct XcdBarrier { unsigned* bar; unsigned x; volatile unsigned* st; };
__device__ __forceinline__ XcdBarrier xcd_barrier_post(unsigned* bar, volatile unsigned* st) {
    XcdBarrier b; b.bar = bar; b.x = xb_xcc_id(); b.st = st;
    if (threadIdx.x == 0) (void)xb_add(&bar[XB_XCNT(b.x)], 1u);
    return b;
}
__device__ __forceinline__ void xcd_barrier_complete(unsigned* bar, unsigned x, unsigned& nloc, unsigned& nx) {
    const unsigned G = gridDim.x * gridDim.y * gridDim.z;
    unsigned sum, cnt, mine, sp = 0u;
    for (;;) {
        sum = 0u; cnt = 0u; mine = 0u;
#pragma unroll
        for (unsigned j = 0; j < 16; ++j) { const unsigned c = xb_ld(&bar[XB_XCNT(j)]); sum += c; cnt += (c > 0u) ? 1u : 0u; mine = (j == x) ? c : mine; }
        if (sum == G) break;
        __builtin_amdgcn_s_sleep(1);
        if ((++sp & 255u) == 0u) { if (xb_ld(&bar[XB_TMO])) break; if (sp > XB_SPIN_CAP) { atomicAdd(&bar[XB_TMO], 1u); break; } }
    }
    nloc = mine > 0u ? mine : 1u; nx = cnt > 0u ? cnt : 1u;
}
__device__ __forceinline__ void xcd_barrier(const XcdBarrier& b) {
    asm volatile("s_waitcnt vmcnt(0)" ::: "memory");
    __syncthreads();
    if (threadIdx.x == 0) {
        unsigned* bar = b.bar;
        __builtin_amdgcn_s_waitcnt(0);
        unsigned nloc = b.st[0], nx = b.st[1];
        if (nloc == 0u) { xcd_barrier_complete(bar, b.x, nloc, nx); b.st[0] = nloc; b.st[1] = nx; }
        const unsigned old = xb_add(&bar[XB_XSUB(b.x)], 1u);
        const unsigned gen = old / nloc;
        if (old + 1u == (gen + 1u) * nloc) {
            __builtin_amdgcn_fence(__ATOMIC_RELEASE, "agent");
            asm volatile("s_waitcnt vmcnt(0)" ::: "memory");
            const unsigned og = xb_add(&bar[XB_TOP], 1u);
            const unsigned tg = og / nx;
            if (og + 1u == (tg + 1u) * nx) xb_add(&bar[XB_TOPGEN], 1u);
            else XB_SPIN(xb_ld(&bar[XB_TOPGEN]) == tg, bar);
            __builtin_amdgcn_fence(__ATOMIC_ACQUIRE, "agent");
            xb_add(&bar[XB_XGEN(b.x)], 1u);
            asm volatile("s_waitcnt vmcnt(0)" ::: "memory");
        } else {
            XB_SPIN(xb_ld(&bar[XB_XGEN(b.x)]) == gen, bar);
            __builtin_amdgcn_fence(__ATOMIC_ACQUIRE, "agent");
            asm volatile("s_waitcnt vmcnt(0)" ::: "memory");
        }
    }
    __syncthreads();
}

__device__ __forceinline__ void run_phase(KP& p, int ph, unsigned char* lds) {
#ifndef TEST_K
    if (ph == 0) { phase0(p, lds); return; }
#else
    if (TEST_K == 7) { phase0(p, lds); return; }
#endif
    const int l = (ph - 1) / 7, k = (ph - 1) % 7;
#ifdef TEST_K
    if (k != TEST_K) return;
#endif
    switch (k) {
        case 0: { EpiIn e{l}; gemm_run(p.ab, p.win_t + (size_t)l * NINP * DM, NINP, DM, lds, e); } break;
        case 1: mixer_phase(p, l, lds); break;
        case 2: { EpiWo e{l}; gemm_run(p.ab, p.wo_t + (size_t)l * DM * DM, DM, DM, lds, e); } break;
        case 3: ln_phase(p, l, 1); if (l == 0) convert_cache(p, 1); break;
        case 4: { EpiGu e{0}; gemm_run(p.ab, p.wgu_t + (size_t)l * NGU * DM, NGU, DM, lds, e); } break;
        case 5: { EpiDn e{0}; gemm_run(p.act, p.wdn_t + (size_t)l * DM * DFF, DM, DFF, lds, e); } break;
        case 6: ln_phase(p, l, 2); break;
    }
}

__global__ void __launch_bounds__(512, 2) mk(Params p, int ph_lo, int ph_hi) {
    extern __shared__ __attribute__((aligned(16))) unsigned char lds[];
#if MK_COOP
    volatile unsigned* st = (volatile unsigned*)(lds + LDS_BYTES);
    if (threadIdx.x == 0) { st[0] = 0u; st[1] = 0u; st[2] = 0u; st[3] = 0u; }
    __syncthreads();
    XcdBarrier xb = xcd_barrier_post(kparams().bar, st);
#endif
    for (int ph = ph_lo; ph < ph_hi; ++ph) {
        int reps = 1;
#ifdef DUP_K
        if (ph > 0 && (ph - 1) % 7 == DUP_K) reps = 2;
        if (ph == 0 && DUP_K == 7) reps = 2;
#endif
        for (int rp = 0; rp < reps; ++rp) { run_phase(kparams(), ph, lds); __syncthreads(); }
#if MK_COOP
        if (ph + 1 < ph_hi) xcd_barrier(xb);
#endif
    }
}

static inline size_t al256(size_t x) { return (x + 255) & ~(size_t)255; }

extern "C" void kernel_launch(void* const* d_in, const int* in_sizes, int n_in, void* d_out, int out_size, void* d_ws, size_t ws_size, hipStream_t stream) {
    static int grid = 0;
    if (grid == 0) {
        int dev = 0, cus = 0, per_cu = 0;
        hipGetDevice(&dev);
        hipDeviceGetAttribute(&cus, hipDeviceAttributeMultiprocessorCount, dev);
        if (hipFuncSetAttribute((const void*)mk, hipFuncAttributeMaxDynamicSharedMemorySize, LDS_BYTES + 16) != hipSuccess) { fprintf(stderr, "hipFuncSetAttribute failed\n"); grid = -1; return; }
        hipOccupancyMaxActiveBlocksPerMultiprocessor(&per_cu, (const void*)mk, NTHR, LDS_BYTES + 16);
        if (per_cu < 1) { fprintf(stderr, "occupancy query says %d\n", per_cu); grid = -1; return; }
        if (per_cu > 1) per_cu = 1;
        grid = cus * per_cu;
        fprintf(stderr, "grid %d (cus %d x %d)\n", grid, cus, per_cu);
    }
    if (grid < 0) return;
    Params p{};
    const float* const* in = (const float* const*)d_in;
    p.x_prompt = in[0]; p.x_sample = in[1]; p.cache_k = in[2]; p.cache_v = in[3]; p.cache_ki = in[4]; p.state_conv = in[5];
    p.w_in = in[6]; p.conv_w = in[7]; p.conv_b = in[8]; p.cln_g = in[9]; p.cln_b = in[10]; p.w_o = in[11]; p.ln1_g = in[12]; p.ln1_b = in[13];
    p.w_gu = in[14]; p.w_dn = in[15]; p.ln2_g = in[16]; p.ln2_b = in[17];
    p.out = (float*)d_out;
    unsigned char* w = (unsigned char*)d_ws; size_t off = 0;
    auto take = [&](size_t bytes) { unsigned char* r = w + off; off = al256(off + bytes); return r; };
    p.win_t = (bf16_t*)take((size_t)2 * NINP * DM * 2);
    p.wo_t = (bf16_t*)take((size_t)2 * DM * DM * 2);
    p.wgu_t = (bf16_t*)take((size_t)2 * NGU * DM * 2);
    p.wdn_t = (bf16_t*)take((size_t)2 * DM * DFF * 2);
    p.trig = (float2*)take((size_t)SS * 32 * 8);
    p.kp = (bf16_t*)take((size_t)4 * SP * 128 * 2); p.vp = (bf16_t*)take((size_t)4 * SP * 128 * 2); p.kip = (bf16_t*)take((size_t)4 * SP * 64 * 2);
    p.ks = (bf16_t*)take((size_t)16 * SS * 128 * 2); p.vs = (bf16_t*)take((size_t)16 * SS * 128 * 2); p.kis = (bf16_t*)take((size_t)16 * SS * 64 * 2);
    p.ab = (bf16_t*)take((size_t)TT * DM * 2);
    p.F = (float*)take((size_t)TT * DM * 4);
    unsigned char* big = take((size_t)TT * DFF * 2);
    p.act = (bf16_t*)big;
    p.u = (bf16_t*)big; p.q = (bf16_t*)(big + (size_t)TT * 512 * 2); p.qi = (bf16_t*)(big + (size_t)2 * TT * 512 * 2); p.wi = (float*)(big + (size_t)3 * TT * 512 * 2);
    p.bar = (unsigned*)take((size_t)XCD_BAR_WORDS * 4);
    if (off > ws_size) { fprintf(stderr, "workspace too small: need %zu have %zu\n", off, ws_size); return; }
#if MK_COOP
    if (hipMemsetAsync(p.bar, 0, (size_t)XCD_BAR_WORDS * 4, stream) != hipSuccess) { fprintf(stderr, "memset failed\n"); return; }
    int lo = 0, hi = 15;
    void* args[] = {&p, &lo, &hi};
    hipError_t e = hipLaunchCooperativeKernel((const void*)mk, dim3(grid), dim3(NTHR), args, LDS_BYTES + 16, stream);
    if (e != hipSuccess) fprintf(stderr, "cooperative launch failed: %s (grid %d)\n", hipGetErrorString(e), grid);
#else
    for (int ph = 0; ph < 15; ++ph) hipLaunchKernelGGL(mk, dim3(grid), dim3(NTHR), LDS_BYTES + 16, stream, p, ph, ph + 1);
#endif
}
```

```cpp
#include <hip/hip_runtime.h>
#include <hip/hip_cooperative_groups.h>
#include <cstdio>
#include <cstdint>
namespace cg = cooperative_groups;

#ifndef DUP_PART
#define DUP_PART 0
#endif
#ifndef MK_COOP
#define MK_COOP 1
#endif

typedef unsigned short bf16_t;
typedef short bf16x8 __attribute__((ext_vector_type(8)));
typedef float f32x4 __attribute__((ext_vector_type(4)));
typedef float f32x16 __attribute__((ext_vector_type(16)));
typedef unsigned u32x4 __attribute__((ext_vector_type(4)));

constexpr int DM = 1024, TP = 16384, TSM = 1024, TT = TP + TSM;
constexpr int NIN = 2376, NINP = 2560, DFF = 2816, NGU = 5632;
constexpr int NTHR = 512, NQ = 8;
constexpr int SP = 4096, SS = 4160;
constexpr int LDS_BYTES = NQ * SS * 4 + NQ * 256 * 2;
constexpr float ALPHA = 1.4142135623730951f;
constexpr float LN_EPS = 1e-5f;

constexpr size_t O_YP = 0, O_YS = 16777216, O_KP = 17825792, O_VP = 22020096, O_KIP = 26214400, O_CP = 28311552,
                 O_KS = 28434432, O_VS = 28696576, O_KIS = 28958720, O_CS = 29089792;

struct Params {
    const float *x_prompt, *x_sample, *cache_k, *cache_v, *cache_ki, *state_conv;
    const float *w_in, *conv_w, *conv_b, *cln_g, *cln_b, *w_o, *ln1_g, *ln1_b, *w_gu, *w_dn, *ln2_g, *ln2_b;
    float* out;
    bf16_t *win_t, *wo_t, *wgu_t, *wdn_t;
    float2* trig;
    bf16_t *kp, *vp, *kip, *ks, *vs, *kis;
    bf16_t* ab;
    float* F;
    bf16_t *act, *u, *q, *qi;
    float* wi;
    unsigned* bar;
    float* part;
};

typedef const __attribute__((address_space(4))) Params KP;
__device__ __forceinline__ KP& kparams() { KP* k = (KP*)__builtin_amdgcn_kernarg_segment_ptr(); asm volatile("" : "+s"(k)); return *k; }
__device__ __forceinline__ unsigned pk_bf16(float lo, float hi) { unsigned r; asm volatile("v_cvt_pk_bf16_f32 %0, %1, %2" : "=v"(r) : "v"(lo), "v"(hi)); return r; }
__device__ __forceinline__ float bf_lo(unsigned v) { return __uint_as_float(v << 16); }
__device__ __forceinline__ float bf_hi(unsigned v) { return __uint_as_float(v & 0xffff0000u); }
__device__ __forceinline__ int opaque_tid() { int t = threadIdx.x; asm volatile("" : "+v"(t)); return t; }
__device__ __forceinline__ unsigned tokey(float f) { unsigned u = __float_as_uint(f); return (u & 0x80000000u) ? ~u : (u | 0x80000000u); }
__device__ __forceinline__ float sigmoidf_(float x) { return 1.0f / (1.0f + __expf(-x)); }

__device__ __forceinline__ int perm_in(int n) {
    const int tile = n >> 8, bj = (n >> 7) & 1, wc = (n >> 5) & 3, i = n & 31;
    if (tile < 4) { const int ch = 128 * tile + 32 * wc + i; return bj ? 512 + ch : ch; }
    if (tile < 6) return 1024 + ((tile - 4) * 4 + wc) * 64 + i + 32 * bj;
    if (tile == 6) return (wc < 2) ? 1536 + wc * 64 + i + 32 * bj : 1664 + 64 * bj + 32 * (wc - 2) + i;
    if (tile < 9) return 1792 + ((tile - 7) * 4 + wc) * 64 + i + 32 * bj;
    if (wc == 0) return 2304 + i + 32 * bj;
    if (wc == 1 && bj == 0 && i < 8) return 2368 + i;
    return -1;
}
__device__ __forceinline__ int perm_gu(int n) { const int tile = n >> 8, bj = (n >> 7) & 1, w = n & 127; const int ch = 128 * tile + w; return bj ? DFF + ch : ch; }

template <int MODE>
__device__ __forceinline__ void transpose_tiles(const float* __restrict__ W, bf16_t* __restrict__ Wt, int K, int N, int Np, float* lds0, int& cursor) {
    const int tk = K >> 6, tn = Np >> 6, nt = tk * tn, tid5 = opaque_tid(), vb = tid5 >> 8, tid = tid5 & 255;
    float* lds = lds0 + vb * (64 * 65);
    const int VG = 2 * (int)gridDim.x;
    int f0 = 2 * (int)blockIdx.x - cursor; if (f0 < 0) f0 += VG;
    int f1 = 2 * (int)blockIdx.x + 1 - cursor; if (f1 < 0) f1 += VG;
    cursor = (cursor + nt) % VG;
    const int fmin = f0 < f1 ? f0 : f1, first = vb ? f1 : f0;
    for (int it = 0; fmin + it * VG < nt; ++it) {
        const int t = first + it * VG;
        const bool on = t < nt;
        const int k0 = on ? (t / tn) << 6 : 0, n0 = on ? (t % tn) << 6 : 0;
        __syncthreads();
        if (on) {
#pragma unroll
            for (int i = 0; i < 16; ++i) {
                const int k = i * 4 + (tid >> 6), n = tid & 63;
                int c = n0 + n; if (MODE == 1) c = perm_in(c); else if (MODE == 2) c = perm_gu(c);
                lds[k * 65 + n] = (c >= 0) ? W[(size_t)(k0 + k) * N + c] : 0.f;
            }
        }
        __syncthreads();
        if (on) {
#pragma unroll
            for (int i = 0; i < 8; ++i) {
                const int n = i * 8 + (tid >> 5), k = (tid & 31) * 2;
                *(unsigned*)(Wt + (size_t)(n0 + n) * K + k0 + k) = pk_bf16(lds[k * 65 + n], lds[(k + 1) * 65 + n]);
            }
        }
    }
}

__device__ __forceinline__ void convert_chunks(const float* __restrict__ src, bf16_t* __restrict__ dst, int nb, int chunk8  , int dst_stride8  ) {
    const int total = nb * chunk8;
    for (int i = blockIdx.x * NTHR + opaque_tid(); i < total; i += gridDim.x * NTHR) {
        const int b = i / chunk8, r = i - b * chunk8;
        const float4 a = *(const float4*)(src + (size_t)i * 8), c = *(const float4*)(src + (size_t)i * 8 + 4);
        uint4 o; o.x = pk_bf16(a.x, a.y); o.y = pk_bf16(a.z, a.w); o.z = pk_bf16(c.x, c.y); o.w = pk_bf16(c.z, c.w);
        *(uint4*)(dst + ((size_t)b * dst_stride8 + r) * 8) = o;
    }
}
__device__ __forceinline__ void convert_cache(KP& p, int l) {
    convert_chunks(p.cache_k + (size_t)l * 16 * 4096 * 128, p.ks, 16, 4096 * 16, SS * 16);
    convert_chunks(p.cache_v + (size_t)l * 16 * 4096 * 128, p.vs, 16, 4096 * 16, SS * 16);
    convert_chunks(p.cache_ki + (size_t)l * 16 * 4096 * 64, p.kis, 16, 4096 * 8, SS * 8);
}

__device__ __forceinline__ void phase0(KP& p, unsigned char* lds) {
    int cursor = 0;
    for (int l = 0; l < 2; ++l) {
        transpose_tiles<1>(p.w_in + (size_t)l * DM * NIN, p.win_t + (size_t)l * NINP * DM, DM, NIN, NINP, (float*)lds, cursor);
        transpose_tiles<0>(p.w_o + (size_t)l * DM * DM, p.wo_t + (size_t)l * DM * DM, DM, DM, DM, (float*)lds, cursor);
        transpose_tiles<2>(p.w_gu + (size_t)l * DM * NGU, p.wgu_t + (size_t)l * NGU * DM, DM, NGU, NGU, (float*)lds, cursor);
        transpose_tiles<0>(p.w_dn + (size_t)l * DFF * DM, p.wdn_t + (size_t)l * DM * DFF, DFF, DM, DM, (float*)lds, cursor);
    }
    __syncthreads();
    convert_chunks(p.x_prompt, p.ab, 1, TP * 128, TP * 128);
    convert_chunks(p.x_sample, p.ab + (size_t)TP * DM, 1, TSM * 128, TSM * 128);
    convert_cache(p, 0);
    for (int i = blockIdx.x * NTHR + opaque_tid(); i < SS * 32; i += gridDim.x * NTHR) {
        const int pos = i >> 5, f = i & 31;
        const float inv = exp2f(-(float)f * (13.287712379549449f / 32.0f));
        const float angf = (float)pos * inv;
        const double rev = (double)angf * 0.15915494309189535;
        const double fr = rev - __builtin_rint(rev);
        const float ang = (float)(fr * 6.283185307179586);
        p.trig[i] = make_float2(__cosf(ang), __sinf(ang));
    }
}

namespace pg8 {
#define PG8_LAS __attribute__((address_space(3)))
typedef unsigned short bf16_t;
typedef short bf16x8 __attribute__((ext_vector_type(8)));
typedef float f32x4 __attribute__((ext_vector_type(4)));
typedef unsigned u32x4 __attribute__((ext_vector_type(4)));
constexpr int BM = 256, BK = 64, HALF = 128, HTB = HALF * BK * 2  , STAGE_BYTES = 8 * HTB, NXCD = 8, WGM = 8;

__host__ __device__ __forceinline__ int lds_byte(int r, int c) { const int st = (r >> 4) * 2 + (c >> 5), rr = r & 15, cc = c & 31, ob = rr * 64 + cc * 2; return st * 1024 + (ob ^ (((ob >> 9) & 1) << 5)); }
__host__ __device__ __forceinline__ void stage_rc(int b, int& R, int& C) { const int st = b / 1024, sb = b % 1024, swz = sb ^ (((sb >> 9) & 1) << 5); R = (st >> 1) * 16 + swz / 64; C = (st & 1) * 32 + (swz % 64) / 2; }
__host__ __device__ __forceinline__ int perm32(int rho) { const int n = rho >> 4, i = rho & 15; return 8 * (i >> 2) + 4 * n + (i & 3); }

struct Unit { int pm, pn; };
struct Gemm { const bf16_t* A; const bf16_t* Bt; int M, N, K, Kl; };

struct StaticOrder {
    int nM, nN, nwg, G, c;
    __host__ __device__ void init(int M, int N, int G_, int c_) { nM = M / BM; nN = N / BM; nwg = nM * nN; G = G_; c = c_; }
    __host__ __device__ bool next(int i, Unit& u) const {
        const long L = (long)i * G + c; if (L >= nwg) return false;
        int wgid = (int)L; { const int q = nwg / NXCD, r = nwg % NXCD, xcd = wgid % NXCD, off = wgid / NXCD; wgid = (xcd < r ? xcd * (q + 1) : r * (q + 1) + (xcd - r) * q) + off; }
        const int nig = WGM * nN, gid = wgid / nig, fm = gid * WGM, gsz = (nM - fm) < WGM ? (nM - fm) : WGM;
        u.pm = fm + ((wgid % nig) % gsz); u.pn = (wgid % nig) / gsz; return true;
    }
    __device__ __forceinline__ void a_ready(const Unit&) const {}
    __device__ __forceinline__ void done(const Unit&) const {}
};

__device__ __forceinline__ unsigned cvt_pk_bf16(float lo, float hi) { unsigned r; asm volatile("v_cvt_pk_bf16_f32 %0, %1, %2" : "=v"(r) : "v"(lo), "v"(hi)); return r; }
template <class Epi, class Sched, bool ALIGN_EPI = false, bool SP2 = false>
__device__ __forceinline__ void gemm_phase(PG8_LAS unsigned char* lds, const Gemm g, const Sched& S, const Epi& E) {
    const int tid = opaque_tid(), wid = __builtin_amdgcn_readfirstlane(tid >> 6), lane = tid & 63, wr = wid >> 2, wc = wid & 3, fr = lane & 15, fq = lane >> 4;
    const int K = g.K, nt = g.Kl / BK;
    unsigned voffA[2], voffB[2];
#pragma unroll
    for (int i = 0; i < 2; ++i) { int R, C; stage_rc(tid * 16 + i * 8192, R, C); const int Rb = Epi::PERM ? ((R & ~31) + perm32(R & 31)) : R;
        voffA[i] = (unsigned)(R * K + C) * 2u; voffB[i] = (unsigned)(Rb * K + C) * 2u; }
    const size_t kstep = (size_t)(BK * 2);
    const size_t hstep = (size_t)HALF * K * 2;
    const size_t tstep = 2 * hstep;
    const unsigned ldsw = (unsigned)wid * 1024u;
    const int aoff = lds_byte(wr * 64 + fr, fq * 8), boff = lds_byte(wc * 32 + fr, fq * 8);
#define PG8_SA(b, h) (((b) * 2 + (h)) * HTB)
#define PG8_SB(b, h) ((4 + (b) * 2 + (h)) * HTB)
#define PG8_STAGE(bufoff, gbase, voff) do { _Pragma("unroll") for (int _i = 0; _i < 2; ++_i) \
        __builtin_amdgcn_global_load_lds((const unsigned*)((const char*)(gbase) + (voff)[_i]), (PG8_LAS unsigned*)(lds + (bufoff) + ldsw + _i * 8192), 16, 0, 0); } while (0)
#define PG8_LDA(dst, b, h) do { _Pragma("unroll") for (int m = 0; m < 4; ++m) _Pragma("unroll") for (int k = 0; k < 2; ++k) dst[m][k] = *(const PG8_LAS bf16x8*)(lds + PG8_SA(b, h) + aoff + m * 2048 + k * 1024); } while (0)
#define PG8_LDB(dst, b, h) do { _Pragma("unroll") for (int n = 0; n < 2; ++n) _Pragma("unroll") for (int k = 0; k < 2; ++k) dst[n][k] = *(const PG8_LAS bf16x8*)(lds + PG8_SB(b, h) + boff + n * 2048 + k * 1024); } while (0)
#define PG8_MMA(ai, bj, At, Bt) do { __builtin_amdgcn_s_setprio(1); _Pragma("unroll") for (int m = 0; m < 4; ++m) _Pragma("unroll") for (int n = 0; n < 2; ++n) _Pragma("unroll") for (int k = 0; k < 2; ++k) \
        acc[ai][bj][m][n] = __builtin_amdgcn_mfma_f32_16x16x32_bf16(Bt[n][k], At[m][k], acc[ai][bj][m][n], 0, 0, 0); __builtin_amdgcn_s_setprio(0); } while (0)
#define PG8_WAIT_V(n) asm volatile("s_waitcnt vmcnt(" #n ")" ::: "memory")
#define PG8_WAIT_L(n) asm volatile("s_waitcnt lgkmcnt(" #n ")" ::: "memory")
#define PG8_BAR __builtin_amdgcn_s_barrier()
#define PG8_SCHED __builtin_amdgcn_sched_barrier(0)
    Unit cur, nxt; int ui = 0;
    if (!S.next(0, cur)) return;
    f32x4 acc[2][2][4][2];
#pragma unroll
    for (int a = 0; a < 2; ++a)
#pragma unroll
        for (int b = 0; b < 2; ++b)
#pragma unroll
            for (int m = 0; m < 4; ++m)
#pragma unroll
                for (int n = 0; n < 2; ++n) acc[a][b][m][n] = (f32x4){0.f, 0.f, 0.f, 0.f};
    bf16x8 At[4][2], B0[2][2], B1[2][2];
    const char* cA = (const char*)g.A + (size_t)cur.pm * tstep; const char* cB = (const char*)g.Bt + (size_t)cur.pn * tstep;
    S.a_ready(cur);
    if constexpr (SP2) {
        PG8_STAGE(PG8_SB(0, 0), cB, voffB); PG8_STAGE(PG8_SB(0, 1), cB + hstep, voffB); PG8_STAGE(PG8_SA(0, 0), cA, voffA); PG8_STAGE(PG8_SA(0, 1), cA + hstep, voffA);
        if (wr == 1) PG8_BAR;
        PG8_WAIT_V(2); PG8_BAR;
        PG8_STAGE(PG8_SB(1, 0), cB + kstep, voffB); PG8_STAGE(PG8_SA(1, 0), cA + kstep, voffA); PG8_STAGE(PG8_SB(1, 1), cB + hstep + kstep, voffB);
        PG8_WAIT_V(6); PG8_BAR;
    } else {
        PG8_STAGE(PG8_SB(0, 0), cB, voffB); PG8_STAGE(PG8_SA(0, 0), cA, voffA); PG8_STAGE(PG8_SB(0, 1), cB + hstep, voffB); PG8_STAGE(PG8_SA(0, 1), cA + hstep, voffA);
        if (wr == 1) PG8_BAR;
        PG8_WAIT_V(4); PG8_BAR;
        PG8_STAGE(PG8_SB(1, 0), cB + kstep, voffB); PG8_STAGE(PG8_SA(1, 0), cA + kstep, voffA); PG8_STAGE(PG8_SB(1, 1), cB + hstep + kstep, voffB);
        PG8_WAIT_V(6); PG8_BAR;
    }
    for (;;) {
        const bool has_next = S.next(ui + 1, nxt);
        const char* nA = has_next ? (const char*)g.A + (size_t)nxt.pm * tstep : cA; const char* nB = has_next ? (const char*)g.Bt + (size_t)nxt.pn * tstep : cB;
        for (int t = 0; t < nt; t += 2) {
            const bool last = (t == nt - 2);
            const char* a1 = cA + (size_t)(t + 1) * kstep;
            const char* a2 = last ? nA : cA + (size_t)(t + 2) * kstep; const char* b2 = last ? nB : cB + (size_t)(t + 2) * kstep;
            const char* a3 = a2 + kstep; const char* b3 = b2 + kstep;
            if (last && has_next) S.a_ready(nxt);
            if constexpr (SP2) {
            PG8_LDB(B0, 0, 0); PG8_LDB(B1, 0, 1); PG8_SCHED; PG8_LDA(At, 0, 0); PG8_STAGE(PG8_SA(1, 1), a1 + hstep, voffA);
            PG8_WAIT_V(8); PG8_WAIT_L(0); PG8_BAR; PG8_MMA(0, 0, At, B0); PG8_MMA(0, 1, At, B1); PG8_BAR; PG8_SCHED;
            PG8_LDA(At, 0, 1); PG8_STAGE(PG8_SB(0, 0), b2, voffB); PG8_STAGE(PG8_SB(0, 1), b2 + hstep, voffB); PG8_STAGE(PG8_SA(0, 0), a2, voffA);
            PG8_WAIT_V(8); PG8_WAIT_L(0); PG8_BAR; PG8_MMA(1, 0, At, B0); PG8_MMA(1, 1, At, B1); PG8_BAR; PG8_SCHED;
            PG8_LDB(B0, 1, 0); PG8_LDB(B1, 1, 1); PG8_SCHED; PG8_LDA(At, 1, 0); PG8_STAGE(PG8_SA(0, 1), a2 + hstep, voffA);
            PG8_WAIT_V(8); PG8_WAIT_L(0); PG8_BAR; PG8_MMA(0, 0, At, B0); PG8_MMA(0, 1, At, B1); PG8_BAR; PG8_SCHED;
            PG8_LDA(At, 1, 1); PG8_STAGE(PG8_SB(1, 0), b3, voffB); PG8_STAGE(PG8_SB(1, 1), b3 + hstep, voffB); PG8_STAGE(PG8_SA(1, 0), a3, voffA);
            PG8_WAIT_V(8); PG8_WAIT_L(0); PG8_BAR; PG8_MMA(1, 0, At, B0); PG8_MMA(1, 1, At, B1); PG8_BAR; PG8_SCHED;
            } else {
            PG8_LDB(B0, 0, 0); PG8_SCHED; PG8_LDA(At, 0, 0); PG8_STAGE(PG8_SA(1, 1), a1 + hstep, voffA);
            PG8_WAIT_L(8); PG8_BAR; PG8_WAIT_L(0); PG8_MMA(0, 0, At, B0); PG8_BAR; PG8_SCHED;
            PG8_LDB(B1, 0, 1); PG8_STAGE(PG8_SB(0, 0), b2, voffB);
            PG8_BAR; PG8_WAIT_L(0); PG8_MMA(0, 1, At, B1); PG8_BAR;
            PG8_LDA(At, 0, 1); PG8_STAGE(PG8_SA(0, 0), a2, voffA);
            PG8_BAR; PG8_WAIT_L(0); PG8_MMA(1, 0, At, B0); PG8_BAR; PG8_SCHED;
            PG8_STAGE(PG8_SB(0, 1), b2 + hstep, voffB);
            PG8_WAIT_V(6); PG8_BAR; PG8_MMA(1, 1, At, B1); PG8_BAR;
            PG8_LDB(B0, 1, 0); PG8_SCHED; PG8_LDA(At, 1, 0); PG8_STAGE(PG8_SA(0, 1), a2 + hstep, voffA);
            PG8_WAIT_L(8); PG8_BAR; PG8_WAIT_L(0); PG8_MMA(0, 0, At, B0); PG8_BAR; PG8_SCHED;
            PG8_LDB(B1, 1, 1); PG8_STAGE(PG8_SB(1, 0), b3, voffB);
            PG8_BAR; PG8_WAIT_L(0); PG8_MMA(0, 1, At, B1); PG8_BAR;
            PG8_LDA(At, 1, 1); PG8_STAGE(PG8_SA(1, 0), a3, voffA);
            PG8_BAR; PG8_WAIT_L(0); PG8_MMA(1, 0, At, B0); PG8_BAR; PG8_SCHED;
            PG8_STAGE(PG8_SB(1, 1), b3 + hstep, voffB);
            PG8_WAIT_V(6); PG8_BAR; PG8_MMA(1, 1, At, B1); PG8_BAR;
            }
        }
        if constexpr (ALIGN_EPI) { if (wr == 0) PG8_BAR; }
        if constexpr (!Epi::AFTER_DRAIN) { E(acc, cur, wr, wc, fr, fq); S.done(cur); }
        if (!has_next) break;
#pragma unroll
        for (int a = 0; a < 2; ++a)
#pragma unroll
            for (int b = 0; b < 2; ++b)
#pragma unroll
                for (int m = 0; m < 4; ++m)
#pragma unroll
                    for (int n = 0; n < 2; ++n) acc[a][b][m][n] = (f32x4){0.f, 0.f, 0.f, 0.f};
        cur = nxt; cA = nA; cB = nB; ++ui;
        if constexpr (ALIGN_EPI) { if (wr == 1) PG8_BAR; }
    }
    PG8_WAIT_V(0);
    if constexpr (!ALIGN_EPI) { if (wr == 0) PG8_BAR; }
    PG8_BAR;
    if constexpr (Epi::AFTER_DRAIN) { E.fused(acc, cur, wr, wc, fr, fq, lds, wid, lane); S.done(cur); }
#undef PG8_SA
#undef PG8_SB
#undef PG8_STAGE
#undef PG8_LDA
#undef PG8_LDB
#undef PG8_MMA
#undef PG8_WAIT_V
#undef PG8_WAIT_L
#undef PG8_BAR
#undef PG8_SCHED
}
}

#ifndef PG8_SP2
#define PG8_SP2 true
#endif
#ifndef PG8_ALIGN
#define PG8_ALIGN true
#endif

__device__ __forceinline__ void tok_decode(int row, bool& isS, int& b, int& t, int& pos) {
    isS = row >= TP;
    if (!isS) { b = row >> 12; t = row & 4095; pos = t; } else { const int r = row - TP; b = r >> 6; t = r & 63; pos = 4096 + t; }
}
typedef pg8::f32x4 (AccT)[2][2][4][2];

struct EpiIn {
    static constexpr bool PERM = false, AFTER_DRAIN = false;
    int l;
    __device__ __forceinline__ void operator()(const AccT& acc, const pg8::Unit& u, int wr, int wc, int fr, int fq) const {
        KP& p = kparams();
        const int tile = u.pn;
#pragma unroll
        for (int ai = 0; ai < 2; ++ai)
#pragma unroll
        for (int m = 0; m < 4; ++m) {
            const int row = u.pm * 256 + ai * 128 + wr * 64 + m * 16 + fr;
            bool isS; int b, t, pos; tok_decode(row, isS, b, t, pos);
            if (tile < 4) {
                const int tl = isS ? t - 34 : t - 4066;
#pragma unroll
                for (int n = 0; n < 2; ++n) {
                    const int ch = 128 * tile + 32 * wc + n * 16 + fq * 4;
                    float uu[4];
#pragma unroll
                    for (int j = 0; j < 4; ++j) uu[j] = acc[ai][0][m][n][j] * sigmoidf_(acc[ai][1][m][n][j]);
                    uint2 w; w.x = pk_bf16(uu[0], uu[1]); w.y = pk_bf16(uu[2], uu[3]);
                    *(uint2*)(p.u + (size_t)row * 512 + ch) = w;
                    if (tl >= 0) {
                        float* o = p.out + (isS ? O_CS + ((size_t)(l * 16 + b) * 30 + tl) * 512 : O_CP + ((size_t)(l * 4 + b) * 30 + tl) * 512) + ch;
                        *(float4*)o = make_float4(uu[0], uu[1], uu[2], uu[3]);
                    }
                }
            } else if (tile == 6 && wc >= 2) {
#pragma unroll
                for (int bj = 0; bj < 2; ++bj) {
                    float* o = p.out + (isS ? O_VS + (((size_t)(l * 16 + b) * 64 + t) * 2 + bj) * 64 : O_VP + (((size_t)(l * 4 + b) * 4096 + t) * 2 + bj) * 64);
                    bf16_t* vb = (isS ? p.vs + ((size_t)b * SS + 4096 + t) * 128 : p.vp + ((size_t)b * SP + t) * 128) + bj * 64;
#pragma unroll
                    for (int n = 0; n < 2; ++n) {
                        const int d = 32 * (wc - 2) + n * 16 + fq * 4;
                        const pg8::f32x4 a = acc[ai][bj][m][n];
                        *(float4*)(o + d) = make_float4(a[0], a[1], a[2], a[3]);
                        uint2 w; w.x = pk_bf16(a[0], a[1]); w.y = pk_bf16(a[2], a[3]);
                        *(uint2*)(vb + d) = w;
                    }
                }
            } else if (tile == 9 && wc >= 1) {
                if (wc == 1 && fq < 2) {
                    const float s = 0.35355339059327373f * 0.125f;
                    const pg8::f32x4 a = acc[ai][0][m][0];
                    *(float4*)(p.wi + (size_t)row * 8 + fq * 4) = make_float4(a[0] * s, a[1] * s, a[2] * s, a[3] * s);
                }
            } else {
                float o1[2][4], o2[2][4];
#pragma unroll
                for (int n = 0; n < 2; ++n) {
                    const float4* tp = (const float4*)(p.trig + (size_t)pos * 32 + n * 16 + fq * 4);
                    const float4 t0 = tp[0], t1 = tp[1];
                    const float cs[4] = {t0.x, t0.z, t1.x, t1.z}, sn[4] = {t0.y, t0.w, t1.y, t1.w};
#pragma unroll
                    for (int j = 0; j < 4; ++j) {
                        const float x1 = acc[ai][0][m][n][j], x2 = acc[ai][1][m][n][j];
                        o1[n][j] = x1 * cs[j] - x2 * sn[j];
                        o2[n][j] = x2 * cs[j] + x1 * sn[j];
                    }
                }
                if (tile == 4 || tile == 5 || tile == 7 || tile == 8) {
                    const bool isq = tile < 6;
                    const float s = isq ? 0.125f * 1.4426950408889634f : 1.0f;
                    bf16_t* dst = (isq ? p.q + (size_t)row * 512 + ((tile - 4) * 4 + wc) * 64 : p.qi + (size_t)row * 512 + ((tile - 7) * 4 + wc) * 64);
#pragma unroll
                    for (int n = 0; n < 2; ++n) {
                        const int d = n * 16 + fq * 4;
                        uint2 w; w.x = pk_bf16(o1[n][0] * s, o1[n][1] * s); w.y = pk_bf16(o1[n][2] * s, o1[n][3] * s);
                        *(uint2*)(dst + d) = w;
                        w.x = pk_bf16(o2[n][0] * s, o2[n][1] * s); w.y = pk_bf16(o2[n][2] * s, o2[n][3] * s);
                        *(uint2*)(dst + d + 32) = w;
                    }
                } else if (tile == 6) {
                    const int kvh = wc;
                    float* o = p.out + (isS ? O_KS + (((size_t)(l * 16 + b) * 64 + t) * 2 + kvh) * 64 : O_KP + (((size_t)(l * 4 + b) * 4096 + t) * 2 + kvh) * 64);
                    bf16_t* kb = (isS ? p.ks + ((size_t)b * SS + 4096 + t) * 128 : p.kp + ((size_t)b * SP + t) * 128) + kvh * 64;
#pragma unroll
                    for (int n = 0; n < 2; ++n) {
                        const int d = n * 16 + fq * 4;
                        *(float4*)(o + d) = make_float4(o1[n][0], o1[n][1], o1[n][2], o1[n][3]);
                        *(float4*)(o + d + 32) = make_float4(o2[n][0], o2[n][1], o2[n][2], o2[n][3]);
                        uint2 w; w.x = pk_bf16(o1[n][0], o1[n][1]); w.y = pk_bf16(o1[n][2], o1[n][3]);
                        *(uint2*)(kb + d) = w;
                        w.x = pk_bf16(o2[n][0], o2[n][1]); w.y = pk_bf16(o2[n][2], o2[n][3]);
                        *(uint2*)(kb + d + 32) = w;
                    }
                } else {
                    float* o = p.out + (isS ? O_KIS + ((size_t)(l * 16 + b) * 64 + t) * 64 : O_KIP + ((size_t)(l * 4 + b) * 4096 + t) * 64);
                    bf16_t* kb = (isS ? p.kis + ((size_t)b * SS + 4096 + t) * 64 : p.kip + ((size_t)b * SP + t) * 64);
#pragma unroll
                    for (int n = 0; n < 2; ++n) {
                        const int d = n * 16 + fq * 4;
                        *(float4*)(o + d) = make_float4(o1[n][0], o1[n][1], o1[n][2], o1[n][3]);
                        *(float4*)(o + d + 32) = make_float4(o2[n][0], o2[n][1], o2[n][2], o2[n][3]);
                        uint2 w; w.x = pk_bf16(o1[n][0], o1[n][1]); w.y = pk_bf16(o1[n][2], o1[n][3]);
                        *(uint2*)(kb + d) = w;
                        w.x = pk_bf16(o2[n][0], o2[n][1]); w.y = pk_bf16(o2[n][2], o2[n][3]);
                        *(uint2*)(kb + d + 32) = w;
                    }
                }
            }
        }
    }
};

struct EpiWo {
    static constexpr bool PERM = false, AFTER_DRAIN = false;
    int l;
    __device__ __forceinline__ void operator()(const AccT& acc, const pg8::Unit& u, int wr, int wc, int fr, int fq) const {
        KP& p = kparams();
#pragma unroll
        for (int ai = 0; ai < 2; ++ai)
#pragma unroll
        for (int m = 0; m < 4; ++m) {
            const int row = u.pm * 256 + ai * 128 + wr * 64 + m * 16 + fr;
            const float* xr = (l == 0) ? ((row < TP) ? p.x_prompt + (size_t)row * DM : p.x_sample + (size_t)(row - TP) * DM) : p.F + (size_t)row * DM;
            float* fo = p.F + (size_t)row * DM;
#pragma unroll
            for (int bj = 0; bj < 2; ++bj)
#pragma unroll
            for (int n = 0; n < 2; ++n) {
                const int c = u.pn * 256 + bj * 128 + wc * 32 + n * 16 + fq * 4;
                const float4 x = *(const float4*)(xr + c);
                const pg8::f32x4 a = acc[ai][bj][m][n];
                *(float4*)(fo + c) = make_float4(ALPHA * x.x + a[0], ALPHA * x.y + a[1], ALPHA * x.z + a[2], ALPHA * x.w + a[3]);
            }
        }
    }
};
struct EpiGu {
    static constexpr bool PERM = false, AFTER_DRAIN = false;
    int pad_;
    __device__ __forceinline__ void operator()(const AccT& acc, const pg8::Unit& u, int wr, int wc, int fr, int fq) const {
        KP& p = kparams();
#pragma unroll
        for (int ai = 0; ai < 2; ++ai)
#pragma unroll
        for (int m = 0; m < 4; ++m) {
            const int row = u.pm * 256 + ai * 128 + wr * 64 + m * 16 + fr;
#pragma unroll
            for (int n = 0; n < 2; ++n) {
                float a[4];
#pragma unroll
                for (int j = 0; j < 4; ++j) { const float g = acc[ai][0][m][n][j]; a[j] = g * sigmoidf_(g) * acc[ai][1][m][n][j]; }
                uint2 w; w.x = pk_bf16(a[0], a[1]); w.y = pk_bf16(a[2], a[3]);
                *(uint2*)(p.act + (size_t)row * DFF + 128 * u.pn + 32 * wc + n * 16 + fq * 4) = w;
            }
        }
    }
};
struct EpiDn {
    static constexpr bool PERM = false, AFTER_DRAIN = false;
    int pad_;
    __device__ __forceinline__ void operator()(const AccT& acc, const pg8::Unit& u, int wr, int wc, int fr, int fq) const {
        KP& p = kparams();
#pragma unroll
        for (int ai = 0; ai < 2; ++ai)
#pragma unroll
        for (int m = 0; m < 4; ++m) {
            float* fo = p.F + (size_t)(u.pm * 256 + ai * 128 + wr * 64 + m * 16 + fr) * DM;
#pragma unroll
            for (int bj = 0; bj < 2; ++bj)
#pragma unroll
            for (int n = 0; n < 2; ++n) {
                const int c = u.pn * 256 + bj * 128 + wc * 32 + n * 16 + fq * 4;
                const float4 x = *(const float4*)(fo + c);
                const pg8::f32x4 a = acc[ai][bj][m][n];
                *(float4*)(fo + c) = make_float4(ALPHA * x.x + a[0], ALPHA * x.y + a[1], ALPHA * x.z + a[2], ALPHA * x.w + a[3]);
            }
        }
    }
};
template <class Epi>
__device__ __forceinline__ void gemm_run(const bf16_t* A, const bf16_t* Bt, int M, int N, int K, unsigned char* lds, const Epi& e) {
    pg8::Gemm g; g.A = A; g.Bt = Bt; g.M = M; g.N = N; g.K = K; g.Kl = K;
    pg8::StaticOrder S; S.init(M, N, (int)gridDim.x, (int)blockIdx.x);
    pg8::gemm_phase<Epi, pg8::StaticOrder, true, true>((PG8_LAS unsigned char*)lds, g, S, e);
}
struct OneUnit {
    int has; pg8::Unit u;
    __device__ __forceinline__ bool next(int i, pg8::Unit& o) const { if (i != 0 || !has) return false; o = u; return true; }
    __device__ __forceinline__ void a_ready(const pg8::Unit&) const {}
    __device__ __forceinline__ void done(const pg8::Unit&) const {}
};
struct EpiPart {
    static constexpr bool PERM = false, AFTER_DRAIN = false;
    float* dst;
    __device__ __forceinline__ void operator()(const AccT& acc, const pg8::Unit& u, int wr, int wc, int fr, int fq) const {
#pragma unroll
        for (int ai = 0; ai < 2; ++ai)
#pragma unroll
        for (int m = 0; m < 4; ++m) {
            float* fo = dst + (size_t)(u.pm * 256 + ai * 128 + wr * 64 + m * 16 + fr) * DM;
#pragma unroll
            for (int bj = 0; bj < 2; ++bj)
#pragma unroll
            for (int n = 0; n < 2; ++n) {
                const pg8::f32x4 a = acc[ai][bj][m][n];
                *(float4*)(fo + u.pn * 256 + bj * 128 + wc * 32 + n * 16 + fq * 4) = make_float4(a[0], a[1], a[2], a[3]);
            }
        }
    }
};
__device__ __forceinline__ void gemm_tail(KP& p, const bf16_t* A, const bf16_t* Bt, int K, int nsplit, unsigned char* lds) {
    const int c = blockIdx.x, nitems = 16 * nsplit;
    const int item = c < nitems ? c : 0, tile = item / nsplit, sl = item - tile * nsplit;
    int k0, kl;
    if (K == DM) { k0 = 256 * sl; kl = 256; } else { k0 = 384 * sl; kl = (sl == nsplit - 1) ? 512 : 384; }
    pg8::Gemm g; g.A = A + (size_t)TP * K + k0; g.Bt = Bt + k0; g.M = TSM; g.N = DM; g.K = K; g.Kl = kl;
    OneUnit S; S.has = c < nitems; S.u.pm = tile >> 2; S.u.pn = tile & 3;
    EpiPart e; e.dst = p.part + (size_t)sl * TSM * DM;
    pg8::gemm_phase<EpiPart, OneUnit, false, true>((PG8_LAS unsigned char*)lds, g, S, e);
}

__device__ __forceinline__ void ln_phase(KP& p, int l, int which) {
    const int tid = opaque_tid(), lane = tid & 63, wid = tid >> 6;
    const float* g = (which == 1 ? p.ln1_g : p.ln2_g) + l * DM;
    const float* bb = (which == 1 ? p.ln1_b : p.ln2_b) + l * DM;
    const bool fin = (which == 2 && l == 1);
    for (int row = blockIdx.x * 8 + wid; row < TT; row += gridDim.x * 8) {
        float* fr = p.F + (size_t)row * DM;
        float4 v[4];
        float s = 0.f;
#pragma unroll
        for (int i = 0; i < 4; ++i) v[i] = *(const float4*)(fr + i * 256 + lane * 4);
        if (row >= TP) {
            const int nsp = (which == 1) ? 4 : 7;
            const float* pr = p.part + (size_t)(row - TP) * DM;
#pragma unroll
            for (int i = 0; i < 4; ++i) {
                float4 x = v[i];
                if (which == 1 && l == 0) x = *(const float4*)(p.x_sample + (size_t)(row - TP) * DM + i * 256 + lane * 4);
                float4 a = make_float4(ALPHA * x.x, ALPHA * x.y, ALPHA * x.z, ALPHA * x.w);
                for (int sp = 0; sp < nsp; ++sp) { const float4 q = *(const float4*)(pr + (size_t)sp * TSM * DM + i * 256 + lane * 4); a.x += q.x; a.y += q.y; a.z += q.z; a.w += q.w; }
                v[i] = a;
            }
        }
#pragma unroll
        for (int i = 0; i < 4; ++i) s += (v[i].x + v[i].y) + (v[i].z + v[i].w);
#pragma unroll
        for (int o = 32; o >= 1; o >>= 1) s += __shfl_xor(s, o);
        const float mean = s * (1.0f / 1024.0f);
        float q = 0.f;
#pragma unroll
        for (int i = 0; i < 4; ++i) { const float a = v[i].x - mean, b = v[i].y - mean, c = v[i].z - mean, d = v[i].w - mean; q += (a * a + b * b) + (c * c + d * d); }
#pragma unroll
        for (int o = 32; o >= 1; o >>= 1) q += __shfl_xor(q, o);
        const float rstd = rsqrtf(q * (1.0f / 1024.0f) + LN_EPS);
#pragma unroll
        for (int i = 0; i < 4; ++i) {
            const int c = i * 256 + lane * 4;
            const float4 gg = *(const float4*)(g + c), be = *(const float4*)(bb + c);
            const float4 o = make_float4((v[i].x - mean) * rstd * gg.x + be.x, (v[i].y - mean) * rstd * gg.y + be.y, (v[i].z - mean) * rstd * gg.z + be.z, (v[i].w - mean) * rstd * gg.w + be.w);
            if (fin) *(float4*)(p.out + (size_t)row * DM + c) = o;
            else {
                *(float4*)(fr + c) = o;
                uint2 w; w.x = pk_bf16(o.x, o.y); w.y = pk_bf16(o.z, o.w);
                *(uint2*)(p.ab + (size_t)row * DM + c) = w;
            }
        }
    }
}

__device__ __forceinline__ void conv_unit(KP& p, int l, int cu, unsigned char* lds) {
    const int tid5 = opaque_tid(), hb = tid5 >> 8, tid = tid5 & 255, lane = tid & 63, wid = tid >> 6;
    const int row0 = cu * 16;
    bool isS; int b, t0, pos; tok_decode(row0, isS, b, t0, pos);
    const int seq_row0 = row0 - t0, tb = t0 + 8 * hb;
    unsigned* xs = (unsigned*)(lds + hb * 40960);
    float* red = (float*)(lds + 81920 + hb * 512);
    const unsigned* ug = (const unsigned*)p.u;
    for (int rep = 0; rep < (DUP_PART == 5 ? 2 : 1); ++rep) {
    __syncthreads();
    {
        const int nneg = tb < 30 ? 30 - tb : 0;
#pragma unroll
        for (int i = 0; i < 38; ++i) {
            const int tok = tb - 30 + i;
            const int tokc = tok < 0 ? 0 : tok;
            unsigned v = ug[(size_t)(seq_row0 + tokc) * 256 + tid];
            if (i < 30 && i < nneg) {
                v = 0u;
                if (isS) { const float2 s = *(const float2*)(p.state_conv + ((size_t)(l * 16 + b) * 30 + (30 + tok)) * 512 + 2 * tid); v = pk_bf16(s.x, s.y); }
            }
            xs[i * 256 + tid] = v;
        }
    }
    float cw0[31], cw1[31];
#pragma unroll
    for (int w = 0; w < 31; ++w) { const float2 c = *(const float2*)(p.conv_w + ((size_t)l * 31 + w) * 512 + 2 * tid); cw0[w] = c.x; cw1[w] = c.y; }
    const float2 cb = *(const float2*)(p.conv_b + l * 512 + 2 * tid);
#pragma unroll 2
    for (int t = 0; t < 8; ++t) {
        float a0 = cb.x, a1 = cb.y;
        const unsigned* xr = xs + t * 256 + tid;
#pragma unroll
        for (int w = 0; w < 31; ++w) { const unsigned v = xr[w * 256]; a0 += bf_lo(v) * cw0[w]; a1 += bf_hi(v) * cw1[w]; }
        float s = a0 + a1, q = a0 * a0 + a1 * a1;
#pragma unroll
        for (int o = 32; o >= 1; o >>= 1) { s += __shfl_xor(s, o); q += __shfl_xor(q, o); }
        if (lane == 0) { red[(wid * 8 + t) * 2] = s; red[(wid * 8 + t) * 2 + 1] = q; }
        xs[t * 256 + tid] = pk_bf16(a0, a1);
    }
    __syncthreads();
    const float2 lg = *(const float2*)(p.cln_g + l * 512 + 2 * tid);
    const float2 lb = *(const float2*)(p.cln_b + l * 512 + 2 * tid);
#pragma unroll 4
    for (int t = 0; t < 8; ++t) {
        const float s = (red[t * 2] + red[(8 + t) * 2]) + (red[(16 + t) * 2] + red[(24 + t) * 2]);
        const float q = (red[t * 2 + 1] + red[(8 + t) * 2 + 1]) + (red[(16 + t) * 2 + 1] + red[(24 + t) * 2 + 1]);
        const float mean = s * (1.0f / 512.0f);
        const float var = fmaxf(q * (1.0f / 512.0f) - mean * mean, 0.f);
        const float rstd = rsqrtf(var + LN_EPS);
        const unsigned v = xs[t * 256 + tid];
        float a = (bf_lo(v) - mean) * rstd * lg.x + lb.x, c = (bf_hi(v) - mean) * rstd * lg.y + lb.y;
        a = a * sigmoidf_(a); c = c * sigmoidf_(c);
        *(unsigned*)(p.ab + (size_t)(row0 + 8 * hb + t) * DM + 2 * tid) = pk_bf16(a, c);
    }
    __syncthreads();
    }
}

__device__ __forceinline__ void attn_unit(KP& p, int isS, int b, int t0, unsigned char* lds) {
    const int tid = opaque_tid(), lane = tid & 63, wid = tid >> 6, r = lane & 31, hh = lane >> 5;
    unsigned* sc = (unsigned*)lds;
    unsigned short* idxl = (unsigned short*)(lds + NQ * SS * 4) + wid * 256;
    const int row0 = isS ? TP + b * 64 + t0 : b * 4096 + t0;
    const int S = isS ? SS : ((t0 >> 6) + 1) * 64;
    const bf16_t* KI = isS ? p.kis + (size_t)b * SS * 64 : p.kip + (size_t)b * SP * 64;
    const bf16_t* Kc = isS ? p.ks + (size_t)b * SS * 128 : p.kp + (size_t)b * SP * 128;
    const bf16_t* Vc = isS ? p.vs + (size_t)b * SS * 128 : p.vp + (size_t)b * SP * 128;
    __syncthreads();
    {
        bf16x8 qf[2][4];
#pragma unroll
        for (int gq = 0; gq < 2; ++gq)
#pragma unroll
            for (int ks = 0; ks < 4; ++ks) qf[gq][ks] = *(const bf16x8*)(p.qi + (size_t)(row0 + 4 * gq + (r >> 3)) * 512 + (r & 7) * 64 + ks * 16 + hh * 8);
        float w[8][4];
#pragma unroll
        for (int q = 0; q < 8; ++q) { const float4 t = *(const float4*)(p.wi + (size_t)(row0 + q) * 8 + 4 * hh); w[q][0] = t.x; w[q][1] = t.y; w[q][2] = t.z; w[q][3] = t.w; }
        const int ntile = S >> 5;
        auto ldk = [&](int kt, bf16x8 (&kf)[4]) {
            const bf16_t* kr = KI + (size_t)(kt * 32 + r) * 64 + hh * 8;
#pragma unroll
            for (int ks = 0; ks < 4; ++ks) kf[ks] = *(const bf16x8*)(kr + ks * 16);
        };
        auto comp = [&](int kt, const bf16x8 (&kf)[4]) {
#pragma unroll
            for (int gq = 0; gq < 2; ++gq) {
                f32x16 d;
#pragma unroll
                for (int i = 0; i < 16; ++i) d[i] = 0.f;
#pragma unroll
                for (int ks = 0; ks < 4; ++ks) d = __builtin_amdgcn_mfma_f32_32x32x16_bf16(qf[gq][ks], kf[ks], d, 0, 0, 0);
                float s[4];
#pragma unroll
                for (int q = 0; q < 4; ++q) {
                    const float* wq = w[4 * gq + q];
                    s[q] = (wq[0] * fmaxf(d[4 * q], 0.f) + wq[1] * fmaxf(d[4 * q + 1], 0.f)) + (wq[2] * fmaxf(d[4 * q + 2], 0.f) + wq[3] * fmaxf(d[4 * q + 3], 0.f));
                    s[q] += __shfl_xor(s[q], 32);
                    s[q] += 0.0f;
                }
                const float a0 = hh ? s[2] : s[0], a1 = hh ? s[3] : s[1];
                sc[(4 * gq + hh * 2) * SS + kt * 32 + r] = tokey(a0);
                sc[(4 * gq + hh * 2 + 1) * SS + kt * 32 + r] = tokey(a1);
            }
        };
        for (int rep = 0; rep < (DUP_PART == 1 ? 2 : 1); ++rep) {
        bf16x8 k0[4], k1[4], k2[4], k3[4];
        int kt = wid;
        if (kt < ntile) ldk(kt, k0);
        if (kt + 8 < ntile) ldk(kt + 8, k1);
        if (kt + 16 < ntile) ldk(kt + 16, k2);
        for (; kt < ntile; kt += 32) {
            if (kt + 24 < ntile) ldk(kt + 24, k3);
            comp(kt, k0);
            if (kt + 32 < ntile) ldk(kt + 32, k0);
            if (kt + 8 < ntile) comp(kt + 8, k1);
            if (kt + 40 < ntile) ldk(kt + 40, k1);
            if (kt + 16 < ntile) comp(kt + 16, k2);
            if (kt + 48 < ntile) ldk(kt + 48, k2);
            if (kt + 24 < ntile) comp(kt + 24, k3);
        }
        }
    }
    __syncthreads();
    const int Ksel = S < 256 ? S : 256;
    for (int rep = 0; rep < (DUP_PART == 2 ? 2 : 1); ++rep)
    if (S <= 256) {
        for (int i = lane; i < S; i += 64) idxl[i] = (unsigned short)i;
    } else {
        unsigned key[65];
        const unsigned* myr = sc + wid * SS;
        const int nslot = S >> 6;
#pragma unroll
        for (int s = 0; s < 65; ++s) key[s] = (s < nslot) ? myr[s * 64 + lane] : 0u;
        unsigned P = 0; bool exact = false;
        for (int bit = 31; bit >= 0; --bit) {
            const unsigned C = P | (1u << bit);
            int cnt = 0;
#pragma unroll
            for (int sg = 0; sg < 13; ++sg) {
                if (sg * 5 < nslot) {
#pragma unroll
                    for (int s = sg * 5; s < sg * 5 + 5; ++s) cnt += __builtin_popcountll(__ballot(key[s] >= C));
                }
            }
            if (cnt >= 256) { P = C; if (cnt == 256) { exact = true; break; } }
        }
        const unsigned Tg = exact ? P - 1u : P;
        const unsigned long long lt = (1ull << lane) - 1ull;
        int base = 0;
#pragma unroll
        for (int sg = 0; sg < 13; ++sg) {
            if (sg * 5 < nslot) {
#pragma unroll
                for (int s = sg * 5; s < sg * 5 + 5; ++s) {
                    const bool g = key[s] > Tg;
                    const unsigned long long m = __ballot(g);
                    if (g) idxl[base + __builtin_popcountll(m & lt)] = (unsigned short)(s * 64 + lane);
                    base += __builtin_popcountll(m);
                }
            }
        }
        const int need = 256 - base;
        if (need > 0) {
            int tb = 0;
#pragma unroll
            for (int s = 0; s < 65; ++s) {
                const bool e = (key[s] == Tg) && (s < nslot);
                const unsigned long long m = __ballot(e);
                const int rk = tb + __builtin_popcountll(m & lt);
                if (e && rk < need) idxl[base + rk] = (unsigned short)(s * 64 + lane);
                tb += __builtin_popcountll(m);
            }
        }
    }
    const int row = row0 + wid;
    float* Pl = (float*)(sc + wid * SS);
    for (int rep = 0; rep < (DUP_PART == 3 ? 2 : 1); ++rep) {
    {
        bf16x8 qa[8];
#pragma unroll
        for (int ks = 0; ks < 8; ++ks) {
            const int kk = ks * 16 + hh * 8, g = kk >> 6, d = kk & 63;
            const bool valid = (r < 8) && ((r >> 2) == g);
            bf16x8 z;
#pragma unroll
            for (int j = 0; j < 8; ++j) z[j] = 0;
            qa[ks] = valid ? *(const bf16x8*)(p.q + (size_t)row * 512 + r * 64 + d) : z;
        }
        auto ldq = [&](int tile, bf16x8 (&kf)[8]) {
            const int key = tile * 32 + r;
            const int id = (key < Ksel) ? (int)idxl[key] : 0;
            const bf16_t* kr = Kc + (size_t)id * 128 + hh * 8;
#pragma unroll
            for (int ks = 0; ks < 8; ++ks) kf[ks] = *(const bf16x8*)(kr + ks * 16);
        };
        auto cmq = [&](int tile, const bf16x8 (&kf)[8]) {
            const int key = tile * 32 + r;
            f32x16 d;
#pragma unroll
            for (int i = 0; i < 16; ++i) d[i] = 0.f;
#pragma unroll
            for (int ks = 0; ks < 8; ++ks) d = __builtin_amdgcn_mfma_f32_32x32x16_bf16(qa[ks], kf[ks], d, 0, 0, 0);
            const bool ok = key < Ksel;
            *(float4*)(Pl + key * 8 + 4 * hh) = make_float4(ok ? d[0] : -INFINITY, ok ? d[1] : -INFINITY, ok ? d[2] : -INFINITY, ok ? d[3] : -INFINITY);
        };
        bf16x8 k0[8], k1[8], k2[8], k3[8];
        ldq(0, k0); ldq(1, k1); ldq(2, k2);
        ldq(3, k3); cmq(0, k0);
        ldq(4, k0); cmq(1, k1);
        ldq(5, k1); cmq(2, k2);
        ldq(6, k2); cmq(3, k3);
        ldq(7, k3); cmq(4, k0);
        cmq(5, k1); cmq(6, k2); cmq(7, k3);
    }
    {
        float lg[8][4];
#pragma unroll
        for (int tile = 0; tile < 8; ++tile) { const float4 t = *(const float4*)(Pl + (tile * 32 + r) * 8 + 4 * hh); lg[tile][0] = t.x; lg[tile][1] = t.y; lg[tile][2] = t.z; lg[tile][3] = t.w; }
#pragma unroll
        for (int i = 0; i < 4; ++i) {
            float mx = lg[0][i];
#pragma unroll
            for (int tile = 1; tile < 8; ++tile) mx = fmaxf(mx, lg[tile][i]);
#pragma unroll
            for (int o = 16; o >= 1; o >>= 1) mx = fmaxf(mx, __shfl_xor(mx, o));
            float sm = 0.f;
#pragma unroll
            for (int tile = 0; tile < 8; ++tile) { lg[tile][i] = exp2f(lg[tile][i] - mx); sm += lg[tile][i]; }
#pragma unroll
            for (int o = 16; o >= 1; o >>= 1) sm += __shfl_xor(sm, o);
            const float inv = 1.0f / sm;
#pragma unroll
            for (int tile = 0; tile < 8; ++tile) lg[tile][i] *= inv;
        }
#pragma unroll
        for (int tile = 0; tile < 8; ++tile) *(float4*)(Pl + (tile * 32 + r) * 8 + 4 * hh) = make_float4(lg[tile][0], lg[tile][1], lg[tile][2], lg[tile][3]);
    }
    }
    {
        const int sub = lane & 15, kq = lane >> 4, g = sub >> 3;
        typedef float f32x2 __attribute__((ext_vector_type(2)));
        f32x2 acc[4][4];
#pragma unroll
        for (int h = 0; h < 4; ++h)
#pragma unroll
            for (int i = 0; i < 4; ++i) acc[h][i] = (f32x2){0.f, 0.f};
        for (int rep = 0; rep < (DUP_PART == 4 ? 2 : 1); ++rep) {
        auto ldv = [&](int k0, u32x4 (&v)[8]) {
#pragma unroll
            for (int j = 0; j < 8; ++j) { const int id = idxl[k0 + 4 * j + kq]; v[j] = *(const u32x4*)(Vc + (size_t)id * 128 + sub * 8); }
        };
        auto cmv = [&](int k0, const u32x4 (&v)[8]) {
#pragma unroll
            for (int j = 0; j < 8; ++j) {
                const float4 pp = *(const float4*)(Pl + (k0 + 4 * j + kq) * 8 + 4 * g);
                const float ph[4] = {pp.x, pp.y, pp.z, pp.w};
#pragma unroll
                for (int i = 0; i < 4; ++i) {
                    const f32x2 vv = (f32x2){bf_lo(v[j][i]), bf_hi(v[j][i])};
#pragma unroll
                    for (int h = 0; h < 4; ++h) acc[h][i] += vv * ph[h];
                }
            }
        };
        u32x4 v0[8], v1[8], v2[8], v3[8];
        ldv(0, v0);
        if (32 < Ksel) ldv(32, v1);
        if (64 < Ksel) ldv(64, v2);
#pragma unroll 1
        for (int k0 = 0; k0 < Ksel; k0 += 128) {
            if (k0 + 96 < Ksel) ldv(k0 + 96, v3);
            cmv(k0, v0);
            if (k0 + 128 < Ksel) ldv(k0 + 128, v0);
            if (k0 + 32 < Ksel) cmv(k0 + 32, v1);
            if (k0 + 160 < Ksel) ldv(k0 + 160, v1);
            if (k0 + 64 < Ksel) cmv(k0 + 64, v2);
            if (k0 + 192 < Ksel) ldv(k0 + 192, v2);
            if (k0 + 96 < Ksel) cmv(k0 + 96, v3);
        }
        }
#pragma unroll
        for (int h = 0; h < 4; ++h)
#pragma unroll
            for (int i = 0; i < 4; ++i) {
                float x = acc[h][i].x, y = acc[h][i].y;
                x += __shfl_xor(x, 16); y += __shfl_xor(y, 16);
                x += __shfl_xor(x, 32); y += __shfl_xor(y, 32);
                if (DUP_PART == 4) { x *= 0.5f; y *= 0.5f; }
                acc[h][i] = (f32x2){x, y};
            }
        if (kq == 0) {
#pragma unroll
            for (int h = 0; h < 4; ++h) {
                u32x4 w;
                w.x = pk_bf16(acc[h][0].x, acc[h][0].y); w.y = pk_bf16(acc[h][1].x, acc[h][1].y);
                w.z = pk_bf16(acc[h][2].x, acc[h][2].y); w.w = pk_bf16(acc[h][3].x, acc[h][3].y);
                *(u32x4*)(p.ab + (size_t)row * DM + 512 + (4 * g + h) * 64 + (sub & 7) * 8) = w;
            }
        }
    }
}

__device__ __forceinline__ void mixer_unit(KP& p, int l, int pair, int u, unsigned char* lds) {
    if (u < 544) {
        int isS, b, t0;
        if (u < 32) { isS = 1; b = 4 * pair + (u >> 3); t0 = (u & 7) * 8; }
        else { const int j = u - 32; isS = 0; b = pair; t0 = (63 - (j >> 3)) * 64 + (j & 7) * 8; }
        attn_unit(p, isS, b, t0, lds);
    } else { const int j = u - 544; conv_unit(p, l, (j < 256) ? pair * 256 + j : 1024 + pair * 16 + (j - 256), lds); }
}
__device__ __forceinline__ void mixer_phase(KP& p, int l, unsigned char* lds) {
    const int G = gridDim.x;
    const bool fast = (G == 256);
    const int x = blockIdx.x & 7, jb = blockIdx.x >> 3, rb = (x & 1) * 32 + jb;
    const int nrd = fast ? 13 : (4 * 816 + G - 1) / G;
    for (int rd = 0; rd < nrd; ++rd) {
        int pair, u; bool valid;
        if (fast) { u = rd * 64 + ((rd & 1) ? (63 - rb) : rb); pair = x >> 1; valid = u < 816; }
        else { const int i = rd * G + (int)blockIdx.x; valid = i < 4 * 816; pair = i / 816; u = i - pair * 816; }
        if (valid) mixer_unit(p, l, pair, u, lds);
    }
}

#define XB_TMO      128
#define XB_XCNT(j)  (256  + 64 * (j))
#define XB_XSUB(j)  (1280 + 64 * (j))
#define XB_XGEN(j)  (2304 + 64 * (j))
#define XB_TOP      3328
#define XB_TOPGEN   3392
#define XCD_BAR_WORDS 3456
#define XB_SPIN_CAP (1u << 20)
__device__ __forceinline__ unsigned xb_ld(unsigned* p)              { return __hip_atomic_load(p, __ATOMIC_RELAXED, __HIP_MEMORY_SCOPE_AGENT); }
__device__ __forceinline__ unsigned xb_add(unsigned* p, unsigned v) { return __hip_atomic_fetch_add(p, v, __ATOMIC_RELAXED, __HIP_MEMORY_SCOPE_AGENT); }
__device__ __forceinline__ unsigned xb_xcc_id() { return (unsigned)__builtin_amdgcn_s_getreg((3 << 11) | 20) & 0xFu; }
#define XB_SPIN(cond, bar) do { unsigned _sp = 0; while (cond) { __builtin_amdgcn_s_sleep(1); \
    if ((++_sp & 255u) == 0u) { if (xb_ld(&(bar)[XB_TMO])) break; if (_sp > XB_SPIN_CAP) { atomicAdd(&(bar)[XB_TMO], 1u); break; } } } } while (0)
struct XcdBarrier { unsigned* bar; unsigned x; volatile unsigned* st; };
__device__ __forceinline__ XcdBarrier xcd_barrier_post(unsigned* bar, volatile unsigned* st) {
    XcdBarrier b; b.bar = bar; b.x = xb_xcc_id(); b.st = st;
    if (threadIdx.x == 0) (void)xb_add(&bar[XB_XCNT(b.x)], 1u);
    return b;
}
__device__ __forceinline__ void xcd_barrier_complete(unsigned* bar, unsigned x, unsigned& nloc, unsigned& nx) {
    const unsigned G = gridDim.x * gridDim.y * gridDim.z;
    unsigned sum, cnt, mine, sp = 0u;
    for (;;) {
        sum = 0u; cnt = 0u; mine = 0u;
#pragma unroll
        for (unsigned j = 0; j < 16; ++j) { const unsigned c = xb_ld(&bar[XB_XCNT(j)]); sum += c; cnt += (c > 0u) ? 1u : 0u; mine = (j == x) ? c : mine; }
        if (sum == G) break;
        __builtin_amdgcn_s_sleep(1);
        if ((++sp & 255u) == 0u) { if (xb_ld(&bar[XB_TMO])) break; if (sp > XB_SPIN_CAP) { atomicAdd(&bar[XB_TMO], 1u); break; } }
    }
    nloc = mine > 0u ? mine : 1u; nx = cnt > 0u ? cnt : 1u;
}
__device__ __forceinline__ void xcd_barrier(const XcdBarrier& b) {
    asm volatile("s_waitcnt vmcnt(0)" ::: "memory");
    __syncthreads();
    if (threadIdx.x == 0) {
        unsigned* bar = b.bar;
        __builtin_amdgcn_s_waitcnt(0);
        unsigned nloc = b.st[0], nx = b.st[1];
        if (nloc == 0u) { xcd_barrier_complete(bar, b.x, nloc, nx); b.st[0] = nloc; b.st[1] = nx; }
        const unsigned old = xb_add(&bar[XB_XSUB(b.x)], 1u);
        const unsigned gen = old / nloc;
        if (old + 1u == (gen + 1u) * nloc) {
            __builtin_amdgcn_fence(__ATOMIC_RELEASE, "agent");
            asm volatile("s_waitcnt vmcnt(0)" ::: "memory");
            const unsigned og = xb_add(&bar[XB_TOP], 1u);
            const unsigned tg = og / nx;
            if (og + 1u == (tg + 1u) * nx) xb_add(&bar[XB_TOPGEN], 1u);
            else XB_SPIN(xb_ld(&bar[XB_TOPGEN]) == tg, bar);
            __builtin_amdgcn_fence(__ATOMIC_ACQUIRE, "agent");
            xb_add(&bar[XB_XGEN(b.x)], 1u);
            asm volatile("s_waitcnt vmcnt(0)" ::: "memory");
        } else {
            XB_SPIN(xb_ld(&bar[XB_XGEN(b.x)]) == gen, bar);
            __builtin_amdgcn_fence(__ATOMIC_ACQUIRE, "agent");
            asm volatile("s_waitcnt vmcnt(0)" ::: "memory");
        }
    }
    __syncthreads();
}

__device__ __forceinline__ void run_phase(KP& p, int ph, unsigned char* lds) {
#ifndef TEST_K
    if (ph == 0) { phase0(p, lds); return; }
#else
    if (TEST_K == 7) { phase0(p, lds); return; }
#endif
    const int l = (ph - 1) / 7, k = (ph - 1) % 7;
#ifdef TEST_K
    if (k != TEST_K) return;
#endif
    switch (k) {
        case 0: { EpiIn e{l}; gemm_run(p.ab, p.win_t + (size_t)l * NINP * DM, TT, NINP, DM, lds, e); } break;
        case 1: mixer_phase(p, l, lds); break;
        case 2: { EpiWo e{l}; gemm_run(p.ab, p.wo_t + (size_t)l * DM * DM, TP, DM, DM, lds, e); __syncthreads(); gemm_tail(p, p.ab, p.wo_t + (size_t)l * DM * DM, DM, 4, lds); } break;
        case 3: ln_phase(p, l, 1); if (l == 0) convert_cache(p, 1); break;
        case 4: { EpiGu e{0}; gemm_run(p.ab, p.wgu_t + (size_t)l * NGU * DM, TT, NGU, DM, lds, e); } break;
        case 5: { EpiDn e{0}; gemm_run(p.act, p.wdn_t + (size_t)l * DM * DFF, TP, DM, DFF, lds, e); __syncthreads(); gemm_tail(p, p.act, p.wdn_t + (size_t)l * DM * DFF, DFF, 7, lds); } break;
        case 6: ln_phase(p, l, 2); break;
    }
}

__global__ void __launch_bounds__(512, 2) mk(Params p, int ph_lo, int ph_hi) {
    extern __shared__ __attribute__((aligned(16))) unsigned char lds[];
#if MK_COOP
    volatile unsigned* st = (volatile unsigned*)(lds + LDS_BYTES);
    if (threadIdx.x == 0) { st[0] = 0u; st[1] = 0u; st[2] = 0u; st[3] = 0u; }
    __syncthreads();
    XcdBarrier xb = xcd_barrier_post(kparams().bar, st);
#endif
    for (int ph = ph_lo; ph < ph_hi; ++ph) {
        int reps = 1;
#ifdef DUP_K
        if (ph > 0 && (ph - 1) % 7 == DUP_K) reps = 2;
        if (ph == 0 && DUP_K == 7) reps = 2;
#endif
        for (int rp = 0; rp < reps; ++rp) { run_phase(kparams(), ph, lds); __syncthreads(); }
#if MK_COOP
        if (ph + 1 < ph_hi) xcd_barrier(xb);
#endif
    }
}

static inline size_t al256(size_t x) { return (x + 255) & ~(size_t)255; }

extern "C" void kernel_launch(void* const* d_in, const int* in_sizes, int n_in, void* d_out, int out_size, void* d_ws, size_t ws_size, hipStream_t stream) {
    static int grid = 0;
    if (grid == 0) {
        int dev = 0, cus = 0, per_cu = 0;
        hipGetDevice(&dev);
        hipDeviceGetAttribute(&cus, hipDeviceAttributeMultiprocessorCount, dev);
        if (hipFuncSetAttribute((const void*)mk, hipFuncAttributeMaxDynamicSharedMemorySize, LDS_BYTES + 16) != hipSuccess) { fprintf(stderr, "hipFuncSetAttribute failed\n"); grid = -1; return; }
        hipOccupancyMaxActiveBlocksPerMultiprocessor(&per_cu, (const void*)mk, NTHR, LDS_BYTES + 16);
        if (per_cu < 1) { fprintf(stderr, "occupancy query says %d\n", per_cu); grid = -1; return; }
        if (per_cu > 1) per_cu = 1;
        grid = cus * per_cu;
        fprintf(stderr, "grid %d (cus %d x %d)\n", grid, cus, per_cu);
    }
    if (grid < 0) return;
    Params p{};
    const float* const* in = (const float* const*)d_in;
    p.x_prompt = in[0]; p.x_sample = in[1]; p.cache_k = in[2]; p.cache_v = in[3]; p.cache_ki = in[4]; p.state_conv = in[5];
    p.w_in = in[6]; p.conv_w = in[7]; p.conv_b = in[8]; p.cln_g = in[9]; p.cln_b = in[10]; p.w_o = in[11]; p.ln1_g = in[12]; p.ln1_b = in[13];
    p.w_gu = in[14]; p.w_dn = in[15]; p.ln2_g = in[16]; p.ln2_b = in[17];
    p.out = (float*)d_out;
    unsigned char* w = (unsigned char*)d_ws; size_t off = 0;
    auto take = [&](size_t bytes) { unsigned char* r = w + off; off = al256(off + bytes); return r; };
    p.win_t = (bf16_t*)take((size_t)2 * NINP * DM * 2);
    p.wo_t = (bf16_t*)take((size_t)2 * DM * DM * 2);
    p.wgu_t = (bf16_t*)take((size_t)2 * NGU * DM * 2);
    p.wdn_t = (bf16_t*)take((size_t)2 * DM * DFF * 2);
    p.trig = (float2*)take((size_t)SS * 32 * 8);
    p.kp = (bf16_t*)take((size_t)4 * SP * 128 * 2); p.vp = (bf16_t*)take((size_t)4 * SP * 128 * 2); p.kip = (bf16_t*)take((size_t)4 * SP * 64 * 2);
    p.ks = (bf16_t*)take((size_t)16 * SS * 128 * 2); p.vs = (bf16_t*)take((size_t)16 * SS * 128 * 2); p.kis = (bf16_t*)take((size_t)16 * SS * 64 * 2);
    p.ab = (bf16_t*)take((size_t)TT * DM * 2);
    p.F = (float*)take((size_t)TT * DM * 4);
    unsigned char* big = take((size_t)TT * DFF * 2);
    p.act = (bf16_t*)big;
    p.u = (bf16_t*)big; p.q = (bf16_t*)(big + (size_t)TT * 512 * 2); p.qi = (bf16_t*)(big + (size_t)2 * TT * 512 * 2); p.wi = (float*)(big + (size_t)3 * TT * 512 * 2);
    p.bar = (unsigned*)take((size_t)XCD_BAR_WORDS * 4);
    p.part = (float*)take((size_t)7 * TSM * DM * 4);
    if (off > ws_size) { fprintf(stderr, "workspace too small: need %zu have %zu\n", off, ws_size); return; }
#if MK_COOP
    if (hipMemsetAsync(p.bar, 0, (size_t)XCD_BAR_WORDS * 4, stream) != hipSuccess) { fprintf(stderr, "memset failed\n"); return; }
    int lo = 0, hi = 15;
    void* args[] = {&p, &lo, &hi};
    hipError_t e = hipLaunchCooperativeKernel((const void*)mk, dim3(grid), dim3(NTHR), args, LDS_BYTES + 16, stream);
    if (e != hipSuccess) fprintf(stderr, "cooperative launch failed: %s (grid %d)\n", hipGetErrorString(e), grid);
#else
    for (int ph = 0; ph < 15; ++ph) hipLaunchKernelGGL(mk, dim3(grid), dim3(NTHR), LDS_BYTES + 16, stream, p, ph, ph + 1);
#endif
}
```

```cpp
#include <hip/hip_runtime.h>
#include <hip/hip_cooperative_groups.h>
#include <cstdio>
#include <cstdint>
namespace cg = cooperative_groups;

#ifndef DUP_PART
#define DUP_PART 0
#endif
#ifndef MK_COOP
#define MK_COOP 1
#endif

typedef unsigned short bf16_t;
typedef short bf16x8 __attribute__((ext_vector_type(8)));
typedef float f32x4 __attribute__((ext_vector_type(4)));
typedef float f32x16 __attribute__((ext_vector_type(16)));
typedef unsigned u32x4 __attribute__((ext_vector_type(4)));

constexpr int DM = 1024, TP = 16384, TSM = 1024, TT = TP + TSM;
constexpr int NIN = 2376, NINP = 2560, DFF = 2816, NGU = 5632;
constexpr int NTHR = 512, NQ = 8;
constexpr int SP = 4096, SS = 4160;
constexpr int LDS_BYTES = NQ * SS * 4 + NQ * 256 * 2;
constexpr float ALPHA = 1.4142135623730951f;
constexpr float LN_EPS = 1e-5f;

constexpr size_t O_YP = 0, O_YS = 16777216, O_KP = 17825792, O_VP = 22020096, O_KIP = 26214400, O_CP = 28311552,
                 O_KS = 28434432, O_VS = 28696576, O_KIS = 28958720, O_CS = 29089792;

struct Params {
    const float *x_prompt, *x_sample, *cache_k, *cache_v, *cache_ki, *state_conv;
    const float *w_in, *conv_w, *conv_b, *cln_g, *cln_b, *w_o, *ln1_g, *ln1_b, *w_gu, *w_dn, *ln2_g, *ln2_b;
    float* out;
    bf16_t *win_t, *wo_t, *wgu_t, *wdn_t;
    float2* trig;
    bf16_t *kp, *vp, *kip, *ks, *vs, *kis;
    bf16_t* ab;
    float* F;
    bf16_t *act, *u, *q, *qi;
    float* wi;
    unsigned* bar;
    float* part;
};

typedef const __attribute__((address_space(4))) Params KP;
__device__ __forceinline__ KP& kparams() { KP* k = (KP*)__builtin_amdgcn_kernarg_segment_ptr(); asm volatile("" : "+s"(k)); return *k; }
__device__ __forceinline__ unsigned pk_bf16(float lo, float hi) { unsigned r; asm volatile("v_cvt_pk_bf16_f32 %0, %1, %2" : "=v"(r) : "v"(lo), "v"(hi)); return r; }
__device__ __forceinline__ float bf_lo(unsigned v) { return __uint_as_float(v << 16); }
__device__ __forceinline__ float bf_hi(unsigned v) { return __uint_as_float(v & 0xffff0000u); }
__device__ __forceinline__ int opaque_tid() { int t = threadIdx.x; asm volatile("" : "+v"(t)); return t; }
__device__ __forceinline__ unsigned tokey(float f) { unsigned u = __float_as_uint(f); return (u & 0x80000000u) ? ~u : (u | 0x80000000u); }
__device__ __forceinline__ float sigmoidf_(float x) { return 1.0f / (1.0f + __expf(-x)); }

__device__ __forceinline__ int perm_in(int n) {
    const int tile = n >> 8, bj = (n >> 7) & 1, wc = (n >> 5) & 3, i = n & 31;
    if (tile < 4) { const int ch = 128 * tile + 32 * wc + i; return bj ? 512 + ch : ch; }
    if (tile < 6) return 1024 + ((tile - 4) * 4 + wc) * 64 + i + 32 * bj;
    if (tile == 6) return (wc < 2) ? 1536 + wc * 64 + i + 32 * bj : 1664 + 64 * bj + 32 * (wc - 2) + i;
    if (tile < 9) return 1792 + ((tile - 7) * 4 + wc) * 64 + i + 32 * bj;
    if (wc == 0) return 2304 + i + 32 * bj;
    if (wc == 1 && bj == 0 && i < 8) return 2368 + i;
    return -1;
}
__device__ __forceinline__ int perm_gu(int n) { const int tile = n >> 8, bj = (n >> 7) & 1, w = n & 127; const int ch = 128 * tile + w; return bj ? DFF + ch : ch; }

template <int MODE>
__device__ __forceinline__ void transpose_tiles(const float* __restrict__ W, bf16_t* __restrict__ Wt, int K, int N, int Np, float* lds0, int& cursor) {
    const int tk = K >> 6, tn = Np >> 6, nt = tk * tn, tid5 = opaque_tid(), vb = tid5 >> 8, tid = tid5 & 255;
    float* lds = lds0 + vb * (64 * 65);
    const int VG = 2 * (int)gridDim.x;
    int f0 = 2 * (int)blockIdx.x - cursor; if (f0 < 0) f0 += VG;
    int f1 = 2 * (int)blockIdx.x + 1 - cursor; if (f1 < 0) f1 += VG;
    cursor = (cursor + nt) % VG;
    const int fmin = f0 < f1 ? f0 : f1, first = vb ? f1 : f0;
    for (int it = 0; fmin + it * VG < nt; ++it) {
        const int t = first + it * VG;
        const bool on = t < nt;
        const int k0 = on ? (t / tn) << 6 : 0, n0 = on ? (t % tn) << 6 : 0;
        __syncthreads();
        if (on) {
#pragma unroll
            for (int i = 0; i < 16; ++i) {
                const int k = i * 4 + (tid >> 6), n = tid & 63;
                int c = n0 + n; if (MODE == 1) c = perm_in(c); else if (MODE == 2) c = perm_gu(c);
                lds[k * 65 + n] = (c >= 0) ? W[(size_t)(k0 + k) * N + c] : 0.f;
            }
        }
        __syncthreads();
        if (on) {
#pragma unroll
            for (int i = 0; i < 8; ++i) {
                const int n = i * 8 + (tid >> 5), k = (tid & 31) * 2;
                *(unsigned*)(Wt + (size_t)(n0 + n) * K + k0 + k) = pk_bf16(lds[k * 65 + n], lds[(k + 1) * 65 + n]);
            }
        }
    }
}

__device__ __forceinline__ void convert_chunks(const float* __restrict__ src, bf16_t* __restrict__ dst, int nb, int chunk8  , int dst_stride8  ) {
    const int total = nb * chunk8;
    for (int i = blockIdx.x * NTHR + opaque_tid(); i < total; i += gridDim.x * NTHR) {
        const int b = i / chunk8, r = i - b * chunk8;
        const float4 a = *(const float4*)(src + (size_t)i * 8), c = *(const float4*)(src + (size_t)i * 8 + 4);
        uint4 o; o.x = pk_bf16(a.x, a.y); o.y = pk_bf16(a.z, a.w); o.z = pk_bf16(c.x, c.y); o.w = pk_bf16(c.z, c.w);
        *(uint4*)(dst + ((size_t)b * dst_stride8 + r) * 8) = o;
    }
}
__device__ __forceinline__ void convert_cache(KP& p, int l) {
    convert_chunks(p.cache_k + (size_t)l * 16 * 4096 * 128, p.ks, 16, 4096 * 16, SS * 16);
    convert_chunks(p.cache_v + (size_t)l * 16 * 4096 * 128, p.vs, 16, 4096 * 16, SS * 16);
    convert_chunks(p.cache_ki + (size_t)l * 16 * 4096 * 64, p.kis, 16, 4096 * 8, SS * 8);
}

__device__ __forceinline__ void phase0(KP& p, unsigned char* lds) {
    int cursor = 0;
    for (int l = 0; l < 2; ++l) {
        transpose_tiles<1>(p.w_in + (size_t)l * DM * NIN, p.win_t + (size_t)l * NINP * DM, DM, NIN, NINP, (float*)lds, cursor);
        transpose_tiles<0>(p.w_o + (size_t)l * DM * DM, p.wo_t + (size_t)l * DM * DM, DM, DM, DM, (float*)lds, cursor);
        transpose_tiles<2>(p.w_gu + (size_t)l * DM * NGU, p.wgu_t + (size_t)l * NGU * DM, DM, NGU, NGU, (float*)lds, cursor);
        transpose_tiles<0>(p.w_dn + (size_t)l * DFF * DM, p.wdn_t + (size_t)l * DM * DFF, DFF, DM, DM, (float*)lds, cursor);
    }
    __syncthreads();
    convert_chunks(p.x_prompt, p.ab, 1, TP * 128, TP * 128);
    convert_chunks(p.x_sample, p.ab + (size_t)TP * DM, 1, TSM * 128, TSM * 128);
    convert_cache(p, 0);
    for (int i = blockIdx.x * NTHR + opaque_tid(); i < SS * 32; i += gridDim.x * NTHR) {
        const int pos = i >> 5, f = i & 31;
        const float inv = exp2f(-(float)f * (13.287712379549449f / 32.0f));
        const float angf = (float)pos * inv;
        const double rev = (double)angf * 0.15915494309189535;
        const double fr = rev - __builtin_rint(rev);
        const float ang = (float)(fr * 6.283185307179586);
        p.trig[i] = make_float2(__cosf(ang), __sinf(ang));
    }
}

namespace pg8 {
#define PG8_LAS __attribute__((address_space(3)))
typedef unsigned short bf16_t;
typedef short bf16x8 __attribute__((ext_vector_type(8)));
typedef float f32x4 __attribute__((ext_vector_type(4)));
typedef unsigned u32x4 __attribute__((ext_vector_type(4)));
constexpr int BM = 256, BK = 64, HALF = 128, HTB = HALF * BK * 2  , STAGE_BYTES = 8 * HTB, NXCD = 8, WGM = 8;

__host__ __device__ __forceinline__ int lds_byte(int r, int c) { const int st = (r >> 4) * 2 + (c >> 5), rr = r & 15, cc = c & 31, ob = rr * 64 + cc * 2; return st * 1024 + (ob ^ (((ob >> 9) & 1) << 5)); }
__host__ __device__ __forceinline__ void stage_rc(int b, int& R, int& C) { const int st = b / 1024, sb = b % 1024, swz = sb ^ (((sb >> 9) & 1) << 5); R = (st >> 1) * 16 + swz / 64; C = (st & 1) * 32 + (swz % 64) / 2; }
__host__ __device__ __forceinline__ int perm32(int rho) { const int n = rho >> 4, i = rho & 15; return 8 * (i >> 2) + 4 * n + (i & 3); }

struct Unit { int pm, pn; };
struct Gemm { const bf16_t* A; const bf16_t* Bt; int M, N, K, Kl; };

struct StaticOrder {
    int nM, nN, nwg, G, c;
    __host__ __device__ void init(int M, int N, int G_, int c_) { nM = M / BM; nN = N / BM; nwg = nM * nN; G = G_; c = c_; }
    __host__ __device__ bool next(int i, Unit& u) const {
        const long L = (long)i * G + c; if (L >= nwg) return false;
        int wgid = (int)L; { const int q = nwg / NXCD, r = nwg % NXCD, xcd = wgid % NXCD, off = wgid / NXCD; wgid = (xcd < r ? xcd * (q + 1) : r * (q + 1) + (xcd - r) * q) + off; }
        const int nig = WGM * nN, gid = wgid / nig, fm = gid * WGM, gsz = (nM - fm) < WGM ? (nM - fm) : WGM;
        u.pm = fm + ((wgid % nig) % gsz); u.pn = (wgid % nig) / gsz; return true;
    }
    __device__ __forceinline__ void a_ready(const Unit&) const {}
    __device__ __forceinline__ void done(const Unit&) const {}
};

__device__ __forceinline__ unsigned cvt_pk_bf16(float lo, float hi) { unsigned r; asm volatile("v_cvt_pk_bf16_f32 %0, %1, %2" : "=v"(r) : "v"(lo), "v"(hi)); return r; }
template <class Epi, class Sched, bool ALIGN_EPI = false, bool SP2 = false>
__device__ __forceinline__ void gemm_phase(PG8_LAS unsigned char* lds, const Gemm g, const Sched& S, const Epi& E) {
    const int tid = opaque_tid(), wid = __builtin_amdgcn_readfirstlane(tid >> 6), lane = tid & 63, wr = wid >> 2, wc = wid & 3, fr = lane & 15, fq = lane >> 4;
    const int K = g.K, nt = g.Kl / BK;
    unsigned voffA[2], voffB[2];
#pragma unroll
    for (int i = 0; i < 2; ++i) { int R, C; stage_rc(tid * 16 + i * 8192, R, C); const int Rb = Epi::PERM ? ((R & ~31) + perm32(R & 31)) : R;
        voffA[i] = (unsigned)(R * K + C) * 2u; voffB[i] = (unsigned)(Rb * K + C) * 2u; }
    const size_t kstep = (size_t)(BK * 2);
    const size_t hstep = (size_t)HALF * K * 2;
    const size_t tstep = 2 * hstep;
    const unsigned ldsw = (unsigned)wid * 1024u;
    const int aoff = lds_byte(wr * 64 + fr, fq * 8), boff = lds_byte(wc * 32 + fr, fq * 8);
#define PG8_SA(b, h) (((b) * 2 + (h)) * HTB)
#define PG8_SB(b, h) ((4 + (b) * 2 + (h)) * HTB)
#define PG8_STAGE(bufoff, gbase, voff) do { _Pragma("unroll") for (int _i = 0; _i < 2; ++_i) \
        __builtin_amdgcn_global_load_lds((const unsigned*)((const char*)(gbase) + (voff)[_i]), (PG8_LAS unsigned*)(lds + (bufoff) + ldsw + _i * 8192), 16, 0, 0); } while (0)
#define PG8_LDA(dst, b, h) do { _Pragma("unroll") for (int m = 0; m < 4; ++m) _Pragma("unroll") for (int k = 0; k < 2; ++k) dst[m][k] = *(const PG8_LAS bf16x8*)(lds + PG8_SA(b, h) + aoff + m * 2048 + k * 1024); } while (0)
#define PG8_LDB(dst, b, h) do { _Pragma("unroll") for (int n = 0; n < 2; ++n) _Pragma("unroll") for (int k = 0; k < 2; ++k) dst[n][k] = *(const PG8_LAS bf16x8*)(lds + PG8_SB(b, h) + boff + n * 2048 + k * 1024); } while (0)
#define PG8_MMA(ai, bj, At, Bt) do { __builtin_amdgcn_s_setprio(1); _Pragma("unroll") for (int m = 0; m < 4; ++m) _Pragma("unroll") for (int n = 0; n < 2; ++n) _Pragma("unroll") for (int k = 0; k < 2; ++k) \
        acc[ai][bj][m][n] = __builtin_amdgcn_mfma_f32_16x16x32_bf16(Bt[n][k], At[m][k], acc[ai][bj][m][n], 0, 0, 0); __builtin_amdgcn_s_setprio(0); } while (0)
#define PG8_WAIT_V(n) asm volatile("s_waitcnt vmcnt(" #n ")" ::: "memory")
#define PG8_WAIT_L(n) asm volatile("s_waitcnt lgkmcnt(" #n ")" ::: "memory")
#define PG8_BAR __builtin_amdgcn_s_barrier()
#define PG8_SCHED __builtin_amdgcn_sched_barrier(0)
    Unit cur, nxt; int ui = 0;
    if (!S.next(0, cur)) return;
    f32x4 acc[2][2][4][2];
#pragma unroll
    for (int a = 0; a < 2; ++a)
#pragma unroll
        for (int b = 0; b < 2; ++b)
#pragma unroll
            for (int m = 0; m < 4; ++m)
#pragma unroll
                for (int n = 0; n < 2; ++n) acc[a][b][m][n] = (f32x4){0.f, 0.f, 0.f, 0.f};
    bf16x8 At[4][2], B0[2][2], B1[2][2];
    const char* cA = (const char*)g.A + (size_t)cur.pm * tstep; const char* cB = (const char*)g.Bt + (size_t)cur.pn * tstep;
    S.a_ready(cur);
    if constexpr (SP2) {
        PG8_STAGE(PG8_SB(0, 0), cB, voffB); PG8_STAGE(PG8_SB(0, 1), cB + hstep, voffB); PG8_STAGE(PG8_SA(0, 0), cA, voffA); PG8_STAGE(PG8_SA(0, 1), cA + hstep, voffA);
        if (wr == 1) PG8_BAR;
        PG8_WAIT_V(2); PG8_BAR;
        PG8_STAGE(PG8_SB(1, 0), cB + kstep, voffB); PG8_STAGE(PG8_SA(1, 0), cA + kstep, voffA); PG8_STAGE(PG8_SB(1, 1), cB + hstep + kstep, voffB);
        PG8_WAIT_V(6); PG8_BAR;
    } else {
        PG8_STAGE(PG8_SB(0, 0), cB, voffB); PG8_STAGE(PG8_SA(0, 0), cA, voffA); PG8_STAGE(PG8_SB(0, 1), cB + hstep, voffB); PG8_STAGE(PG8_SA(0, 1), cA + hstep, voffA);
        if (wr == 1) PG8_BAR;
        PG8_WAIT_V(4); PG8_BAR;
        PG8_STAGE(PG8_SB(1, 0), cB + kstep, voffB); PG8_STAGE(PG8_SA(1, 0), cA + kstep, voffA); PG8_STAGE(PG8_SB(1, 1), cB + hstep + kstep, voffB);
        PG8_WAIT_V(6); PG8_BAR;
    }
    for (;;) {
        const bool has_next = S.next(ui + 1, nxt);
        const char* nA = has_next ? (const char*)g.A + (size_t)nxt.pm * tstep : cA; const char* nB = has_next ? (const char*)g.Bt + (size_t)nxt.pn * tstep : cB;
        for (int t = 0; t < nt; t += 2) {
            const bool last = (t == nt - 2);
            const char* a1 = cA + (size_t)(t + 1) * kstep;
            const char* a2 = last ? nA : cA + (size_t)(t + 2) * kstep; const char* b2 = last ? nB : cB + (size_t)(t + 2) * kstep;
            const char* a3 = a2 + kstep; const char* b3 = b2 + kstep;
            if (last && has_next) S.a_ready(nxt);
            if constexpr (SP2) {
            PG8_LDB(B0, 0, 0); PG8_LDB(B1, 0, 1); PG8_SCHED; PG8_LDA(At, 0, 0); PG8_STAGE(PG8_SA(1, 1), a1 + hstep, voffA);
            PG8_WAIT_V(8); PG8_WAIT_L(0); PG8_BAR; PG8_MMA(0, 0, At, B0); PG8_MMA(0, 1, At, B1); PG8_BAR; PG8_SCHED;
            PG8_LDA(At, 0, 1); PG8_STAGE(PG8_SB(0, 0), b2, voffB); PG8_STAGE(PG8_SB(0, 1), b2 + hstep, voffB); PG8_STAGE(PG8_SA(0, 0), a2, voffA);
            PG8_WAIT_V(8); PG8_WAIT_L(0); PG8_BAR; PG8_MMA(1, 0, At, B0); PG8_MMA(1, 1, At, B1); PG8_BAR; PG8_SCHED;
            PG8_LDB(B0, 1, 0); PG8_LDB(B1, 1, 1); PG8_SCHED; PG8_LDA(At, 1, 0); PG8_STAGE(PG8_SA(0, 1), a2 + hstep, voffA);
            PG8_WAIT_V(8); PG8_WAIT_L(0); PG8_BAR; PG8_MMA(0, 0, At, B0); PG8_MMA(0, 1, At, B1); PG8_BAR; PG8_SCHED;
            PG8_LDA(At, 1, 1); PG8_STAGE(PG8_SB(1, 0), b3, voffB); PG8_STAGE(PG8_SB(1, 1), b3 + hstep, voffB); PG8_STAGE(PG8_SA(1, 0), a3, voffA);
            PG8_WAIT_V(8); PG8_WAIT_L(0); PG8_BAR; PG8_MMA(1, 0, At, B0); PG8_MMA(1, 1, At, B1); PG8_BAR; PG8_SCHED;
            } else {
            PG8_LDB(B0, 0, 0); PG8_SCHED; PG8_LDA(At, 0, 0); PG8_STAGE(PG8_SA(1, 1), a1 + hstep, voffA);
            PG8_WAIT_L(8); PG8_BAR; PG8_WAIT_L(0); PG8_MMA(0, 0, At, B0); PG8_BAR; PG8_SCHED;
            PG8_LDB(B1, 0, 1); PG8_STAGE(PG8_SB(0, 0), b2, voffB);
            PG8_BAR; PG8_WAIT_L(0); PG8_MMA(0, 1, At, B1); PG8_BAR;
            PG8_LDA(At, 0, 1); PG8_STAGE(PG8_SA(0, 0), a2, voffA);
            PG8_BAR; PG8_WAIT_L(0); PG8_MMA(1, 0, At, B0); PG8_BAR; PG8_SCHED;
            PG8_STAGE(PG8_SB(0, 1), b2 + hstep, voffB);
            PG8_WAIT_V(6); PG8_BAR; PG8_MMA(1, 1, At, B1); PG8_BAR;
            PG8_LDB(B0, 1, 0); PG8_SCHED; PG8_LDA(At, 1, 0); PG8_STAGE(PG8_SA(0, 1), a2 + hstep, voffA);
            PG8_WAIT_L(8); PG8_BAR; PG8_WAIT_L(0); PG8_MMA(0, 0, At, B0); PG8_BAR; PG8_SCHED;
            PG8_LDB(B1, 1, 1); PG8_STAGE(PG8_SB(1, 0), b3, voffB);
            PG8_BAR; PG8_WAIT_L(0); PG8_MMA(0, 1, At, B1); PG8_BAR;
            PG8_LDA(At, 1, 1); PG8_STAGE(PG8_SA(1, 0), a3, voffA);
            PG8_BAR; PG8_WAIT_L(0); PG8_MMA(1, 0, At, B0); PG8_BAR; PG8_SCHED;
            PG8_STAGE(PG8_SB(1, 1), b3 + hstep, voffB);
            PG8_WAIT_V(6); PG8_BAR; PG8_MMA(1, 1, At, B1); PG8_BAR;
            }
        }
        if constexpr (ALIGN_EPI) { if (wr == 0) PG8_BAR; }
        if constexpr (!Epi::AFTER_DRAIN) { E(acc, cur, wr, wc, fr, fq); S.done(cur); }
        if (!has_next) break;
#pragma unroll
        for (int a = 0; a < 2; ++a)
#pragma unroll
            for (int b = 0; b < 2; ++b)
#pragma unroll
                for (int m = 0; m < 4; ++m)
#pragma unroll
                    for (int n = 0; n < 2; ++n) acc[a][b][m][n] = (f32x4){0.f, 0.f, 0.f, 0.f};
        cur = nxt; cA = nA; cB = nB; ++ui;
        if constexpr (ALIGN_EPI) { if (wr == 1) PG8_BAR; }
    }
    PG8_WAIT_V(0);
    if constexpr (!ALIGN_EPI) { if (wr == 0) PG8_BAR; }
    PG8_BAR;
    if constexpr (Epi::AFTER_DRAIN) { E.fused(acc, cur, wr, wc, fr, fq, lds, wid, lane); S.done(cur); }
#undef PG8_SA
#undef PG8_SB
#undef PG8_STAGE
#undef PG8_LDA
#undef PG8_LDB
#undef PG8_MMA
#undef PG8_WAIT_V
#undef PG8_WAIT_L
#undef PG8_BAR
#undef PG8_SCHED
}
}

#ifndef PG8_SP2
#define PG8_SP2 true
#endif
#ifndef PG8_ALIGN
#define PG8_ALIGN true
#endif

__device__ __forceinline__ void tok_decode(int row, bool& isS, int& b, int& t, int& pos) {
    isS = row >= TP;
    if (!isS) { b = row >> 12; t = row & 4095; pos = t; } else { const int r = row - TP; b = r >> 6; t = r & 63; pos = 4096 + t; }
}
typedef pg8::f32x4 (AccT)[2][2][4][2];

struct EpiIn {
    static constexpr bool PERM = false, AFTER_DRAIN = false;
    int l;
    __device__ __forceinline__ void operator()(const AccT& acc, const pg8::Unit& u, int wr, int wc, int fr, int fq) const {
        KP& p = kparams();
        const int tile = u.pn;
#pragma unroll
        for (int ai = 0; ai < 2; ++ai)
#pragma unroll
        for (int m = 0; m < 4; ++m) {
            const int row = u.pm * 256 + ai * 128 + wr * 64 + m * 16 + fr;
            bool isS; int b, t, pos; tok_decode(row, isS, b, t, pos);
            if (tile < 4) {
                const int tl = isS ? t - 34 : t - 4066;
#pragma unroll
                for (int n = 0; n < 2; ++n) {
                    const int ch = 128 * tile + 32 * wc + n * 16 + fq * 4;
                    float uu[4];
#pragma unroll
                    for (int j = 0; j < 4; ++j) uu[j] = acc[ai][0][m][n][j] * sigmoidf_(acc[ai][1][m][n][j]);
                    uint2 w; w.x = pk_bf16(uu[0], uu[1]); w.y = pk_bf16(uu[2], uu[3]);
                    *(uint2*)(p.u + (size_t)row * 512 + ch) = w;
                    if (tl >= 0) {
                        float* o = p.out + (isS ? O_CS + ((size_t)(l * 16 + b) * 30 + tl) * 512 : O_CP + ((size_t)(l * 4 + b) * 30 + tl) * 512) + ch;
                        *(float4*)o = make_float4(uu[0], uu[1], uu[2], uu[3]);
                    }
                }
            } else if (tile == 6 && wc >= 2) {
#pragma unroll
                for (int bj = 0; bj < 2; ++bj) {
                    float* o = p.out + (isS ? O_VS + (((size_t)(l * 16 + b) * 64 + t) * 2 + bj) * 64 : O_VP + (((size_t)(l * 4 + b) * 4096 + t) * 2 + bj) * 64);
                    bf16_t* vb = (isS ? p.vs + ((size_t)b * SS + 4096 + t) * 128 : p.vp + ((size_t)b * SP + t) * 128) + bj * 64;
#pragma unroll
                    for (int n = 0; n < 2; ++n) {
                        const int d = 32 * (wc - 2) + n * 16 + fq * 4;
                        const pg8::f32x4 a = acc[ai][bj][m][n];
                        *(float4*)(o + d) = make_float4(a[0], a[1], a[2], a[3]);
                        uint2 w; w.x = pk_bf16(a[0], a[1]); w.y = pk_bf16(a[2], a[3]);
                        *(uint2*)(vb + d) = w;
                    }
                }
            } else if (tile == 9 && wc >= 1) {
                if (wc == 1 && fq < 2) {
                    const float s = 0.35355339059327373f * 0.125f;
                    const pg8::f32x4 a = acc[ai][0][m][0];
                    *(float4*)(p.wi + (size_t)row * 8 + fq * 4) = make_float4(a[0] * s, a[1] * s, a[2] * s, a[3] * s);
                }
            } else {
                float o1[2][4], o2[2][4];
#pragma unroll
                for (int n = 0; n < 2; ++n) {
                    const float4* tp = (const float4*)(p.trig + (size_t)pos * 32 + n * 16 + fq * 4);
                    const float4 t0 = tp[0], t1 = tp[1];
                    const float cs[4] = {t0.x, t0.z, t1.x, t1.z}, sn[4] = {t0.y, t0.w, t1.y, t1.w};
#pragma unroll
                    for (int j = 0; j < 4; ++j) {
                        const float x1 = acc[ai][0][m][n][j], x2 = acc[ai][1][m][n][j];
                        o1[n][j] = x1 * cs[j] - x2 * sn[j];
                        o2[n][j] = x2 * cs[j] + x1 * sn[j];
                    }
                }
                if (tile == 4 || tile == 5 || tile == 7 || tile == 8) {
                    const bool isq = tile < 6;
                    const float s = isq ? 0.125f * 1.4426950408889634f : 1.0f;
                    bf16_t* dst = (isq ? p.q + (size_t)row * 512 + ((tile - 4) * 4 + wc) * 64 : p.qi + (size_t)row * 512 + ((tile - 7) * 4 + wc) * 64);
#pragma unroll
                    for (int n = 0; n < 2; ++n) {
                        const int d = n * 16 + fq * 4;
                        uint2 w; w.x = pk_bf16(o1[n][0] * s, o1[n][1] * s); w.y = pk_bf16(o1[n][2] * s, o1[n][3] * s);
                        *(uint2*)(dst + d) = w;
                        w.x = pk_bf16(o2[n][0] * s, o2[n][1] * s); w.y = pk_bf16(o2[n][2] * s, o2[n][3] * s);
                        *(uint2*)(dst + d + 32) = w;
                    }
                } else if (tile == 6) {
                    const int kvh = wc;
                    float* o = p.out + (isS ? O_KS + (((size_t)(l * 16 + b) * 64 + t) * 2 + kvh) * 64 : O_KP + (((size_t)(l * 4 + b) * 4096 + t) * 2 + kvh) * 64);
                    bf16_t* kb = (isS ? p.ks + ((size_t)b * SS + 4096 + t) * 128 : p.kp + ((size_t)b * SP + t) * 128) + kvh * 64;
#pragma unroll
                    for (int n = 0; n < 2; ++n) {
                        const int d = n * 16 + fq * 4;
                        *(float4*)(o + d) = make_float4(o1[n][0], o1[n][1], o1[n][2], o1[n][3]);
                        *(float4*)(o + d + 32) = make_float4(o2[n][0], o2[n][1], o2[n][2], o2[n][3]);
                        uint2 w; w.x = pk_bf16(o1[n][0], o1[n][1]); w.y = pk_bf16(o1[n][2], o1[n][3]);
                        *(uint2*)(kb + d) = w;
                        w.x = pk_bf16(o2[n][0], o2[n][1]); w.y = pk_bf16(o2[n][2], o2[n][3]);
                        *(uint2*)(kb + d + 32) = w;
                    }
                } else {
                    float* o = p.out + (isS ? O_KIS + ((size_t)(l * 16 + b) * 64 + t) * 64 : O_KIP + ((size_t)(l * 4 + b) * 4096 + t) * 64);
                    bf16_t* kb = (isS ? p.kis + ((size_t)b * SS + 4096 + t) * 64 : p.kip + ((size_t)b * SP + t) * 64);
#pragma unroll
                    for (int n = 0; n < 2; ++n) {
                        const int d = n * 16 + fq * 4;
                        *(float4*)(o + d) = make_float4(o1[n][0], o1[n][1], o1[n][2], o1[n][3]);
                        *(float4*)(o + d + 32) = make_float4(o2[n][0], o2[n][1], o2[n][2], o2[n][3]);
                        uint2 w; w.x = pk_bf16(o1[n][0], o1[n][1]); w.y = pk_bf16(o1[n][2], o1[n][3]);
                        *(uint2*)(kb + d) = w;
                        w.x = pk_bf16(o2[n][0], o2[n][1]); w.y = pk_bf16(o2[n][2], o2[n][3]);
                        *(uint2*)(kb + d + 32) = w;
                    }
                }
            }
        }
    }
};

struct EpiWo {
    static constexpr bool PERM = false, AFTER_DRAIN = false;
    int l;
    __device__ __forceinline__ void operator()(const AccT& acc, const pg8::Unit& u, int wr, int wc, int fr, int fq) const {
        KP& p = kparams();
#pragma unroll
        for (int ai = 0; ai < 2; ++ai)
#pragma unroll
        for (int m = 0; m < 4; ++m) {
            const int row = u.pm * 256 + ai * 128 + wr * 64 + m * 16 + fr;
            const float* xr = (l == 0) ? ((row < TP) ? p.x_prompt + (size_t)row * DM : p.x_sample + (size_t)(row - TP) * DM) : p.F + (size_t)row * DM;
            float* fo = p.F + (size_t)row * DM;
#pragma unroll
            for (int bj = 0; bj < 2; ++bj)
#pragma unroll
            for (int n = 0; n < 2; ++n) {
                const int c = u.pn * 256 + bj * 128 + wc * 32 + n * 16 + fq * 4;
                const float4 x = *(const float4*)(xr + c);
                const pg8::f32x4 a = acc[ai][bj][m][n];
                *(float4*)(fo + c) = make_float4(ALPHA * x.x + a[0], ALPHA * x.y + a[1], ALPHA * x.z + a[2], ALPHA * x.w + a[3]);
            }
        }
    }
};
struct EpiGu {
    static constexpr bool PERM = false, AFTER_DRAIN = false;
    int pad_;
    __device__ __forceinline__ void operator()(const AccT& acc, const pg8::Unit& u, int wr, int wc, int fr, int fq) const {
        KP& p = kparams();
#pragma unroll
        for (int ai = 0; ai < 2; ++ai)
#pragma unroll
        for (int m = 0; m < 4; ++m) {
            const int row = u.pm * 256 + ai * 128 + wr * 64 + m * 16 + fr;
#pragma unroll
            for (int n = 0; n < 2; ++n) {
                float a[4];
#pragma unroll
                for (int j = 0; j < 4; ++j) { const float g = acc[ai][0][m][n][j]; a[j] = g * sigmoidf_(g) * acc[ai][1][m][n][j]; }
                uint2 w; w.x = pk_bf16(a[0], a[1]); w.y = pk_bf16(a[2], a[3]);
                *(uint2*)(p.act + (size_t)row * DFF + 128 * u.pn + 32 * wc + n * 16 + fq * 4) = w;
            }
        }
    }
};
struct EpiDn {
    static constexpr bool PERM = false, AFTER_DRAIN = false;
    int pad_;
    __device__ __forceinline__ void operator()(const AccT& acc, const pg8::Unit& u, int wr, int wc, int fr, int fq) const {
        KP& p = kparams();
#pragma unroll
        for (int ai = 0; ai < 2; ++ai)
#pragma unroll
        for (int m = 0; m < 4; ++m) {
            float* fo = p.F + (size_t)(u.pm * 256 + ai * 128 + wr * 64 + m * 16 + fr) * DM;
#pragma unroll
            for (int bj = 0; bj < 2; ++bj)
#pragma unroll
            for (int n = 0; n < 2; ++n) {
                const int c = u.pn * 256 + bj * 128 + wc * 32 + n * 16 + fq * 4;
                const float4 x = *(const float4*)(fo + c);
                const pg8::f32x4 a = acc[ai][bj][m][n];
                *(float4*)(fo + c) = make_float4(ALPHA * x.x + a[0], ALPHA * x.y + a[1], ALPHA * x.z + a[2], ALPHA * x.w + a[3]);
            }
        }
    }
};
template <class Epi>
__device__ __forceinline__ void gemm_run(const bf16_t* A, const bf16_t* Bt, int M, int N, int K, unsigned char* lds, const Epi& e) {
    pg8::Gemm g; g.A = A; g.Bt = Bt; g.M = M; g.N = N; g.K = K; g.Kl = K;
    pg8::StaticOrder S; S.init(M, N, (int)gridDim.x, (int)blockIdx.x);
    pg8::gemm_phase<Epi, pg8::StaticOrder, true, true>((PG8_LAS unsigned char*)lds, g, S, e);
}
struct OneUnit {
    int has; pg8::Unit u;
    __device__ __forceinline__ bool next(int i, pg8::Unit& o) const { if (i != 0 || !has) return false; o = u; return true; }
    __device__ __forceinline__ void a_ready(const pg8::Unit&) const {}
    __device__ __forceinline__ void done(const pg8::Unit&) const {}
};
struct EpiPart {
    static constexpr bool PERM = false, AFTER_DRAIN = false;
    float* dst;
    __device__ __forceinline__ void operator()(const AccT& acc, const pg8::Unit& u, int wr, int wc, int fr, int fq) const {
#pragma unroll
        for (int ai = 0; ai < 2; ++ai)
#pragma unroll
        for (int m = 0; m < 4; ++m) {
            float* fo = dst + (size_t)(u.pm * 256 + ai * 128 + wr * 64 + m * 16 + fr) * DM;
#pragma unroll
            for (int bj = 0; bj < 2; ++bj)
#pragma unroll
            for (int n = 0; n < 2; ++n) {
                const pg8::f32x4 a = acc[ai][bj][m][n];
                *(float4*)(fo + u.pn * 256 + bj * 128 + wc * 32 + n * 16 + fq * 4) = make_float4(a[0], a[1], a[2], a[3]);
            }
        }
    }
};
__device__ __forceinline__ void gemm_tail(KP& p, const bf16_t* A, const bf16_t* Bt, int K, int nsplit, unsigned char* lds) {
    const int c = blockIdx.x, nitems = 16 * nsplit;
    const int item = c < nitems ? c : 0, tile = item / nsplit, sl = item - tile * nsplit;
    int k0, kl;
    if (K == DM) { k0 = 256 * sl; kl = 256; } else { k0 = 384 * sl; kl = (sl == nsplit - 1) ? 512 : 384; }
    pg8::Gemm g; g.A = A + (size_t)TP * K + k0; g.Bt = Bt + k0; g.M = TSM; g.N = DM; g.K = K; g.Kl = kl;
    OneUnit S; S.has = c < nitems; S.u.pm = tile >> 2; S.u.pn = tile & 3;
    EpiPart e; e.dst = p.part + (size_t)sl * TSM * DM;
    pg8::gemm_phase<EpiPart, OneUnit, false, true>((PG8_LAS unsigned char*)lds, g, S, e);
}

__device__ __forceinline__ void ln_phase(KP& p, int l, int which) {
    const int tid = opaque_tid(), lane = tid & 63, wid = tid >> 6;
    const float* g = (which == 1 ? p.ln1_g : p.ln2_g) + l * DM;
    const float* bb = (which == 1 ? p.ln1_b : p.ln2_b) + l * DM;
    const bool fin = (which == 2 && l == 1);
    for (int row = blockIdx.x * 8 + wid; row < TT; row += gridDim.x * 8) {
        float* fr = p.F + (size_t)row * DM;
        float4 v[4];
        float s = 0.f;
#pragma unroll
        for (int i = 0; i < 4; ++i) v[i] = *(const float4*)(fr + i * 256 + lane * 4);
        if (row >= TP) {
            const int nsp = (which == 1) ? 4 : 7;
            const float* pr = p.part + (size_t)(row - TP) * DM;
#pragma unroll
            for (int i = 0; i < 4; ++i) {
                float4 x = v[i];
                if (which == 1 && l == 0) x = *(const float4*)(p.x_sample + (size_t)(row - TP) * DM + i * 256 + lane * 4);
                float4 a = make_float4(ALPHA * x.x, ALPHA * x.y, ALPHA * x.z, ALPHA * x.w);
                for (int sp = 0; sp < nsp; ++sp) { const float4 q = *(const float4*)(pr + (size_t)sp * TSM * DM + i * 256 + lane * 4); a.x += q.x; a.y += q.y; a.z += q.z; a.w += q.w; }
                v[i] = a;
            }
        }
#pragma unroll
        for (int i = 0; i < 4; ++i) s += (v[i].x + v[i].y) + (v[i].z + v[i].w);
#pragma unroll
        for (int o = 32; o >= 1; o >>= 1) s += __shfl_xor(s, o);
        const float mean = s * (1.0f / 1024.0f);
        float q = 0.f;
#pragma unroll
        for (int i = 0; i < 4; ++i) { const float a = v[i].x - mean, b = v[i].y - mean, c = v[i].z - mean, d = v[i].w - mean; q += (a * a + b * b) + (c * c + d * d); }
#pragma unroll
        for (int o = 32; o >= 1; o >>= 1) q += __shfl_xor(q, o);
        const float rstd = rsqrtf(q * (1.0f / 1024.0f) + LN_EPS);
#pragma unroll
        for (int i = 0; i < 4; ++i) {
            const int c = i * 256 + lane * 4;
            const float4 gg = *(const float4*)(g + c), be = *(const float4*)(bb + c);
            const float4 o = make_float4((v[i].x - mean) * rstd * gg.x + be.x, (v[i].y - mean) * rstd * gg.y + be.y, (v[i].z - mean) * rstd * gg.z + be.z, (v[i].w - mean) * rstd * gg.w + be.w);
            if (fin) *(float4*)(p.out + (size_t)row * DM + c) = o;
            else {
                *(float4*)(fr + c) = o;
                uint2 w; w.x = pk_bf16(o.x, o.y); w.y = pk_bf16(o.z, o.w);
                *(uint2*)(p.ab + (size_t)row * DM + c) = w;
            }
        }
    }
}

__device__ __forceinline__ void conv_unit(KP& p, int l, int cu, unsigned char* lds) {
    const int tid5 = opaque_tid(), hb = tid5 >> 8, tid = tid5 & 255, lane = tid & 63, wid = tid >> 6;
    const int row0 = cu * 16;
    bool isS; int b, t0, pos; tok_decode(row0, isS, b, t0, pos);
    const int seq_row0 = row0 - t0, tb = t0 + 8 * hb;
    unsigned* xs = (unsigned*)(lds + hb * 40960);
    float* red = (float*)(lds + 81920 + hb * 512);
    const unsigned* ug = (const unsigned*)p.u;
    for (int rep = 0; rep < (DUP_PART == 5 ? 2 : 1); ++rep) {
    __syncthreads();
    {
        const int nneg = tb < 30 ? 30 - tb : 0;
#pragma unroll
        for (int i = 0; i < 38; ++i) {
            const int tok = tb - 30 + i;
            const int tokc = tok < 0 ? 0 : tok;
            unsigned v = ug[(size_t)(seq_row0 + tokc) * 256 + tid];
            if (i < 30 && i < nneg) {
                v = 0u;
                if (isS) { const float2 s = *(const float2*)(p.state_conv + ((size_t)(l * 16 + b) * 30 + (30 + tok)) * 512 + 2 * tid); v = pk_bf16(s.x, s.y); }
            }
            xs[i * 256 + tid] = v;
        }
    }
    float cw0[31], cw1[31];
#pragma unroll
    for (int w = 0; w < 31; ++w) { const float2 c = *(const float2*)(p.conv_w + ((size_t)l * 31 + w) * 512 + 2 * tid); cw0[w] = c.x; cw1[w] = c.y; }
    const float2 cb = *(const float2*)(p.conv_b + l * 512 + 2 * tid);
#pragma unroll 2
    for (int t = 0; t < 8; ++t) {
        float a0 = cb.x, a1 = cb.y;
        const unsigned* xr = xs + t * 256 + tid;
#pragma unroll
        for (int w = 0; w < 31; ++w) { const unsigned v = xr[w * 256]; a0 += bf_lo(v) * cw0[w]; a1 += bf_hi(v) * cw1[w]; }
        float s = a0 + a1, q = a0 * a0 + a1 * a1;
#pragma unroll
        for (int o = 32; o >= 1; o >>= 1) { s += __shfl_xor(s, o); q += __shfl_xor(q, o); }
        if (lane == 0) { red[(wid * 8 + t) * 2] = s; red[(wid * 8 + t) * 2 + 1] = q; }
        xs[t * 256 + tid] = pk_bf16(a0, a1);
    }
    __syncthreads();
    const float2 lg = *(const float2*)(p.cln_g + l * 512 + 2 * tid);
    const float2 lb = *(const float2*)(p.cln_b + l * 512 + 2 * tid);
#pragma unroll 4
    for (int t = 0; t < 8; ++t) {
        const float s = (red[t * 2] + red[(8 + t) * 2]) + (red[(16 + t) * 2] + red[(24 + t) * 2]);
        const float q = (red[t * 2 + 1] + red[(8 + t) * 2 + 1]) + (red[(16 + t) * 2 + 1] + red[(24 + t) * 2 + 1]);
        const float mean = s * (1.0f / 512.0f);
        const float var = fmaxf(q * (1.0f / 512.0f) - mean * mean, 0.f);
        const float rstd = rsqrtf(var + LN_EPS);
        const unsigned v = xs[t * 256 + tid];
        float a = (bf_lo(v) - mean) * rstd * lg.x + lb.x, c = (bf_hi(v) - mean) * rstd * lg.y + lb.y;
        a = a * sigmoidf_(a); c = c * sigmoidf_(c);
        *(unsigned*)(p.ab + (size_t)(row0 + 8 * hb + t) * DM + 2 * tid) = pk_bf16(a, c);
    }
    __syncthreads();
    }
}

__device__ __forceinline__ void attn_unit(KP& p, int isS, int b, int t0, unsigned char* lds) {
    const int tid = opaque_tid(), lane = tid & 63, wid = tid >> 6, r = lane & 31, hh = lane >> 5;
    unsigned* sc = (unsigned*)lds;
    unsigned short* idxl = (unsigned short*)(lds + NQ * SS * 4) + wid * 256;
    const int row0 = isS ? TP + b * 64 + t0 : b * 4096 + t0;
    const int S = isS ? SS : ((t0 >> 6) + 1) * 64;
    const bf16_t* KI = isS ? p.kis + (size_t)b * SS * 64 : p.kip + (size_t)b * SP * 64;
    const bf16_t* Kc = isS ? p.ks + (size_t)b * SS * 128 : p.kp + (size_t)b * SP * 128;
    const bf16_t* Vc = isS ? p.vs + (size_t)b * SS * 128 : p.vp + (size_t)b * SP * 128;
    __syncthreads();
    {
        bf16x8 qf[2][4];
#pragma unroll
        for (int gq = 0; gq < 2; ++gq)
#pragma unroll
            for (int ks = 0; ks < 4; ++ks) qf[gq][ks] = *(const bf16x8*)(p.qi + (size_t)(row0 + 4 * gq + (r >> 3)) * 512 + (r & 7) * 64 + ks * 16 + hh * 8);
        float w[8][4];
#pragma unroll
        for (int q = 0; q < 8; ++q) { const float4 t = *(const float4*)(p.wi + (size_t)(row0 + q) * 8 + 4 * hh); w[q][0] = t.x; w[q][1] = t.y; w[q][2] = t.z; w[q][3] = t.w; }
        const int ntile = S >> 5;
        auto ldk = [&](int kt, bf16x8 (&kf)[4]) {
            const bf16_t* kr = KI + (size_t)(kt * 32 + r) * 64 + hh * 8;
#pragma unroll
            for (int ks = 0; ks < 4; ++ks) kf[ks] = *(const bf16x8*)(kr + ks * 16);
        };
        auto comp = [&](int kt, const bf16x8 (&kf)[4]) {
#pragma unroll
            for (int gq = 0; gq < 2; ++gq) {
                f32x16 d;
#pragma unroll
                for (int i = 0; i < 16; ++i) d[i] = 0.f;
#pragma unroll
                for (int ks = 0; ks < 4; ++ks) d = __builtin_amdgcn_mfma_f32_32x32x16_bf16(qf[gq][ks], kf[ks], d, 0, 0, 0);
                float s[4];
#pragma unroll
                for (int q = 0; q < 4; ++q) {
                    const float* wq = w[4 * gq + q];
                    s[q] = (wq[0] * fmaxf(d[4 * q], 0.f) + wq[1] * fmaxf(d[4 * q + 1], 0.f)) + (wq[2] * fmaxf(d[4 * q + 2], 0.f) + wq[3] * fmaxf(d[4 * q + 3], 0.f));
                    s[q] += __shfl_xor(s[q], 32);
                    s[q] += 0.0f;
                }
                const float a0 = hh ? s[2] : s[0], a1 = hh ? s[3] : s[1];
                sc[(4 * gq + hh * 2) * SS + kt * 32 + r] = tokey(a0);
                sc[(4 * gq + hh * 2 + 1) * SS + kt * 32 + r] = tokey(a1);
            }
        };
        for (int rep = 0; rep < (DUP_PART == 1 ? 2 : 1); ++rep) {
        bf16x8 k0[4], k1[4], k2[4], k3[4];
        int kt = wid;
        if (kt < ntile) ldk(kt, k0);
        if (kt + 8 < ntile) ldk(kt + 8, k1);
        if (kt + 16 < ntile) ldk(kt + 16, k2);
        for (; kt < ntile; kt += 32) {
            if (kt + 24 < ntile) ldk(kt + 24, k3);
            comp(kt, k0);
            if (kt + 32 < ntile) ldk(kt + 32, k0);
            if (kt + 8 < ntile) comp(kt + 8, k1);
            if (kt + 40 < ntile) ldk(kt + 40, k1);
            if (kt + 16 < ntile) comp(kt + 16, k2);
            if (kt + 48 < ntile) ldk(kt + 48, k2);
            if (kt + 24 < ntile) comp(kt + 24, k3);
        }
        }
    }
    __syncthreads();
    const int Ksel = S < 256 ? S : 256;
    for (int rep = 0; rep < (DUP_PART == 2 ? 2 : 1); ++rep)
    if (S <= 256) {
        for (int i = lane; i < S; i += 64) idxl[i] = (unsigned short)i;
    } else {
        unsigned key[65];
        const unsigned* myr = sc + wid * SS;
        const int nslot = S >> 6;
#pragma unroll
        for (int s = 0; s < 65; ++s) key[s] = (s < nslot) ? myr[s * 64 + lane] : 0u;
        const unsigned long long lt = (1ull << lane) - 1ull;
        bool filt = false; unsigned Pv = 0u; int ncand = 0;
        if (nslot >= 20) {
            const float mm = 65792.0f / (float)S;
            const int rs = (int)(mm + 3.0f * sqrtf(mm) + 6.5f);
            for (int bit = 31; bit >= 0; --bit) {
                const unsigned C = Pv | (1u << bit);
                const int c = __builtin_popcountll(__ballot(key[0] >= C)) + __builtin_popcountll(__ballot(key[5] >= C)) + __builtin_popcountll(__ballot(key[10] >= C)) + __builtin_popcountll(__ballot(key[15] >= C));
                if (c >= rs) Pv = C;
            }
            int ca = 0;
#pragma unroll
            for (int sg = 0; sg < 13; ++sg) {
                if (sg * 5 < nslot) {
#pragma unroll
                    for (int s = sg * 5; s < sg * 5 + 5; ++s) ca += __builtin_popcountll(__ballot(key[s] >= Pv));
                }
            }
            if (ca >= 256 && ca <= 1024) { filt = true; ncand = ca; }
        }
        if (filt) {
            unsigned* candk = (unsigned*)(sc + wid * SS);
            unsigned short* candi = (unsigned short*)(candk + 1024);
            int cb = 0;
#pragma unroll
            for (int sg = 0; sg < 13; ++sg) {
                if (sg * 5 < nslot) {
#pragma unroll
                    for (int s = sg * 5; s < sg * 5 + 5; ++s) {
                        const bool g = key[s] >= Pv;
                        const unsigned long long m = __ballot(g);
                        if (g) { const int pos = cb + __builtin_popcountll(m & lt); candk[pos] = key[s]; candi[pos] = (unsigned short)(s * 64 + lane); }
                        cb += __builtin_popcountll(m);
                    }
                }
            }
            unsigned ck[16];
#pragma unroll
            for (int j = 0; j < 16; ++j) ck[j] = (j * 64 + lane < ncand) ? candk[j * 64 + lane] : 0u;
            const int ncs = (ncand + 63) >> 6;
            unsigned P = 0; bool exact = false;
            for (int bit = 31; bit >= 0; --bit) {
                const unsigned C = P | (1u << bit);
                int cnt = 0;
#pragma unroll
                for (int jg = 0; jg < 4; ++jg) {
                    if (jg * 4 < ncs) {
#pragma unroll
                        for (int j = jg * 4; j < jg * 4 + 4; ++j) cnt += __builtin_popcountll(__ballot(ck[j] >= C));
                    }
                }
                if (cnt >= 256) { P = C; if (cnt == 256) { exact = true; break; } }
            }
            const unsigned Tg = exact ? P - 1u : P;
            int base = 0;
#pragma unroll
            for (int jg = 0; jg < 4; ++jg) {
                if (jg * 4 < ncs) {
#pragma unroll
                    for (int j = jg * 4; j < jg * 4 + 4; ++j) {
                        const bool g = ck[j] > Tg;
                        const unsigned long long m = __ballot(g);
                        if (g) idxl[base + __builtin_popcountll(m & lt)] = candi[j * 64 + lane];
                        base += __builtin_popcountll(m);
                    }
                }
            }
            const int need = 256 - base;
            if (need > 0) {
                int tb = 0;
#pragma unroll
                for (int j = 0; j < 16; ++j) {
                    const bool e = (ck[j] == Tg) && (j * 64 + lane < ncand);
                    const unsigned long long m = __ballot(e);
                    const int rk = tb + __builtin_popcountll(m & lt);
                    if (e && rk < need) idxl[base + rk] = candi[j * 64 + lane];
                    tb += __builtin_popcountll(m);
                }
            }
        } else {
        unsigned P = 0; bool exact = false;
        for (int bit = 31; bit >= 0; --bit) {
            const unsigned C = P | (1u << bit);
            int cnt = 0;
#pragma unroll
            for (int sg = 0; sg < 13; ++sg) {
                if (sg * 5 < nslot) {
#pragma unroll
                    for (int s = sg * 5; s < sg * 5 + 5; ++s) cnt += __builtin_popcountll(__ballot(key[s] >= C));
                }
            }
            if (cnt >= 256) { P = C; if (cnt == 256) { exact = true; break; } }
        }
        const unsigned Tg = exact ? P - 1u : P;
        int base = 0;
#pragma unroll
        for (int sg = 0; sg < 13; ++sg) {
            if (sg * 5 < nslot) {
#pragma unroll
                for (int s = sg * 5; s < sg * 5 + 5; ++s) {
                    const bool g = key[s] > Tg;
                    const unsigned long long m = __ballot(g);
                    if (g) idxl[base + __builtin_popcountll(m & lt)] = (unsigned short)(s * 64 + lane);
                    base += __builtin_popcountll(m);
                }
            }
        }
        const int need = 256 - base;
        if (need > 0) {
            int tb = 0;
#pragma unroll
            for (int s = 0; s < 65; ++s) {
                const bool e = (key[s] == Tg) && (s < nslot);
                const unsigned long long m = __ballot(e);
                const int rk = tb + __builtin_popcountll(m & lt);
                if (e && rk < need) idxl[base + rk] = (unsigned short)(s * 64 + lane);
                tb += __builtin_popcountll(m);
            }
        }
        }
    }
    const int row = row0 + wid;
    unsigned char* Tl = (unsigned char*)(sc + wid * SS);
    bf16_t* Pb = (bf16_t*)(Tl + 8192);
    const int sub = lane & 15, kq = lane >> 4;
#define LDT(base, tile, v) do { _Pragma("unroll") for (int j = 0; j < 8; ++j) { const int key_ = (tile) * 32 + 4 * j + kq; const int id_ = (key_ < Ksel) ? (int)idxl[key_] : 0; \
        v[j] = *(const u32x4*)((base) + (size_t)id_ * 128 + sub * 8); } } while (0)
#define STK(v) do { _Pragma("unroll") for (int j = 0; j < 8; ++j) { const int rr_ = 4 * j + kq; *(u32x4*)(Tl + rr_ * 256 + ((sub ^ (rr_ & 15)) << 4)) = v[j]; } } while (0)
#define STV(v) do { _Pragma("unroll") for (int j = 0; j < 8; ++j) { const int rr_ = 4 * j + kq; *(u32x4*)(Tl + rr_ * 256 + ((sub ^ (((rr_ & 3) << 2) | ((rr_ >> 2) & 3))) << 4)) = v[j]; } } while (0)
    for (int rep3 = 0; rep3 < (DUP_PART == 3 ? 2 : 1); ++rep3) {
    f32x4 lg[8];
    {
        bf16x8 qa[8];
#pragma unroll
        for (int ks = 0; ks < 8; ++ks) {
            const int kk = ks * 16 + hh * 8, g = kk >> 6, d = kk & 63;
            const bool valid = (r < 8) && ((r >> 2) == g);
            bf16x8 z;
#pragma unroll
            for (int j = 0; j < 8; ++j) z[j] = 0;
            qa[ks] = valid ? *(const bf16x8*)(p.q + (size_t)row * 512 + r * 64 + d) : z;
        }
        auto cmq = [&](int tile) -> f32x4 {
            f32x16 d;
#pragma unroll
            for (int i = 0; i < 16; ++i) d[i] = 0.f;
#pragma unroll
            for (int ks = 0; ks < 8; ++ks) {
                const bf16x8 kf = *(const bf16x8*)(Tl + r * 256 + (((ks * 2 + hh) ^ (r & 15)) << 4));
                d = __builtin_amdgcn_mfma_f32_32x32x16_bf16(qa[ks], kf, d, 0, 0, 0);
            }
            const bool ok = tile * 32 + r < Ksel;
            return (f32x4){ok ? d[0] : -INFINITY, ok ? d[1] : -INFINITY, ok ? d[2] : -INFINITY, ok ? d[3] : -INFINITY};
        };
        u32x4 k0[8], k1[8], k2[8], k3[8];
        LDT(Kc, 0, k0); LDT(Kc, 1, k1); LDT(Kc, 2, k2);
        LDT(Kc, 3, k3); STK(k0); lg[0] = cmq(0);
        LDT(Kc, 4, k0); STK(k1); lg[1] = cmq(1);
        LDT(Kc, 5, k1); STK(k2); lg[2] = cmq(2);
        LDT(Kc, 6, k2); STK(k3); lg[3] = cmq(3);
        LDT(Kc, 7, k3); STK(k0); lg[4] = cmq(4);
        STK(k1); lg[5] = cmq(5); STK(k2); lg[6] = cmq(6); STK(k3); lg[7] = cmq(7);
    }
    u32x4 v0[8], v1[8], v2[8], v3[8];
    LDT(Vc, 0, v0); LDT(Vc, 1, v1); LDT(Vc, 2, v2);
    {
#pragma unroll
        for (int i = 0; i < 4; ++i) {
            float mx = lg[0][i];
#pragma unroll
            for (int tile = 1; tile < 8; ++tile) mx = fmaxf(mx, lg[tile][i]);
#pragma unroll
            for (int o = 16; o >= 1; o >>= 1) mx = fmaxf(mx, __shfl_xor(mx, o));
            float sm = 0.f;
#pragma unroll
            for (int tile = 0; tile < 8; ++tile) { lg[tile][i] = exp2f(lg[tile][i] - mx); sm += lg[tile][i]; }
#pragma unroll
            for (int o = 16; o >= 1; o >>= 1) sm += __shfl_xor(sm, o);
            const float inv = 1.0f / sm;
#pragma unroll
            for (int tile = 0; tile < 8; ++tile) Pb[(4 * hh + i) * 256 + tile * 32 + r] = (bf16_t)(pk_bf16(lg[tile][i] * inv, 0.f) & 0xffffu);
        }
    }
    {
        f32x4 acc[8];
#pragma unroll
        for (int ct = 0; ct < 8; ++ct) acc[ct] = (f32x4){0.f, 0.f, 0.f, 0.f};
        const unsigned tl_off = (unsigned)(size_t)((PG8_LAS unsigned char*)Tl);
        const int g4 = lane >> 4, tq = (lane & 15) >> 2, tp = lane & 3;
        const int ra = 8 * g4 + tq, rb = ra + 4;
        const int xa = ((ra & 3) << 2) | ((ra >> 2) & 3), xb2 = ((rb & 3) << 2) | ((rb >> 2) & 3);
        auto pvt = [&](int tile) {
            const bf16x8 a = *(const bf16x8*)(Pb + (lane & 7) * 256 + tile * 32 + (lane >> 4) * 8);
#pragma unroll
            for (int ct = 0; ct < 8; ++ct) {
                const int ch = 2 * ct + (tp >> 1);
                const unsigned a0 = tl_off + ra * 256 + ((ch ^ xa) << 4) + 8 * (tp & 1);
                const unsigned a1 = tl_off + rb * 256 + ((ch ^ xb2) << 4) + 8 * (tp & 1);
                typedef short s16x4 __attribute__((ext_vector_type(4)));
                s16x4 t0, t1;
                asm volatile("ds_read_b64_tr_b16 %0, %2\n\tds_read_b64_tr_b16 %1, %3\n\ts_waitcnt lgkmcnt(0)" : "=&v"(t0), "=&v"(t1) : "v"(a0), "v"(a1) : "memory");
                bf16x8 b; b[0] = t0[0]; b[1] = t0[1]; b[2] = t0[2]; b[3] = t0[3]; b[4] = t1[0]; b[5] = t1[1]; b[6] = t1[2]; b[7] = t1[3];
                acc[ct] = __builtin_amdgcn_mfma_f32_16x16x32_bf16(a, b, acc[ct], 0, 0, 0);
            }
        };
        LDT(Vc, 3, v3); STV(v0); pvt(0);
        LDT(Vc, 4, v0); STV(v1); pvt(1);
        LDT(Vc, 5, v1); STV(v2); pvt(2);
        LDT(Vc, 6, v2); STV(v3); pvt(3);
        LDT(Vc, 7, v3); STV(v0); pvt(4);
        STV(v1); pvt(5); STV(v2); pvt(6); STV(v3); pvt(7);
        if (g4 < 2) {
#pragma unroll
            for (int c4 = 0; c4 < 4; ++c4) {
                f32x4 olo = acc[c4], ohi = acc[4 + c4];
                asm volatile("" : "+v"(olo), "+v"(ohi));
                const f32x4 o = g4 ? ohi : olo;
#pragma unroll
                for (int j = 0; j < 4; ++j) p.ab[(size_t)row * DM + 512 + (4 * g4 + j) * 64 + 16 * c4 + (lane & 15)] = (bf16_t)(pk_bf16(o[j], 0.f) & 0xffffu);
            }
        }
    }
    }
}

__device__ __forceinline__ void mixer_unit(KP& p, int l, int pair, int u, unsigned char* lds) {
    if (u < 544) {
        int isS, b, t0;
        if (u < 32) { isS = 1; b = 4 * pair + (u >> 3); t0 = (u & 7) * 8; }
        else { const int j = u - 32; isS = 0; b = pair; t0 = (63 - (j >> 3)) * 64 + (j & 7) * 8; }
        attn_unit(p, isS, b, t0, lds);
    } else { const int j = u - 544; conv_unit(p, l, (j < 256) ? pair * 256 + j : 1024 + pair * 16 + (j - 256), lds); }
}
__device__ __forceinline__ void mixer_phase(KP& p, int l, unsigned char* lds) {
    const int tid = opaque_tid();
    volatile unsigned* st = (volatile unsigned*)(lds + LDS_BYTES);
    const unsigned xcc = (unsigned)__builtin_amdgcn_s_getreg((3 << 11) | 20) & 7u;
    for (int pp = 0; pp < 4; ++pp) {
        const int pair = (int)((xcc >> 1) + pp) & 3;
        unsigned* ctr = p.bar + 3456 + (l * 4 + pair) * 16;
        for (;;) {
            __syncthreads();
            if (tid == 0) st[2] = __hip_atomic_fetch_add(ctr, 1u, __ATOMIC_RELAXED, __HIP_MEMORY_SCOPE_AGENT);
            __syncthreads();
            const unsigned u = st[2];
            if (u >= 816u) break;
            mixer_unit(p, l, pair, (int)u, lds);
        }
    }
}

#define XB_TMO      128
#define XB_XCNT(j)  (256  + 64 * (j))
#define XB_XSUB(j)  (1280 + 64 * (j))
#define XB_XGEN(j)  (2304 + 64 * (j))
#define XB_TOP      3328
#define XB_TOPGEN   3392
#define XCD_BAR_WORDS 3456
#define XB_SPIN_CAP (1u << 20)
__device__ __forceinline__ unsigned xb_ld(unsigned* p)              { return __hip_atomic_load(p, __ATOMIC_RELAXED, __HIP_MEMORY_SCOPE_AGENT); }
__device__ __forceinline__ unsigned xb_add(unsigned* p, unsigned v) { return __hip_atomic_fetch_add(p, v, __ATOMIC_RELAXED, __HIP_MEMORY_SCOPE_AGENT); }
__device__ __forceinline__ unsigned xb_xcc_id() { return (unsigned)__builtin_amdgcn_s_getreg((3 << 11) | 20) & 0xFu; }
#define XB_SPIN(cond, bar) do { unsigned _sp = 0; while (cond) { __builtin_amdgcn_s_sleep(1); \
    if ((++_sp & 255u) == 0u) { if (xb_ld(&(bar)[XB_TMO])) break; if (_sp > XB_SPIN_CAP) { atomicAdd(&(bar)[XB_TMO], 1u); break; } } } } while (0)
struct XcdBarrier { unsigned* bar; unsigned x; volatile unsigned* st; };
__device__ __forceinline__ XcdBarrier xcd_barrier_post(unsigned* bar, volatile unsigned* st) {
    XcdBarrier b; b.bar = bar; b.x = xb_xcc_id(); b.st = st;
    if (threadIdx.x == 0) (void)xb_add(&bar[XB_XCNT(b.x)], 1u);
    return b;
}
__device__ __forceinline__ void xcd_barrier_complete(unsigned* bar, unsigned x, unsigned& nloc, unsigned& nx) {
    const unsigned G = gridDim.x * gridDim.y * gridDim.z;
    unsigned sum, cnt, mine, sp = 0u;
    for (;;) {
        sum = 0u; cnt = 0u; mine = 0u;
#pragma unroll
        for (unsigned j = 0; j < 16; ++j) { const unsigned c = xb_ld(&bar[XB_XCNT(j)]); sum += c; cnt += (c > 0u) ? 1u : 0u; mine = (j == x) ? c : mine; }
        if (sum == G) break;
        __builtin_amdgcn_s_sleep(1);
        if ((++sp & 255u) == 0u) { if (xb_ld(&bar[XB_TMO])) break; if (sp > XB_SPIN_CAP) { atomicAdd(&bar[XB_TMO], 1u); break; } }
    }
    nloc = mine > 0u ? mine : 1u; nx = cnt > 0u ? cnt : 1u;
}
__device__ __forceinline__ void xcd_barrier(const XcdBarrier& b) {
    asm volatile("s_waitcnt vmcnt(0)" ::: "memory");
    __syncthreads();
    if (threadIdx.x == 0) {
        unsigned* bar = b.bar;
        __builtin_amdgcn_s_waitcnt(0);
        unsigned nloc = b.st[0], nx = b.st[1];
        if (nloc == 0u) { xcd_barrier_complete(bar, b.x, nloc, nx); b.st[0] = nloc; b.st[1] = nx; }
        const unsigned old = xb_add(&bar[XB_XSUB(b.x)], 1u);
        const unsigned gen = old / nloc;
        if (old + 1u == (gen + 1u) * nloc) {
            __builtin_amdgcn_fence(__ATOMIC_RELEASE, "agent");
            asm volatile("s_waitcnt vmcnt(0)" ::: "memory");
            const unsigned og = xb_add(&bar[XB_TOP], 1u);
            const unsigned tg = og / nx;
            if (og + 1u == (tg + 1u) * nx) xb_add(&bar[XB_TOPGEN], 1u);
            else XB_SPIN(xb_ld(&bar[XB_TOPGEN]) == tg, bar);
            __builtin_amdgcn_fence(__ATOMIC_ACQUIRE, "agent");
            xb_add(&bar[XB_XGEN(b.x)], 1u);
            asm volatile("s_waitcnt vmcnt(0)" ::: "memory");
        } else {
            XB_SPIN(xb_ld(&bar[XB_XGEN(b.x)]) == gen, bar);
            __builtin_amdgcn_fence(__ATOMIC_ACQUIRE, "agent");
            asm volatile("s_waitcnt vmcnt(0)" ::: "memory");
        }
    }
    __syncthreads();
}

__device__ __forceinline__ void run_phase(KP& p, int ph, unsigned char* lds) {
#ifndef TEST_K
    if (ph == 0) { phase0(p, lds); return; }
#else
    if (TEST_K == 7) { phase0(p, lds); return; }
#endif
    const int l = (ph - 1) / 7, k = (ph - 1) % 7;
#ifdef TEST_K
    if (k != TEST_K) return;
#endif
    switch (k) {
        case 0: { EpiIn e{l}; gemm_run(p.ab, p.win_t + (size_t)l * NINP * DM, TT, NINP, DM, lds, e); } break;
        case 1: mixer_phase(p, l, lds); break;
        case 2: { EpiWo e{l}; gemm_run(p.ab, p.wo_t + (size_t)l * DM * DM, TP, DM, DM, lds, e); __syncthreads(); gemm_tail(p, p.ab, p.wo_t + (size_t)l * DM * DM, DM, 4, lds); } break;
        case 3: ln_phase(p, l, 1); if (l == 0) convert_cache(p, 1); break;
        case 4: { EpiGu e{0}; gemm_run(p.ab, p.wgu_t + (size_t)l * NGU * DM, TT, NGU, DM, lds, e); } break;
        case 5: { EpiDn e{0}; gemm_run(p.act, p.wdn_t + (size_t)l * DM * DFF, TP, DM, DFF, lds, e); __syncthreads(); gemm_tail(p, p.act, p.wdn_t + (size_t)l * DM * DFF, DFF, 7, lds); } break;
        case 6: ln_phase(p, l, 2); break;
    }
}

__global__ void __launch_bounds__(512, 2) mk(Params p, int ph_lo, int ph_hi) {
    extern __shared__ __attribute__((aligned(16))) unsigned char lds[];
#if MK_COOP
    volatile unsigned* st = (volatile unsigned*)(lds + LDS_BYTES);
    if (threadIdx.x == 0) { st[0] = 0u; st[1] = 0u; st[2] = 0u; st[3] = 0u; }
    __syncthreads();
    XcdBarrier xb = xcd_barrier_post(kparams().bar, st);
#endif
    for (int ph = ph_lo; ph < ph_hi; ++ph) {
        int reps = 1;
#ifdef DUP_K
        if (ph > 0 && (ph - 1) % 7 == DUP_K) reps = 2;
        if (ph == 0 && DUP_K == 7) reps = 2;
#endif
        for (int rp = 0; rp < reps; ++rp) { run_phase(kparams(), ph, lds); __syncthreads(); }
#if MK_COOP
        if (ph + 1 < ph_hi) xcd_barrier(xb);
#endif
    }
}

static inline size_t al256(size_t x) { return (x + 255) & ~(size_t)255; }

extern "C" void kernel_launch(void* const* d_in, const int* in_sizes, int n_in, void* d_out, int out_size, void* d_ws, size_t ws_size, hipStream_t stream) {
    static int grid = 0;
    if (grid == 0) {
        int dev = 0, cus = 0, per_cu = 0;
        hipGetDevice(&dev);
        hipDeviceGetAttribute(&cus, hipDeviceAttributeMultiprocessorCount, dev);
        if (hipFuncSetAttribute((const void*)mk, hipFuncAttributeMaxDynamicSharedMemorySize, LDS_BYTES + 16) != hipSuccess) { fprintf(stderr, "hipFuncSetAttribute failed\n"); grid = -1; return; }
        hipOccupancyMaxActiveBlocksPerMultiprocessor(&per_cu, (const void*)mk, NTHR, LDS_BYTES + 16);
        if (per_cu < 1) { fprintf(stderr, "occupancy query says %d\n", per_cu); grid = -1; return; }
        if (per_cu > 1) per_cu = 1;
        grid = cus * per_cu;
        fprintf(stderr, "grid %d (cus %d x %d)\n", grid, cus, per_cu);
    }
    if (grid < 0) return;
    Params p{};
    const float* const* in = (const float* const*)d_in;
    p.x_prompt = in[0]; p.x_sample = in[1]; p.cache_k = in[2]; p.cache_v = in[3]; p.cache_ki = in[4]; p.state_conv = in[5];
    p.w_in = in[6]; p.conv_w = in[7]; p.conv_b = in[8]; p.cln_g = in[9]; p.cln_b = in[10]; p.w_o = in[11]; p.ln1_g = in[12]; p.ln1_b = in[13];
    p.w_gu = in[14]; p.w_dn = in[15]; p.ln2_g = in[16]; p.ln2_b = in[17];
    p.out = (float*)d_out;
    unsigned char* w = (unsigned char*)d_ws; size_t off = 0;
    auto take = [&](size_t bytes) { unsigned char* r = w + off; off = al256(off + bytes); return r; };
    p.win_t = (bf16_t*)take((size_t)2 * NINP * DM * 2);
    p.wo_t = (bf16_t*)take((size_t)2 * DM * DM * 2);
    p.wgu_t = (bf16_t*)take((size_t)2 * NGU * DM * 2);
    p.wdn_t = (bf16_t*)take((size_t)2 * DM * DFF * 2);
    p.trig = (float2*)take((size_t)SS * 32 * 8);
    p.kp = (bf16_t*)take((size_t)4 * SP * 128 * 2); p.vp = (bf16_t*)take((size_t)4 * SP * 128 * 2); p.kip = (bf16_t*)take((size_t)4 * SP * 64 * 2);
    p.ks = (bf16_t*)take((size_t)16 * SS * 128 * 2); p.vs = (bf16_t*)take((size_t)16 * SS * 128 * 2); p.kis = (bf16_t*)take((size_t)16 * SS * 64 * 2);
    p.ab = (bf16_t*)take((size_t)TT * DM * 2);
    p.F = (float*)take((size_t)TT * DM * 4);
    unsigned char* big = take((size_t)TT * DFF * 2);
    p.act = (bf16_t*)big;
    p.u = (bf16_t*)big; p.q = (bf16_t*)(big + (size_t)TT * 512 * 2); p.qi = (bf16_t*)(big + (size_t)2 * TT * 512 * 2); p.wi = (float*)(big + (size_t)3 * TT * 512 * 2);
    p.bar = (unsigned*)take((size_t)(XCD_BAR_WORDS + 128) * 4);
    p.part = (float*)take((size_t)7 * TSM * DM * 4);
    if (off > ws_size) { fprintf(stderr, "workspace too small: need %zu have %zu\n", off, ws_size); return; }
#if MK_COOP
    if (hipMemsetAsync(p.bar, 0, (size_t)(XCD_BAR_WORDS + 128) * 4, stream) != hipSuccess) { fprintf(stderr, "memset failed\n"); return; }
    int lo = 0, hi = 15;
    void* args[] = {&p, &lo, &hi};
    hipError_t e = hipLaunchCooperativeKernel((const void*)mk, dim3(grid), dim3(NTHR), args, LDS_BYTES + 16, stream);
    if (e != hipSuccess) fprintf(stderr, "cooperative launch failed: %s (grid %d)\n", hipGetErrorString(e), grid);
#else
    for (int ph = 0; ph < 15; ++ph) hipLaunchKernelGGL(mk, dim3(grid), dim3(NTHR), LDS_BYTES + 16, stream, p, ph, ph + 1);
#endif
}
```
